# Optimizing an MI355X kernel written in HIP

```python
import math
import jax, jax.numpy as jnp
from jax import lax
import numpy as np

D_MODEL = 2048
BATCH = 2
SEQ = 4096
DEPTH = 2
DEC_BATCH = 32
DEC_SEQ = 4
PAST_LEN = 16384
PAGE_SIZE = 128

GROUP_W = D_MODEL // 4
D_MIX = 4 * GROUP_W
CONV_W = 3
CONV_GROUPS = 4
GLA_HEADS = 4
GLA_DK = GROUP_W // 2 // GLA_HEADS
GLA_DV = GROUP_W // GLA_HEADS
GLA_RANK = 16
GLA_TAU = 16.0
GLA_CHUNK = 64
SWA_HEADS = 8
SWA_KV_HEADS = 2
SWA_HD = GROUP_W // SWA_HEADS
WINDOW = 128
SWA_BLOCK = WINDOW
N_MEM = 256
MEM_HEADS = 4
MEM_HD = GROUP_W // MEM_HEADS
EPS = 1e-6

IN_SPLITS = (GROUP_W, GROUP_W, GROUP_W, GROUP_W,
             GLA_HEADS * GLA_DK, GLA_HEADS * GLA_DK, GLA_HEADS * GLA_DV, GLA_RANK, GROUP_W,
             SWA_HEADS * SWA_HD, SWA_KV_HEADS * SWA_HD, SWA_KV_HEADS * SWA_HD, GROUP_W,
             MEM_HEADS * MEM_HD, GROUP_W)
IN_OFFSETS = tuple(sum(IN_SPLITS[:i + 1]) for i in range(len(IN_SPLITS) - 1))
D_IN = sum(IN_SPLITS)

kernel_name = "hymba_conv_gla_swa_memory_step"


def rmsnorm(x, g):
    xf = x.astype(jnp.float32)
    y = xf * lax.rsqrt(jnp.mean(xf * xf, axis=-1, keepdims=True) + EPS)
    return (y * g.astype(jnp.float32)).astype(x.dtype)


def short_conv(u, prev, w):
    L = u.shape[1]
    ext = jnp.concatenate([prev.astype(u.dtype), u], axis=1)
    out = w[0] * ext[:, 0:L]
    for j in range(1, CONV_W):
        out = out + w[j] * ext[:, j:j + L]
    return out, ext[:, -(CONV_W - 1):]


def gla_chunked(q, k, v, log_a, s0, chunk):
    b, L, H, _ = q.shape
    n = L // chunk

    def to_chunks(t):
        return t.reshape(b, n, chunk, H, t.shape[-1]).transpose(1, 0, 3, 2, 4)

    qc, kc, vc, ac = to_chunks(q), to_chunks(k), to_chunks(v), to_chunks(log_a)
    mask = jnp.tril(jnp.ones((chunk, chunk), dtype=bool))

    def step(S, inp):
        qi, ki, vi, ai = inp
        cum = jnp.cumsum(ai, axis=2)
        total = cum[:, :, -1:]
        q_dec = qi * jnp.exp(cum)
        k_dec = ki * jnp.exp(-cum)
        attn = jnp.where(mask, jnp.einsum('bhtd,bhsd->bhts', q_dec, k_dec), 0.0)
        o = jnp.einsum('bhts,bhsv->bhtv', attn, vi) + jnp.einsum('bhtd,bhdv->bhtv', q_dec, S)
        k_tail = ki * jnp.exp(total - cum)
        S_new = jnp.exp(total)[:, :, 0, :, None] * S + jnp.einsum('bhsd,bhsv->bhdv', k_tail, vi)
        return S_new, o

    S, o = lax.scan(step, s0, (qc, kc, vc, ac))
    o = o.transpose(1, 0, 3, 2, 4).reshape(b, L, H, -1)
    return o, S


def sink_softmax(s, valid, sinks):
    sink = sinks.astype(jnp.float32).reshape(SWA_KV_HEADS, -1, 1, 1)
    s = jnp.where(valid, s, -jnp.inf)
    m = jnp.maximum(jnp.max(s, axis=-1, keepdims=True), sink)
    e = jnp.exp(s - m)
    return e / (jnp.sum(e, axis=-1, keepdims=True) + jnp.exp(sink - m))


def swa_banded(q, k, v, sinks):
    b, L, H, hd = q.shape
    n = L // SWA_BLOCK
    G = H // SWA_KV_HEADS
    qb = q.reshape(b, n, SWA_BLOCK, SWA_KV_HEADS, G, hd)

    def band(t):
        prev = jnp.concatenate([jnp.zeros_like(t[:, :SWA_BLOCK]), t[:, :-SWA_BLOCK]], axis=1)
        return jnp.concatenate([prev.reshape(b, n, SWA_BLOCK, SWA_KV_HEADS, hd),
                                t.reshape(b, n, SWA_BLOCK, SWA_KV_HEADS, hd)], axis=2)

    kb, vb = band(k), band(v)
    s = jnp.einsum('bnqkgd,bnskd->bnkgqs', qb, kb).astype(jnp.float32) * (hd ** -0.5)
    blk = jnp.arange(n)[:, None, None]
    qi = jnp.arange(SWA_BLOCK)[None, :, None]
    kj = jnp.arange(2 * SWA_BLOCK)[None, None, :]
    dist = qi + SWA_BLOCK - kj
    valid = (dist >= 0) & (dist < WINDOW) & (blk * SWA_BLOCK + kj - SWA_BLOCK >= 0)
    p = sink_softmax(s, valid[:, None, None], sinks)
    o = jnp.einsum('bnkgqs,bnskd->bnqkgd', p.astype(v.dtype), vb)
    return o.reshape(b, L, H, hd)


def swa_decode(q, k_all, v_all, sinks):
    b, T, H, hd = q.shape
    G = H // SWA_KV_HEADS
    S = k_all.shape[1]
    qg = q.reshape(b, T, SWA_KV_HEADS, G, hd)
    s = jnp.einsum('btkgd,bskd->bkgts', qg, k_all).astype(jnp.float32) * (hd ** -0.5)
    dist = jnp.arange(T)[:, None] + (S - T) - jnp.arange(S)[None, :]
    valid = (dist >= 0) & (dist < WINDOW)
    p = sink_softmax(s, valid, sinks)
    o = jnp.einsum('bkgts,bskd->btkgd', p.astype(v_all.dtype), v_all)
    return o.reshape(b, T, H, hd)


def memory_kv(mem, g_mem, w_mem_kv, g_mem_k):
    b, m, _ = mem.shape
    kv = rmsnorm(mem, g_mem) @ w_mem_kv
    k, v = jnp.split(kv, 2, axis=-1)
    k = rmsnorm(k.reshape(b, m, MEM_HEADS, MEM_HD), g_mem_k)
    return k, v.reshape(b, m, MEM_HEADS, MEM_HD)


def mixer_layer(x, mem_k, mem_v, conv_prev, gla_s0, swa_k_prev, swa_v_prev,
                g_norm, w_in, conv_w, w_gla_a_up, b_gla_a, g_gla_o, g_swa_q, g_swa_k,
                swa_sinks, g_mem_q, w_out):
    b, L, _ = x.shape
    f32 = jnp.float32
    hn = rmsnorm(x, g_norm)
    proj = hn @ w_in
    (a_b, a_c, a_h, a_z, g_q, g_k, g_v, g_a, g_z,
     s_q, s_k, s_v, s_z, m_q, m_z) = jnp.split(proj, IN_OFFSETS, axis=-1)

    if conv_prev is None:
        conv_prev = jnp.zeros((b, CONV_W - 1, GROUP_W), x.dtype)
    conv_out, conv_state = short_conv(a_c * a_h, conv_prev, conv_w)
    y_a = a_b * conv_out * jax.nn.silu(a_z)

    q = g_q.reshape(b, L, GLA_HEADS, GLA_DK).astype(f32) * (GLA_DK ** -0.5)
    k = g_k.reshape(b, L, GLA_HEADS, GLA_DK).astype(f32)
    v = g_v.reshape(b, L, GLA_HEADS, GLA_DV).astype(f32)
    log_a = jax.nn.log_sigmoid((g_a @ w_gla_a_up + b_gla_a).astype(f32)).reshape(b, L, GLA_HEADS, GLA_DK) / GLA_TAU
    if gla_s0 is None:
        s0 = jnp.zeros((b, GLA_HEADS, GLA_DK, GLA_DV), f32)
    else:
        s0 = gla_s0.astype(f32)
    chunk = GLA_CHUNK if L % GLA_CHUNK == 0 else L
    o_gla, gla_state = gla_chunked(q, k, v, log_a, s0, chunk)
    o_gla = rmsnorm(o_gla, g_gla_o).astype(x.dtype)
    y_b = o_gla.reshape(b, L, GROUP_W) * jax.nn.silu(g_z)

    q = rmsnorm(s_q.reshape(b, L, SWA_HEADS, SWA_HD), g_swa_q)
    k = rmsnorm(s_k.reshape(b, L, SWA_KV_HEADS, SWA_HD), g_swa_k)
    v = s_v.reshape(b, L, SWA_KV_HEADS, SWA_HD)
    if swa_k_prev is None:
        o_swa = swa_banded(q, k, v, swa_sinks)
        k_buf, v_buf = k[:, -WINDOW:], v[:, -WINDOW:]
    else:
        k_all = jnp.concatenate([swa_k_prev.astype(k.dtype), k], axis=1)
        v_all = jnp.concatenate([swa_v_prev.astype(v.dtype), v], axis=1)
        o_swa = swa_decode(q, k_all, v_all, swa_sinks)
        k_buf, v_buf = k_all[:, -WINDOW:], v_all[:, -WINDOW:]
    y_c = o_swa.reshape(b, L, GROUP_W) * jax.nn.silu(s_z)

    q = rmsnorm(m_q.reshape(b, L, MEM_HEADS, MEM_HD), g_mem_q)
    s = jnp.einsum('blhd,bmhd->bhlm', q, mem_k.astype(q.dtype)).astype(f32) * (MEM_HD ** -0.5)
    p = jax.nn.softmax(s, axis=-1).astype(x.dtype)
    o_mem = jnp.einsum('bhlm,bmhd->blhd', p, mem_v.astype(x.dtype))
    y_d = o_mem.reshape(b, L, GROUP_W) * jax.nn.silu(m_z)

    mix = jnp.concatenate([y_a, y_b, y_c, y_d], axis=-1)
    y = x + mix @ w_out
    return y, conv_state, gla_state.astype(x.dtype), k_buf, v_buf


def setup_inputs(seed: int = 0) -> dict:
    key = jax.random.key(seed)
    ks = jax.random.split(key, 32)

    def nrm(k, shape, scale=1.0):
        return jax.random.normal(k, shape, jnp.float32) * scale

    def gain(k, shape):
        return 1.0 + 0.02 * jax.random.normal(k, shape, jnp.float32)

    return {
        "x_prompt": nrm(ks[0], (BATCH, SEQ, D_MODEL)),
        "x_sample": nrm(ks[1], (DEC_BATCH, DEC_SEQ, D_MODEL)),
        "mem_prompt": nrm(ks[2], (BATCH, N_MEM, D_MODEL)),
        "state_conv": nrm(ks[3], (DEPTH, DEC_BATCH, CONV_W - 1, GROUP_W)),
        "state_gla": nrm(ks[4], (DEPTH, DEC_BATCH, GLA_HEADS, GLA_DK, GLA_DV), 0.3),
        "cache_swa_k": nrm(ks[5], (DEPTH, DEC_BATCH, WINDOW, SWA_KV_HEADS, SWA_HD)),
        "cache_swa_v": nrm(ks[6], (DEPTH, DEC_BATCH, WINDOW, SWA_KV_HEADS, SWA_HD)),
        "cache_mem_k": nrm(ks[7], (DEPTH, DEC_BATCH, N_MEM, MEM_HEADS, MEM_HD)),
        "cache_mem_v": nrm(ks[8], (DEPTH, DEC_BATCH, N_MEM, MEM_HEADS, MEM_HD)),
        "g_norm": gain(ks[9], (DEPTH, D_MODEL)),
        "w_in": nrm(ks[10], (DEPTH, D_MODEL, D_IN), D_MODEL ** -0.5),
        "conv_w": nrm(ks[11], (DEPTH, CONV_W, GROUP_W), CONV_W ** -0.5),
        "w_gla_a_up": nrm(ks[12], (DEPTH, GLA_RANK, GLA_HEADS * GLA_DK), GLA_RANK ** -0.5),
        "b_gla_a": nrm(ks[13], (DEPTH, GLA_HEADS * GLA_DK), 0.1),
        "g_gla_o": gain(ks[14], (DEPTH, GLA_DV)),
        "g_swa_q": gain(ks[15], (DEPTH, SWA_HD)),
        "g_swa_k": gain(ks[16], (DEPTH, SWA_HD)),
        "swa_sinks": nrm(ks[17], (DEPTH, SWA_HEADS), 0.5),
        "g_mem": gain(ks[18], (DEPTH, D_MODEL)),
        "w_mem_kv": nrm(ks[19], (DEPTH, D_MODEL, 2 * MEM_HEADS * MEM_HD), D_MODEL ** -0.5),
        "g_mem_q": gain(ks[20], (DEPTH, MEM_HD)),
        "g_mem_k": gain(ks[21], (DEPTH, MEM_HD)),
        "w_out": nrm(ks[22], (DEPTH, D_MIX, D_MODEL), D_MIX ** -0.5),
    }


def reference(x_prompt, x_sample, mem_prompt, state_conv, state_gla, cache_swa_k, cache_swa_v,
              cache_mem_k, cache_mem_v, g_norm, w_in, conv_w, w_gla_a_up, b_gla_a, g_gla_o,
              g_swa_q, g_swa_k, swa_sinks, g_mem, w_mem_kv, g_mem_q, g_mem_k, w_out):
    hp, hs = x_prompt, x_sample
    conv_p, gla_p, swk_p, swv_p, mk_p, mv_p = [], [], [], [], [], []
    conv_s, gla_s, swk_s, swv_s = [], [], [], []
    for l in range(DEPTH):
        lw = (g_norm[l], w_in[l], conv_w[l], w_gla_a_up[l], b_gla_a[l], g_gla_o[l],
              g_swa_q[l], g_swa_k[l], swa_sinks[l], g_mem_q[l], w_out[l])
        mk, mv = memory_kv(mem_prompt, g_mem[l], w_mem_kv[l], g_mem_k[l])
        hp, c, s, kb, vb = mixer_layer(hp, mk, mv, None, None, None, None, *lw)
        conv_p.append(c); gla_p.append(s); swk_p.append(kb); swv_p.append(vb)
        mk_p.append(mk); mv_p.append(mv)
        hs, c, s, kb, vb = mixer_layer(hs, cache_mem_k[l], cache_mem_v[l], state_conv[l], state_gla[l],
                                       cache_swa_k[l], cache_swa_v[l], *lw)
        conv_s.append(c); gla_s.append(s); swk_s.append(kb); swv_s.append(vb)
    return (hp, hs,
            jnp.stack(conv_p), jnp.stack(gla_p), jnp.stack(swk_p), jnp.stack(swv_p),
            jnp.stack(mk_p), jnp.stack(mv_p),
            jnp.stack(conv_s), jnp.stack(gla_s), jnp.stack(swk_s), jnp.stack(swv_s))
```

```cpp
#include <hip/hip_runtime.h>
#include <cstdio>
#include <cstdint>

#ifndef MK_N_LAUNCHES
#define MK_N_LAUNCHES 1
#endif

#define GAS __attribute__((address_space(1)))
#define LAS __attribute__((address_space(3)))
typedef unsigned short bf16_t;
typedef short bf16x8 __attribute__((ext_vector_type(8)));
typedef short s16x4 __attribute__((ext_vector_type(4)));
typedef short v4i16_t __attribute__((ext_vector_type(4)));
typedef float f32x4 __attribute__((ext_vector_type(4)));
typedef unsigned u32x4 __attribute__((ext_vector_type(4)));
typedef unsigned u32x2 __attribute__((ext_vector_type(2)));

constexpr int DM = 2048, SEQ = 4096, NP = 8192, NS = 128, DB = 32, DS = 4, DIN = 5904, PN = 6144, NMEMROWS = 512;
constexpr int C_AB = 0, C_AC = 512, C_AH = 1024, C_AZ = 1536, C_GQ = 2048, C_GK = 2304, C_GV = 2560, C_GA = 3072, C_GZ = 3088,
              C_SQ = 3600, C_SK = 4112, C_SV = 4240, C_SZ = 4368, C_MQ = 4880, C_MZ = 5392;
constexpr float EPS = 1e-6f;
constexpr size_t O_YP = 0, O_YS = 16777216, O_CONVP = 17039360, O_GLAP = 17043456, O_SWKP = 17174528, O_SWVP = 17240064, O_MKP = 17305600,
                 O_MVP = 17829888, O_CONVS = 18354176, O_GLAS = 18419712, O_SWKS = 20516864, O_SWVS = 21565440, O_END = 22614016;
constexpr size_t MiB = 1u << 20;
constexpr size_t WS_CTL = 0, CTL_ZERO_BYTES = 1 * MiB;
constexpr size_t WS_WIN = 2 * MiB, WIN_L = (size_t)PN * DM * 2;
constexpr size_t WS_WOUT = 50 * MiB, WOUT_L = (size_t)DM * DM * 2;
constexpr size_t WS_WMEM = 66 * MiB;
constexpr size_t WS_XB = 74 * MiB;
constexpr size_t WS_PROJ = 106 * MiB;
constexpr size_t WS_MIX = 202 * MiB;
constexpr size_t WS_GLAKV = 234 * MiB;
constexpr size_t WS_GLAST = 250 * MiB;
constexpr size_t WS_GLADEC = 258 * MiB;
constexpr size_t WS_MEMKV = 259 * MiB;
constexpr size_t WS_MEMA = 263 * MiB;
constexpr size_t WS_XS = 265 * MiB;
constexpr size_t WS_PROJS = 266 * MiB;
constexpr size_t WS_MIXS = 268 * MiB;
constexpr size_t WS_END = 270 * MiB;
constexpr int CW_BAR = 4096;
constexpr int CW_SSP = 65536;
constexpr int CW_SSS = CW_SSP + 2 * 8192;
constexpr int CW_SSM = CW_SSS + 2 * 128;
static_assert((CW_SSM + 512) * 4 <= (int)CTL_ZERO_BYTES, "ctl");

constexpr int NWAVES = 8, NTHREADS = 512;
constexpr int LDS_BYTES = 147456, MISC_OFF = 143360;

__device__ __forceinline__ float bflo(unsigned u) { return __uint_as_float(u << 16); }
__device__ __forceinline__ float bfhi(unsigned u) { return __uint_as_float(u & 0xffff0000u); }
__device__ __forceinline__ float bf1(bf16_t h) { return __uint_as_float((unsigned)h << 16); }
__device__ __forceinline__ unsigned f2bf(float f) { unsigned u = __float_as_uint(f); return (u + 0x7fffu + ((u >> 16) & 1u)) >> 16; }
__device__ __forceinline__ unsigned pk2(float lo, float hi) { return f2bf(lo) | (f2bf(hi) << 16); }
__device__ __forceinline__ void unpack8(const u32x4 r, float* f) { f[0] = bflo(r.x); f[1] = bfhi(r.x); f[2] = bflo(r.y); f[3] = bfhi(r.y); f[4] = bflo(r.z); f[5] = bfhi(r.z); f[6] = bflo(r.w); f[7] = bfhi(r.w); }
__device__ __forceinline__ u32x4 pack8(const float* f) { u32x4 r; r.x = pk2(f[0], f[1]); r.y = pk2(f[2], f[3]); r.z = pk2(f[4], f[5]); r.w = pk2(f[6], f[7]); return r; }
__device__ __forceinline__ float siluf(float x) { return x / (1.f + __expf(-x)); }
__device__ __forceinline__ float logsigf(float x) { return fminf(x, 0.f) - log1pf(__expf(-fabsf(x))); }
__device__ __forceinline__ float wave_sum(float v) {
#pragma unroll
    for (int o = 1; o < 64; o <<= 1) v += __shfl_xor(v, o);
    return v;
}
#define LDS_WAIT() asm volatile("s_waitcnt lgkmcnt(0)" ::: "memory")
__device__ __forceinline__ s16x4 tr4(const LAS unsigned char* base, int pitchB, int r0, int c0, int li) {
    const LAS unsigned char* p = base + (r0 + (li >> 2)) * pitchB + (c0 + 4 * (li & 3)) * 2;
    return __builtin_bit_cast(s16x4, __builtin_amdgcn_ds_read_tr16_b64_v4i16((LAS v4i16_t*)p));
}
__device__ __forceinline__ bf16x8 cat8(s16x4 a, s16x4 b) { return (bf16x8){a[0], a[1], a[2], a[3], b[0], b[1], b[2], b[3]}; }
__device__ __forceinline__ bf16x8 pk8f(f32x4 a, f32x4 b) { u32x4 r; r.x = pk2(a[0], a[1]); r.y = pk2(a[2], a[3]); r.z = pk2(b[0], b[1]); r.w = pk2(b[2], b[3]); return __builtin_bit_cast(bf16x8, r); }
#define MFMA16(a, b, c) __builtin_amdgcn_mfma_f32_16x16x32_bf16((a), (b), (c), 0, 0, 0)

namespace pg8 {
#define PG8_LAS __attribute__((address_space(3)))
constexpr int BM = 256, BK = 64, HALF = 128, HTB = HALF * BK * 2, STAGE_BYTES = 8 * HTB, NXCD = 8, WGM = 8;
__host__ __device__ __forceinline__ int lds_byte(int r, int c) { const int st = (r >> 4) * 2 + (c >> 5), rr = r & 15, cc = c & 31, ob = rr * 64 + cc * 2; return st * 1024 + (ob ^ (((ob >> 9) & 1) << 5)); }
__host__ __device__ __forceinline__ void stage_rc(int b, int& R, int& C) { const int st = b / 1024, sb = b % 1024, swz = sb ^ (((sb >> 9) & 1) << 5); R = (st >> 1) * 16 + swz / 64; C = (st & 1) * 32 + (swz % 64) / 2; }
__host__ __device__ __forceinline__ int perm32(int rho) { const int n = rho >> 4, i = rho & 15; return 8 * (i >> 2) + 4 * n + (i & 3); }
struct Unit { int pm, pn; };
struct Gemm { const bf16_t* A; const bf16_t* Bt; int M, N, K; };
struct StaticOrder {
    int nM, nN, nwg, G, c;
    __host__ __device__ void init(int M, int N, int G_, int c_) { nM = M / BM; nN = N / BM; nwg = nM * nN; G = G_; c = c_; }
    __host__ __device__ bool next(int i, Unit& u) const {
        const long L = (long)i * G + c; if (L >= nwg) return false;
        int wgid = (int)L; { const int q = nwg / NXCD, r = nwg % NXCD, xcd = wgid % NXCD, off = wgid / NXCD; wgid = (xcd < r ? xcd * (q + 1) : r * (q + 1) + (xcd - r) * q) + off; }
        const int nig = WGM * nN, gid = wgid / nig, fm = gid * WGM, gsz = (nM - fm) < WGM ? (nM - fm) : WGM;
        u.pm = fm + ((wgid % nig) % gsz); u.pn = (wgid % nig) / gsz; return true;
    }
    __device__ __forceinline__ void a_ready(const Unit&) const {}
    __device__ __forceinline__ void done(const Unit&) const {}
};
__device__ __forceinline__ unsigned cvt_pk_bf16(float lo, float hi) { unsigned r; asm volatile("v_cvt_pk_bf16_f32 %0, %1, %2" : "=v"(r) : "v"(lo), "v"(hi)); return r; }

struct EpiProj {
    static constexpr bool PERM = true, AFTER_DRAIN = false;
    bf16_t* O; int ldc; const float* ss;
    __device__ __forceinline__ void operator()(const f32x4 (&acc)[2][2][4][2], const Unit& u, int wr, int wc, int fr, int fq) const {
        const int row0 = u.pm * BM + wr * 64 + fr, col0 = u.pn * BM + wc * 32 + 8 * fq;
#pragma unroll
        for (int ai = 0; ai < 2; ++ai)
#pragma unroll
            for (int m = 0; m < 4; ++m) { const int row = row0 + ai * HALF + m * 16; const float sc = rsqrtf(ss[row] * (1.0f / DM) + EPS);
                bf16_t* rowp = O + (size_t)row * ldc + col0;
#pragma unroll
                for (int bj = 0; bj < 2; ++bj) { const f32x4 v0 = acc[ai][bj][m][0] * sc, v1 = acc[ai][bj][m][1] * sc;
                    u32x4 w; w.x = cvt_pk_bf16(v0[0], v0[1]); w.y = cvt_pk_bf16(v0[2], v0[3]); w.z = cvt_pk_bf16(v1[0], v1[1]); w.w = cvt_pk_bf16(v1[2], v1[3]);
                    *(u32x4*)(rowp + bj * HALF) = w; } }
    }
};
struct EpiOut {
    static constexpr bool PERM = false, AFTER_DRAIN = false;
    const float* base; float* out; bf16_t* xb; float* ssn;
    __device__ __forceinline__ void operator()(const f32x4 (&acc)[2][2][4][2], const Unit& u, int wr, int wc, int fr, int fq) const {
        const int row0 = u.pm * BM + wr * 64 + fr, col0 = u.pn * BM + wc * 32 + 4 * fq;
#pragma unroll
        for (int ai = 0; ai < 2; ++ai)
#pragma unroll
            for (int m = 0; m < 4; ++m) { const int row = row0 + ai * HALF + m * 16; const size_t off = (size_t)row * DM + col0; float s = 0.f;
#pragma unroll
                for (int bj = 0; bj < 2; ++bj)
#pragma unroll
                    for (int n = 0; n < 2; ++n) { const size_t o2 = off + bj * HALF + n * 16; const f32x4 y = *(const f32x4*)(base + o2) + acc[ai][bj][m][n];
                        *(f32x4*)(out + o2) = y;
                        if (xb) { u32x2 w; w.x = cvt_pk_bf16(y[0], y[1]); w.y = cvt_pk_bf16(y[2], y[3]); *(u32x2*)(xb + o2) = w; s += (y[0] * y[0] + y[1] * y[1]) + (y[2] * y[2] + y[3] * y[3]); } }
                if (xb) { s += __shfl_xor(s, 16); s += __shfl_xor(s, 32); if (fq == 0) atomicAdd(ssn + row, s); } }
    }
};

template <class Epi, class Sched, bool ALIGN_EPI = false, bool SP2 = false>
__device__ __forceinline__ void gemm_phase(PG8_LAS unsigned char* lds, const Gemm g, const Sched& S, const Epi& E) {
    int tid_ = threadIdx.x; asm volatile("" : "+v"(tid_));
    const int tid = tid_, wid = __builtin_amdgcn_readfirstlane(tid >> 6), lane = tid & 63, wr = wid >> 2, wc = wid & 3, fr = lane & 15, fq = lane >> 4;
    const int K = g.K, nt = K / BK;
    unsigned voffA[2], voffB[2];
#pragma unroll
    for (int i = 0; i < 2; ++i) { int R, C; stage_rc(tid * 16 + i * 8192, R, C); const int Rb = Epi::PERM ? ((R & ~31) + perm32(R & 31)) : R;
        voffA[i] = (unsigned)(R * K + C) * 2u; voffB[i] = (unsigned)(Rb * K + C) * 2u; }
    const size_t kstep = (size_t)(BK * 2);
    const size_t hstep = (size_t)HALF * K * 2;
    const size_t tstep = 2 * hstep;
    const unsigned ldsw = (unsigned)wid * 1024u;
    const int aoff = lds_byte(wr * 64 + fr, fq * 8), boff = lds_byte(wc * 32 + fr, fq * 8);
#define PG8_SA(b, h) (((b) * 2 + (h)) * HTB)
#define PG8_SB(b, h) ((4 + (b) * 2 + (h)) * HTB)
#define PG8_STAGE(bufoff, gbase, voff) do { _Pragma("unroll") for (int _i = 0; _i < 2; ++_i) { unsigned _vo = (voff)[_i]; asm volatile("" : "+v"(_vo)); \
        __builtin_amdgcn_global_load_lds((const unsigned*)((const char*)(gbase) + _vo), (PG8_LAS unsigned*)(lds + (bufoff) + ldsw + _i * 8192), 16, 0, 0); } } while (0)
#define PG8_LDA(dst, b, h) do { _Pragma("unroll") for (int m = 0; m < 4; ++m) _Pragma("unroll") for (int k = 0; k < 2; ++k) dst[m][k] = *(const PG8_LAS bf16x8*)(lds + PG8_SA(b, h) + aoff + m * 2048 + k * 1024); } while (0)
#define PG8_LDB(dst, b, h) do { _Pragma("unroll") for (int n = 0; n < 2; ++n) _Pragma("unroll") for (int k = 0; k < 2; ++k) dst[n][k] = *(const PG8_LAS bf16x8*)(lds + PG8_SB(b, h) + boff + n * 2048 + k * 1024); } while (0)
#define PG8_MMA(ai, bj, At, Bt) do { __builtin_amdgcn_s_setprio(1); _Pragma("unroll") for (int m = 0; m < 4; ++m) _Pragma("unroll") for (int n = 0; n < 2; ++n) _Pragma("unroll") for (int k = 0; k < 2; ++k) \
        acc[ai][bj][m][n] = __builtin_amdgcn_mfma_f32_16x16x32_bf16(Bt[n][k], At[m][k], acc[ai][bj][m][n], 0, 0, 0); __builtin_amdgcn_s_setprio(0); } while (0)
#define PG8_WAIT_V(n) asm volatile("s_waitcnt vmcnt(" #n ")" ::: "memory")
#define PG8_WAIT_L(n) asm volatile("s_waitcnt lgkmcnt(" #n ")" ::: "memory")
#define PG8_BAR __builtin_amdgcn_s_barrier()
#define PG8_SCHED __builtin_amdgcn_sched_barrier(0)
    Unit cur, nxt; int ui = 0;
    if (!S.next(0, cur)) return;
    f32x4 acc[2][2][4][2];
#pragma unroll
    for (int a = 0; a < 2; ++a)
#pragma unroll
        for (int b = 0; b < 2; ++b)
#pragma unroll
            for (int m = 0; m < 4; ++m)
#pragma unroll
                for (int n = 0; n < 2; ++n) acc[a][b][m][n] = (f32x4){0.f, 0.f, 0.f, 0.f};
    bf16x8 At[4][2], B0[2][2], B1[2][2];
    const char* cA = (const char*)g.A + (size_t)cur.pm * tstep; const char* cB = (const char*)g.Bt + (size_t)cur.pn * tstep;
    S.a_ready(cur);
    if constexpr (SP2) {
        PG8_STAGE(PG8_SB(0, 0), cB, voffB); PG8_STAGE(PG8_SB(0, 1), cB + hstep, voffB); PG8_STAGE(PG8_SA(0, 0), cA, voffA); PG8_STAGE(PG8_SA(0, 1), cA + hstep, voffA);
        if (wr == 1) PG8_BAR;
        PG8_WAIT_V(2); PG8_BAR;
        PG8_STAGE(PG8_SB(1, 0), cB + kstep, voffB); PG8_STAGE(PG8_SA(1, 0), cA + kstep, voffA); PG8_STAGE(PG8_SB(1, 1), cB + hstep + kstep, voffB);
        PG8_WAIT_V(6); PG8_BAR;
    } else {
        PG8_STAGE(PG8_SB(0, 0), cB, voffB); PG8_STAGE(PG8_SA(0, 0), cA, voffA); PG8_STAGE(PG8_SB(0, 1), cB + hstep, voffB); PG8_STAGE(PG8_SA(0, 1), cA + hstep, voffA);
        if (wr == 1) PG8_BAR;
        PG8_WAIT_V(4); PG8_BAR;
        PG8_STAGE(PG8_SB(1, 0), cB + kstep, voffB); PG8_STAGE(PG8_SA(1, 0), cA + kstep, voffA); PG8_STAGE(PG8_SB(1, 1), cB + hstep + kstep, voffB);
        PG8_WAIT_V(6); PG8_BAR;
    }
    for (;;) {
        const bool has_next = S.next(ui + 1, nxt);
        const char* nA = has_next ? (const char*)g.A + (size_t)nxt.pm * tstep : cA; const char* nB = has_next ? (const char*)g.Bt + (size_t)nxt.pn * tstep : cB;
        for (int t = 0; t < nt; t += 2) {
            const bool last = (t == nt - 2);
            const char* a1 = cA + (size_t)(t + 1) * kstep;
            const char* a2 = last ? nA : cA + (size_t)(t + 2) * kstep; const char* b2 = last ? nB : cB + (size_t)(t + 2) * kstep;
            const char* a3 = a2 + kstep; const char* b3 = b2 + kstep;
            if (last && has_next) S.a_ready(nxt);
            if constexpr (SP2) {
            PG8_LDB(B0, 0, 0); PG8_LDB(B1, 0, 1); PG8_SCHED; PG8_LDA(At, 0, 0); PG8_STAGE(PG8_SA(1, 1), a1 + hstep, voffA);
            PG8_WAIT_V(8); PG8_WAIT_L(0); PG8_BAR; PG8_MMA(0, 0, At, B0); PG8_MMA(0, 1, At, B1); PG8_BAR; PG8_SCHED;
            PG8_LDA(At, 0, 1); PG8_STAGE(PG8_SB(0, 0), b2, voffB); PG8_STAGE(PG8_SB(0, 1), b2 + hstep, voffB); PG8_STAGE(PG8_SA(0, 0), a2, voffA);
            PG8_WAIT_V(8); PG8_WAIT_L(0); PG8_BAR; PG8_MMA(1, 0, At, B0); PG8_MMA(1, 1, At, B1); PG8_BAR; PG8_SCHED;
            PG8_LDB(B0, 1, 0); PG8_LDB(B1, 1, 1); PG8_SCHED; PG8_LDA(At, 1, 0); PG8_STAGE(PG8_SA(0, 1), a2 + hstep, voffA);
            PG8_WAIT_V(8); PG8_WAIT_L(0); PG8_BAR; PG8_MMA(0, 0, At, B0); PG8_MMA(0, 1, At, B1); PG8_BAR; PG8_SCHED;
            PG8_LDA(At, 1, 1); PG8_STAGE(PG8_SB(1, 0), b3, voffB); PG8_STAGE(PG8_SB(1, 1), b3 + hstep, voffB); PG8_STAGE(PG8_SA(1, 0), a3, voffA);
            PG8_WAIT_V(8); PG8_WAIT_L(0); PG8_BAR; PG8_MMA(1, 0, At, B0); PG8_MMA(1, 1, At, B1); PG8_BAR; PG8_SCHED;
            } else {
            PG8_LDB(B0, 0, 0); PG8_SCHED; PG8_LDA(At, 0, 0); PG8_STAGE(PG8_SA(1, 1), a1 + hstep, voffA);
            PG8_WAIT_L(8); PG8_BAR; PG8_WAIT_L(0); PG8_MMA(0, 0, At, B0); PG8_BAR; PG8_SCHED;
            PG8_LDB(B1, 0, 1); PG8_STAGE(PG8_SB(0, 0), b2, voffB);
            PG8_BAR; PG8_WAIT_L(0); PG8_MMA(0, 1, At, B1); PG8_BAR;
            PG8_LDA(At, 0, 1); PG8_STAGE(PG8_SA(0, 0), a2, voffA);
            PG8_BAR; PG8_WAIT_L(0); PG8_MMA(1, 0, At, B0); PG8_BAR; PG8_SCHED;
            PG8_STAGE(PG8_SB(0, 1), b2 + hstep, voffB);
            PG8_WAIT_V(6); PG8_BAR; PG8_MMA(1, 1, At, B1); PG8_BAR;
            PG8_LDB(B0, 1, 0); PG8_SCHED; PG8_LDA(At, 1, 0); PG8_STAGE(PG8_SA(0, 1), a2 + hstep, voffA);
            PG8_WAIT_L(8); PG8_BAR; PG8_WAIT_L(0); PG8_MMA(0, 0, At, B0); PG8_BAR; PG8_SCHED;
            PG8_LDB(B1, 1, 1); PG8_STAGE(PG8_SB(1, 0), b3, voffB);
            PG8_BAR; PG8_WAIT_L(0); PG8_MMA(0, 1, At, B1); PG8_BAR;
            PG8_LDA(At, 1, 1); PG8_STAGE(PG8_SA(1, 0), a3, voffA);
            PG8_BAR; PG8_WAIT_L(0); PG8_MMA(1, 0, At, B0); PG8_BAR; PG8_SCHED;
            PG8_STAGE(PG8_SB(1, 1), b3 + hstep, voffB);
            PG8_WAIT_V(6); PG8_BAR; PG8_MMA(1, 1, At, B1); PG8_BAR;
            }
        }
        if constexpr (ALIGN_EPI) { if (wr == 0) PG8_BAR; }
        if constexpr (!Epi::AFTER_DRAIN) { E(acc, cur, wr, wc, fr, fq); S.done(cur); }
        if (!has_next) break;
#pragma unroll
        for (int a = 0; a < 2; ++a)
#pragma unroll
            for (int b = 0; b < 2; ++b)
#pragma unroll
                for (int m = 0; m < 4; ++m)
#pragma unroll
                    for (int n = 0; n < 2; ++n) acc[a][b][m][n] = (f32x4){0.f, 0.f, 0.f, 0.f};
        cur = nxt; cA = nA; cB = nB; ++ui;
        if constexpr (ALIGN_EPI) { if (wr == 1) PG8_BAR; }
    }
    PG8_WAIT_V(0);
    if constexpr (!ALIGN_EPI) { if (wr == 0) PG8_BAR; }
    PG8_BAR;
#undef PG8_SA
#undef PG8_SB
#undef PG8_STAGE
#undef PG8_LDA
#undef PG8_LDB
#undef PG8_MMA
#undef PG8_WAIT_V
#undef PG8_WAIT_L
#undef PG8_BAR
#undef PG8_SCHED
}
}

typedef GAS unsigned gu32;
#define RLX_AGENT __ATOMIC_RELAXED, __HIP_MEMORY_SCOPE_AGENT
#define XB_TMO      128
#define XB_XCNT(j)  (256  + 64 * (j))
#define XB_XSUB(j)  (1280 + 64 * (j))
#define XB_XGEN(j)  (2304 + 64 * (j))
#define XB_TOP      3328
#define XB_TOPGEN   3392
#define XCD_BAR_WORDS 3456
#define XB_SPIN_CAP (1u << 18)
__device__ __forceinline__ unsigned xb_ld(unsigned* p)              { return __hip_atomic_load(p, __ATOMIC_RELAXED, __HIP_MEMORY_SCOPE_AGENT); }
__device__ __forceinline__ unsigned xb_add(unsigned* p, unsigned v) { return __hip_atomic_fetch_add(p, v, __ATOMIC_RELAXED, __HIP_MEMORY_SCOPE_AGENT); }
__device__ __forceinline__ unsigned xb_xcc_id() { return (unsigned)__builtin_amdgcn_s_getreg((3 << 11) | 20) & 0xFu; }
#define XB_SPIN(cond, bar) do { unsigned _sp = 0; while (cond) { __builtin_amdgcn_s_sleep(1); \
    if ((++_sp & 255u) == 0u) { if (xb_ld(&(bar)[XB_TMO])) break; if (_sp > XB_SPIN_CAP) { atomicAdd(&(bar)[XB_TMO], 1u); break; } } } } while (0)
struct XcdBarrier { unsigned* bar; unsigned x; volatile LAS unsigned* st; };
__device__ __forceinline__ XcdBarrier xcd_barrier_post(unsigned* bar, volatile LAS unsigned* st) {
    XcdBarrier b; b.bar = bar; b.x = xb_xcc_id(); b.st = st;
    if (threadIdx.x == 0) (void)xb_add(&bar[XB_XCNT(b.x)], 1u);
    return b;
}
__device__ __forceinline__ void xcd_barrier_complete(unsigned* bar, unsigned x, unsigned& nloc, unsigned& nx) {
    const unsigned G = gridDim.x * gridDim.y * gridDim.z;
    unsigned sum, cnt, mine, sp = 0u;
    for (;;) {
        sum = 0u; cnt = 0u; mine = 0u;
#pragma unroll
        for (unsigned j = 0; j < 16; ++j) { const unsigned c = xb_ld(&bar[XB_XCNT(j)]); sum += c; cnt += (c > 0u) ? 1u : 0u; mine = (j == x) ? c : mine; }
        if (sum == G) break;
        __builtin_amdgcn_s_sleep(1);
        if ((++sp & 255u) == 0u) { if (xb_ld(&bar[XB_TMO])) break; if (sp > XB_SPIN_CAP) { atomicAdd(&bar[XB_TMO], 1u); break; } }
    }
    nloc = mine > 0u ? mine : 1u; nx = cnt > 0u ? cnt : 1u;
}
__device__ __forceinline__ void xcd_barrier(const XcdBarrier& b) {
    asm volatile("s_waitcnt vmcnt(0)" ::: "memory");
    __syncthreads();
    if (threadIdx.x == 0) {
        unsigned* bar = b.bar;
        __builtin_amdgcn_s_waitcnt(0);
        unsigned nloc = b.st[0], nx = b.st[1];
        if (nloc == 0u) { xcd_barrier_complete(bar, b.x, nloc, nx); b.st[0] = nloc; b.st[1] = nx; }
        const unsigned old = xb_add(&bar[XB_XSUB(b.x)], 1u);
        const unsigned gen = old / nloc;
        if (old + 1u == (gen + 1u) * nloc) {
            __builtin_amdgcn_fence(__ATOMIC_RELEASE, "agent");
            asm volatile("s_waitcnt vmcnt(0)" ::: "memory");
            const unsigned og = xb_add(&bar[XB_TOP], 1u);
            const unsigned tg = og / nx;
            if (og + 1u == (tg + 1u) * nx) xb_add(&bar[XB_TOPGEN], 1u);
            else XB_SPIN(xb_ld(&bar[XB_TOPGEN]) == tg, bar);
            __builtin_amdgcn_fence(__ATOMIC_ACQUIRE, "agent");
            xb_add(&bar[XB_XGEN(b.x)], 1u);
            asm volatile("s_waitcnt vmcnt(0)" ::: "memory");
        } else {
            XB_SPIN(xb_ld(&bar[XB_XGEN(b.x)]) == gen, bar);
            __builtin_amdgcn_fence(__ATOMIC_ACQUIRE, "agent");
            asm volatile("s_waitcnt vmcnt(0)" ::: "memory");
        }
    }
    __syncthreads();
}

struct Args { const float* in[23]; float* out; unsigned char* ws; int ph_lo, ph_hi; };
struct Ctx {
    LAS unsigned char* lds; int tid, lane, wave, G, bid;
    const Args* a; float* out; unsigned char* ws; float* ctlf;
};
#define IN_XP 0
#define IN_XS 1
#define IN_MEM 2
#define IN_SCONV 3
#define IN_SGLA 4
#define IN_CSWK 5
#define IN_CSWV 6
#define IN_CMK 7
#define IN_CMV 8
#define IN_GNORM 9
#define IN_WIN 10
#define IN_CONVW 11
#define IN_WUP 12
#define IN_BA 13
#define IN_GGLAO 14
#define IN_GSWQ 15
#define IN_GSWK 16
#define IN_SINKS 17
#define IN_GMEM 18
#define IN_WMEM 19
#define IN_GMEMQ 20
#define IN_GMEMK 21
#define IN_WOUT 22

__device__ __forceinline__ void p0_transpose_item(const float* W, const float* gk, int K, int N, bf16_t* WT, LAS float* scr, int kb, int nb, int lane) {
    const int k0 = 64 * kb, n0 = 32 * nb, nn = n0 + (lane & 31); const bool ok = nn < N;
#pragma unroll 8
    for (int i = 0; i < 32; ++i) { const int kk = 2 * i + (lane >> 5); float w = ok ? W[(size_t)(k0 + kk) * N + nn] : 0.f; if (gk) w *= gk[k0 + kk]; scr[kk * 33 + (lane & 31)] = w; }
    LDS_WAIT(); asm volatile("" ::: "memory");
    const int c = lane & 7;
#pragma unroll
    for (int j = 0; j < 4; ++j) { const int n = (lane >> 3) + 8 * j; const LAS float* s = scr + (8 * c) * 33 + n;
        u32x4 o; o.x = pk2(s[0 * 33], s[1 * 33]); o.y = pk2(s[2 * 33], s[3 * 33]); o.z = pk2(s[4 * 33], s[5 * 33]); o.w = pk2(s[6 * 33], s[7 * 33]);
        if (n0 + n < N) *(u32x4*)(WT + (size_t)(n0 + n) * K + k0 + 8 * c) = o; }
    LDS_WAIT(); asm volatile("" ::: "memory");
}
__device__ __forceinline__ void row_to_bf16(const float* xrow, bf16_t* orow, float* ss, int lane) {
    const f32x4* xr = (const f32x4*)xrow + lane; f32x4 v[8]; float s = 0.f;
#pragma unroll
    for (int j = 0; j < 8; ++j) { v[j] = xr[64 * j]; s += (v[j].x * v[j].x + v[j].y * v[j].y) + (v[j].z * v[j].z + v[j].w * v[j].w); }
    s = wave_sum(s);
    u32x2* o8 = (u32x2*)orow + lane;
#pragma unroll
    for (int j = 0; j < 8; ++j) { u32x2 w; w.x = pk2(v[j].x, v[j].y); w.y = pk2(v[j].z, v[j].w); o8[64 * j] = w; }
    if (lane == 0) *ss = s;
}
__device__ __forceinline__ void p0_prologue(Ctx& F) {
    LAS float* scr = (LAS float*)(F.lds + F.wave * 16384);
    const int gw = F.bid * NWAVES + F.wave, NGW = F.G * NWAVES;
    constexpr int T_IN = 2 * 32 * 185, T_OUT = 2 * 32 * 64, T_MEM = 2 * 32 * 32, T_ZP = 2 * 240, T_XP = NP, T_XS = NS, T_M = NMEMROWS;
    constexpr int NIT = T_IN + T_OUT + T_MEM + T_ZP + T_XP + T_XS + T_M;
    for (int it = gw; it < NIT; it += NGW) {
        int r = it;
        if (r < T_IN) { const int l = r / (32 * 185), q = r % (32 * 185);
            p0_transpose_item(F.a->in[IN_WIN] + (size_t)l * DM * DIN, F.a->in[IN_GNORM] + l * DM, DM, DIN, (bf16_t*)(F.ws + WS_WIN + l * WIN_L), scr, q / 185, q % 185, F.lane); continue; }
        r -= T_IN;
        if (r < T_OUT) { const int l = r / 2048, q = r % 2048;
            p0_transpose_item(F.a->in[IN_WOUT] + (size_t)l * DM * DM, nullptr, DM, DM, (bf16_t*)(F.ws + WS_WOUT + l * WOUT_L), scr, q / 64, q % 64, F.lane); continue; }
        r -= T_OUT;
        if (r < T_MEM) { const int l = r / 1024, q = r % 1024;
            p0_transpose_item(F.a->in[IN_WMEM] + (size_t)l * DM * 1024, F.a->in[IN_GMEM] + l * DM, DM, 1024, (bf16_t*)(F.ws + WS_WMEM) + (size_t)l * 1024 * DM, scr, q / 32, q % 32, F.lane); continue; }
        r -= T_MEM;
        if (r < T_ZP) { const int l = r / 240, n = DIN + r % 240; u32x4* p = (u32x4*)((bf16_t*)(F.ws + WS_WIN + l * WIN_L) + (size_t)n * DM) + F.lane;
#pragma unroll
            for (int j = 0; j < 4; ++j) p[64 * j] = (u32x4){0u, 0u, 0u, 0u};
            continue; }
        r -= T_ZP;
        if (r < T_XP) { row_to_bf16(F.a->in[IN_XP] + (size_t)r * DM, (bf16_t*)(F.ws + WS_XB) + (size_t)r * DM, F.ctlf + CW_SSP + r, F.lane); continue; }
        r -= T_XP;
        if (r < T_XS) { row_to_bf16(F.a->in[IN_XS] + (size_t)r * DM, (bf16_t*)(F.ws + WS_XS) + (size_t)r * DM, F.ctlf + CW_SSS + r, F.lane); continue; }
        r -= T_XS;
        row_to_bf16(F.a->in[IN_MEM] + (size_t)r * DM, (bf16_t*)(F.ws + WS_MEMA) + (size_t)r * DM, F.ctlf + CW_SSM + r, F.lane);
    }
}

template <class Epi>
__device__ __forceinline__ void sg_unit(Ctx& F, const bf16_t* A, const bf16_t* Bt, const Epi& E) {
    constexpr int PA = 144, BUF = 27648, BOFF = 18432;
    LAS unsigned char* lds = F.lds;
    const int tid = F.tid, r = tid >> 3, ch = tid & 7, fr = F.lane & 15, fq = F.lane >> 4, wm = F.wave & 3, wn = F.wave >> 2;
    const u32x4* ga0 = (const u32x4*)(A + (size_t)r * DM + ch * 8);
    const u32x4* ga1 = (const u32x4*)(A + (size_t)(r + 64) * DM + ch * 8);
    const u32x4* gb = (const u32x4*)(Bt + (size_t)r * DM + ch * 8);
    f32x4 acc[2][2];
#pragma unroll
    for (int a = 0; a < 2; ++a)
#pragma unroll
        for (int b = 0; b < 2; ++b) acc[a][b] = (f32x4){0.f, 0.f, 0.f, 0.f};
    __syncthreads();
    u32x4 ra0 = ga0[0], ra1 = ga1[0], rb = gb[0];
    *(LAS u32x4*)(lds + r * PA + ch * 16) = ra0; *(LAS u32x4*)(lds + (r + 64) * PA + ch * 16) = ra1; *(LAS u32x4*)(lds + BOFF + r * PA + ch * 16) = rb;
    __syncthreads();
    for (int t = 0; t < 32; ++t) {
        const int cb = (t & 1) * BUF, nb = ((t + 1) & 1) * BUF;
        if (t + 1 < 32) { ra0 = ga0[(t + 1) * 8]; ra1 = ga1[(t + 1) * 8]; rb = gb[(t + 1) * 8]; }
#pragma unroll
        for (int ks = 0; ks < 2; ++ks) {
            bf16x8 Af[2], Bf[2];
#pragma unroll
            for (int i = 0; i < 2; ++i) { Af[i] = *(const LAS bf16x8*)(lds + cb + (32 * wm + 16 * i + fr) * PA + (ks * 32 + 8 * fq) * 2);
                                          Bf[i] = *(const LAS bf16x8*)(lds + cb + BOFF + (32 * wn + 16 * i + fr) * PA + (ks * 32 + 8 * fq) * 2); }
#pragma unroll
            for (int mi = 0; mi < 2; ++mi)
#pragma unroll
                for (int ni = 0; ni < 2; ++ni) acc[mi][ni] = MFMA16(Bf[ni], Af[mi], acc[mi][ni]);
        }
        if (t + 1 < 32) { *(LAS u32x4*)(lds + nb + r * PA + ch * 16) = ra0; *(LAS u32x4*)(lds + nb + (r + 64) * PA + ch * 16) = ra1; *(LAS u32x4*)(lds + nb + BOFF + r * PA + ch * 16) = rb; }
        __syncthreads();
    }
#pragma unroll
    for (int mi = 0; mi < 2; ++mi)
#pragma unroll
        for (int ni = 0; ni < 2; ++ni) E(acc[mi][ni], 32 * wm + 16 * mi + fr, 32 * wn + 16 * ni + 4 * fq);
}
struct SgEpiBf16 { bf16_t* O; int ldc; const float* ss;
    __device__ __forceinline__ void operator()(const f32x4 a, int row, int col) const { const float sc = rsqrtf(ss[row] * (1.0f / DM) + EPS);
        u32x2 w; w.x = pk2(a[0] * sc, a[1] * sc); w.y = pk2(a[2] * sc, a[3] * sc); *(u32x2*)(O + (size_t)row * ldc + col) = w; } };
struct SgEpiF32 { float* O; int ldc; const float* ss;
    __device__ __forceinline__ void operator()(const f32x4 a, int row, int col) const { const float sc = rsqrtf(ss[row] * (1.0f / DM) + EPS); *(f32x4*)(O + (size_t)row * ldc + col) = a * sc; } };
struct SgEpiOut { const float* base; float* out; bf16_t* xb; float* ssn;
    __device__ __forceinline__ void operator()(const f32x4 a, int row, int col) const { const size_t o = (size_t)row * DM + col; const f32x4 y = *(const f32x4*)(base + o) + a; *(f32x4*)(out + o) = y;
        if (xb) { u32x2 w; w.x = pk2(y[0], y[1]); w.y = pk2(y[2], y[3]); *(u32x2*)(xb + o) = w; atomicAdd(ssn + row, (y[0] * y[0] + y[1] * y[1]) + (y[2] * y[2] + y[3] * y[3])); } } };

__device__ __forceinline__ void conv_unit(Ctx& F, int l, int cu) {
    const bf16_t* proj = (const bf16_t*)(F.ws + WS_PROJ); bf16_t* mix = (bf16_t*)(F.ws + WS_MIX);
    const int R0 = cu * 64, b = R0 >> 12, t0 = R0 & 4095, tg = F.tid >> 6, c8 = (F.tid & 63) * 8, ts = t0 + tg * 8;
    const float* cw = F.a->in[IN_CONVW] + l * 3 * 512;
    float w0[8], w1[8], w2[8], um2[8], um1[8];
#pragma unroll
    for (int j = 0; j < 8; ++j) { w0[j] = cw[c8 + j]; w1[j] = cw[512 + c8 + j]; w2[j] = cw[1024 + c8 + j]; um2[j] = 0.f; um1[j] = 0.f; }
    if (ts >= 2) {
        float a[8], h[8];
        const bf16_t* p2 = proj + (size_t)(b * SEQ + ts - 2) * PN;
        unpack8(*(const u32x4*)(p2 + C_AC + c8), a); unpack8(*(const u32x4*)(p2 + C_AH + c8), h);
#pragma unroll
        for (int j = 0; j < 8; ++j) um2[j] = a[j] * h[j];
        unpack8(*(const u32x4*)(p2 + PN + C_AC + c8), a); unpack8(*(const u32x4*)(p2 + PN + C_AH + c8), h);
#pragma unroll
        for (int j = 0; j < 8; ++j) um1[j] = a[j] * h[j];
    }
    for (int i = 0; i < 8; ++i) {
        const int t = ts + i; const size_t row = (size_t)(b * SEQ + t); const bf16_t* p = proj + row * PN;
        float a[8], h[8], ab[8], az[8], u[8], y[8];
        unpack8(*(const u32x4*)(p + C_AC + c8), a); unpack8(*(const u32x4*)(p + C_AH + c8), h); unpack8(*(const u32x4*)(p + C_AB + c8), ab); unpack8(*(const u32x4*)(p + C_AZ + c8), az);
#pragma unroll
        for (int j = 0; j < 8; ++j) { u[j] = a[j] * h[j]; const float o = w0[j] * um2[j] + w1[j] * um1[j] + w2[j] * u[j]; y[j] = ab[j] * o * siluf(az[j]); um2[j] = um1[j]; um1[j] = u[j]; }
        *(u32x4*)(mix + row * DM + c8) = pack8(y);
        if (t >= SEQ - 2) { float* o = F.out + O_CONVP + ((size_t)(l * 2 + b) * 2 + (t - (SEQ - 2))) * 512 + c8;
#pragma unroll
            for (int j = 0; j < 8; ++j) o[j] = u[j]; }
    }
}

__device__ __forceinline__ void swa_unit(Ctx& F, int l, int un) {
    constexpr int PK = 144, VOFF = 256 * PK;
    const bf16_t* proj = (const bf16_t*)(F.ws + WS_PROJ); bf16_t* mix = (bf16_t*)(F.ws + WS_MIX);
    LAS unsigned char* Kl = F.lds; LAS unsigned char* Vl = F.lds + VOFF;
    const int blk = un & 31, h = (un >> 5) & 7, b = un >> 8, kvh = h >> 2, t0 = blk * 128;
    const int fr = F.lane & 15, fq = F.lane >> 4;
    __syncthreads();
    {   const float* gk = F.a->in[IN_GSWK] + l * 64;
        const bool wout = (blk == 31) && ((h & 3) == 0);
#pragma unroll
        for (int i = 0; i < 4; ++i) { const int p = F.tid + 512 * i, kj = p >> 3, ch = p & 7, tok = t0 - 128 + kj;
            u32x4 kraw = (u32x4){0u, 0u, 0u, 0u}, vraw = kraw;
            if (tok >= 0) { const bf16_t* pr = proj + (size_t)(b * SEQ + tok) * PN; kraw = *(const u32x4*)(pr + C_SK + kvh * 64 + ch * 8); vraw = *(const u32x4*)(pr + C_SV + kvh * 64 + ch * 8); }
            float k[8]; unpack8(kraw, k); float ss = 0.f;
#pragma unroll
            for (int j = 0; j < 8; ++j) ss += k[j] * k[j];
            ss += __shfl_xor(ss, 1); ss += __shfl_xor(ss, 2); ss += __shfl_xor(ss, 4);
            const float rs = rsqrtf(ss * (1.f / 64.f) + EPS);
#pragma unroll
            for (int j = 0; j < 8; ++j) k[j] = k[j] * rs * gk[ch * 8 + j];
            *(LAS u32x4*)(Kl + kj * PK + ch * 16) = pack8(k); *(LAS u32x4*)(Vl + kj * PK + ch * 16) = vraw;
            if (wout && kj >= 128) { const size_t o = ((size_t)(l * 2 + b) * 128 + (kj - 128)) * 128 + kvh * 64 + ch * 8; float v[8]; unpack8(vraw, v);
#pragma unroll
                for (int j = 0; j < 8; ++j) { F.out[O_SWKP + o + j] = k[j]; F.out[O_SWVP + o + j] = v[j]; } }
        }
    }
    __syncthreads();
    const int qi = 16 * F.wave + fr; const size_t row = (size_t)(b * SEQ + t0 + qi); const bf16_t* pr = proj + row * PN;
    bf16x8 Qf[2];
    {   const float* gq = F.a->in[IN_GSWQ] + l * 64; float q[2][8]; float ss = 0.f;
#pragma unroll
        for (int ks = 0; ks < 2; ++ks) { unpack8(*(const u32x4*)(pr + C_SQ + h * 64 + ks * 32 + fq * 8), q[ks]);
#pragma unroll
            for (int j = 0; j < 8; ++j) ss += q[ks][j] * q[ks][j]; }
        ss += __shfl_xor(ss, 16); ss += __shfl_xor(ss, 32);
        const float rs = rsqrtf(ss * (1.f / 64.f) + EPS) * 0.125f;
#pragma unroll
        for (int ks = 0; ks < 2; ++ks) {
#pragma unroll
            for (int j = 0; j < 8; ++j) q[ks][j] = q[ks][j] * rs * gq[ks * 32 + fq * 8 + j];
            Qf[ks] = __builtin_bit_cast(bf16x8, pack8(q[ks])); }
    }
    const int e = F.wave & ~1;
    f32x4 S[10];
#pragma unroll
    for (int kb = 0; kb < 10; ++kb) { f32x4 a = (f32x4){0.f, 0.f, 0.f, 0.f};
#pragma unroll
        for (int ks = 0; ks < 2; ++ks) { const bf16x8 kf = *(const LAS bf16x8*)(Kl + (16 * (e + kb) + fr) * PK + (ks * 32 + fq * 8) * 2); a = MFMA16(kf, Qf[ks], a); }
        S[kb] = a; }
    const float sink = F.a->in[IN_SINKS][l * 8 + h];
    float m = sink;
#pragma unroll
    for (int kb = 0; kb < 10; ++kb)
#pragma unroll
        for (int i = 0; i < 4; ++i) { const int kj = 16 * (e + kb) + 4 * fq + i; const bool valid = (kj >= qi + 1) && (kj <= qi + 128) && (blk > 0 || kj >= 128);
            if (!valid) S[kb][i] = -INFINITY; m = fmaxf(m, S[kb][i]); }
    m = fmaxf(m, __shfl_xor(m, 16)); m = fmaxf(m, __shfl_xor(m, 32));
    float sum = 0.f;
#pragma unroll
    for (int kb = 0; kb < 10; ++kb)
#pragma unroll
        for (int i = 0; i < 4; ++i) { const float ev = __expf(S[kb][i] - m); S[kb][i] = ev; sum += ev; }
    sum += __shfl_xor(sum, 16); sum += __shfl_xor(sum, 32);
    sum += __expf(sink - m);
    const float inv = 1.f / sum;
    f32x4 o[4];
#pragma unroll
    for (int db = 0; db < 4; ++db) o[db] = (f32x4){0.f, 0.f, 0.f, 0.f};
#pragma unroll
    for (int p = 0; p < 5; ++p) { const bf16x8 Pb = pk8f(S[2 * p] * inv, S[2 * p + 1] * inv);
#pragma unroll
        for (int db = 0; db < 4; ++db) { const bf16x8 Va = cat8(tr4(Vl, PK, 16 * (e + 2 * p) + 4 * fq, 16 * db, fr), tr4(Vl, PK, 16 * (e + 2 * p + 1) + 4 * fq, 16 * db, fr));
            o[db] = MFMA16(Va, Pb, o[db]); } }
#pragma unroll
    for (int db = 0; db < 4; ++db) { const int d = 16 * db + 4 * fq; const u32x2 zr = *(const u32x2*)(pr + C_SZ + h * 64 + d);
        u32x2 w; w.x = pk2(o[db][0] * siluf(bflo(zr.x)), o[db][1] * siluf(bfhi(zr.x))); w.y = pk2(o[db][2] * siluf(bflo(zr.y)), o[db][3] * siluf(bfhi(zr.y)));
        *(u32x2*)(mix + row * DM + 1024 + h * 64 + d) = w; }
}

template <bool SAMPLE>
__device__ __forceinline__ void mem_unit(Ctx& F, int l, int un) {
    constexpr int PK = 272, VOFF = 256 * PK;
    LAS unsigned char* Kl = F.lds; LAS unsigned char* Vl = F.lds + VOFF;
    const int fr = F.lane & 15, fq = F.lane >> 4;
    int b, h, qb;
    if (SAMPLE) { b = un >> 2; h = un & 3; qb = 0; } else { qb = un & 31; h = (un >> 5) & 3; b = un >> 7; }
    __syncthreads();
    {   const int m = F.tid >> 1, half = F.tid & 1;
        const float* ks; const float* vs;
        if (SAMPLE) { ks = F.a->in[IN_CMK] + ((size_t)(l * DB + b) * 256 + m) * 512 + h * 128 + half * 64; vs = F.a->in[IN_CMV] + ((size_t)(l * DB + b) * 256 + m) * 512 + h * 128 + half * 64; }
        else { ks = (const float*)(F.ws + WS_MEMKV) + (size_t)(b * 256 + m) * 2048 + l * 1024 + h * 128 + half * 64; vs = ks + 512; }
        const float* gmk = F.a->in[IN_GMEMK] + l * 128 + half * 64;
        float rs = 1.f;
        if (!SAMPLE) { float ss = 0.f;
#pragma unroll
            for (int j = 0; j < 16; ++j) { const f32x4 v = ((const f32x4*)ks)[j]; ss += (v.x * v.x + v.y * v.y) + (v.z * v.z + v.w * v.w); }
            ss += __shfl_xor(ss, 1); rs = rsqrtf(ss * (1.f / 128.f) + EPS); }
        float* ko = F.out + O_MKP + ((size_t)(l * 2 + b) * 256 + m) * 512 + h * 128 + half * 64;
        float* vo = F.out + O_MVP + ((size_t)(l * 2 + b) * 256 + m) * 512 + h * 128 + half * 64;
#pragma unroll
        for (int j = 0; j < 8; ++j) { f32x4 k0 = ((const f32x4*)ks)[2 * j], k1 = ((const f32x4*)ks)[2 * j + 1]; const f32x4 v0 = ((const f32x4*)vs)[2 * j], v1 = ((const f32x4*)vs)[2 * j + 1];
            if (!SAMPLE) { const f32x4 g0 = ((const f32x4*)gmk)[2 * j], g1 = ((const f32x4*)gmk)[2 * j + 1]; k0 = k0 * rs * g0; k1 = k1 * rs * g1;
                if (qb == 0) { ((f32x4*)ko)[2 * j] = k0; ((f32x4*)ko)[2 * j + 1] = k1; ((f32x4*)vo)[2 * j] = v0; ((f32x4*)vo)[2 * j + 1] = v1; } }
            u32x4 kw, vw; kw.x = pk2(k0.x, k0.y); kw.y = pk2(k0.z, k0.w); kw.z = pk2(k1.x, k1.y); kw.w = pk2(k1.z, k1.w);
            vw.x = pk2(v0.x, v0.y); vw.y = pk2(v0.z, v0.w); vw.z = pk2(v1.x, v1.y); vw.w = pk2(v1.z, v1.w);
            *(LAS u32x4*)(Kl + m * PK + half * 128 + j * 16) = kw; *(LAS u32x4*)(Vl + m * PK + half * 128 + j * 16) = vw; }
    }
    __syncthreads();
    if (SAMPLE && F.wave != 0) return;
    const bf16_t* proj; bf16_t* mix; size_t row;
    if (SAMPLE) { proj = (const bf16_t*)(F.ws + WS_PROJS); mix = (bf16_t*)(F.ws + WS_MIXS); row = (size_t)(b * DS + (fr & 3)); }
    else { proj = (const bf16_t*)(F.ws + WS_PROJ); mix = (bf16_t*)(F.ws + WS_MIX); row = (size_t)(b * SEQ + qb * 128 + 16 * F.wave + fr); }
    const bf16_t* pr = proj + row * PN;
    bf16x8 Qf[4];
    {   const float* gq = F.a->in[IN_GMEMQ] + l * 128; float q[4][8]; float ss = 0.f;
#pragma unroll
        for (int ks = 0; ks < 4; ++ks) { unpack8(*(const u32x4*)(pr + C_MQ + h * 128 + ks * 32 + fq * 8), q[ks]);
#pragma unroll
            for (int j = 0; j < 8; ++j) ss += q[ks][j] * q[ks][j]; }
        ss += __shfl_xor(ss, 16); ss += __shfl_xor(ss, 32);
        const float rs = rsqrtf(ss * (1.f / 128.f) + EPS) * 0.08838834764831845f;
#pragma unroll
        for (int ks = 0; ks < 4; ++ks) {
#pragma unroll
            for (int j = 0; j < 8; ++j) q[ks][j] = q[ks][j] * rs * gq[ks * 32 + fq * 8 + j];
            Qf[ks] = __builtin_bit_cast(bf16x8, pack8(q[ks])); }
    }
    f32x4 S[16];
#pragma unroll
    for (int kb = 0; kb < 16; ++kb) { f32x4 a = (f32x4){0.f, 0.f, 0.f, 0.f};
#pragma unroll
        for (int ks = 0; ks < 4; ++ks) { const bf16x8 kf = *(const LAS bf16x8*)(Kl + (16 * kb + fr) * PK + (ks * 32 + fq * 8) * 2); a = MFMA16(kf, Qf[ks], a); }
        S[kb] = a; }
    float m = -INFINITY;
#pragma unroll
    for (int kb = 0; kb < 16; ++kb)
#pragma unroll
        for (int i = 0; i < 4; ++i) m = fmaxf(m, S[kb][i]);
    m = fmaxf(m, __shfl_xor(m, 16)); m = fmaxf(m, __shfl_xor(m, 32));
    float sum = 0.f;
#pragma unroll
    for (int kb = 0; kb < 16; ++kb)
#pragma unroll
        for (int i = 0; i < 4; ++i) { const float ev = __expf(S[kb][i] - m); S[kb][i] = ev; sum += ev; }
    sum += __shfl_xor(sum, 16); sum += __shfl_xor(sum, 32);
    const float inv = 1.f / sum;
    f32x4 o[8];
#pragma unroll
    for (int db = 0; db < 8; ++db) o[db] = (f32x4){0.f, 0.f, 0.f, 0.f};
#pragma unroll
    for (int p = 0; p < 8; ++p) { const bf16x8 Pb = pk8f(S[2 * p] * inv, S[2 * p + 1] * inv);
#pragma unroll
        for (int db = 0; db < 8; ++db) { const bf16x8 Va = cat8(tr4(Vl, PK, 32 * p + 4 * fq, 16 * db, fr), tr4(Vl, PK, 32 * p + 16 + 4 * fq, 16 * db, fr));
            o[db] = MFMA16(Va, Pb, o[db]); } }
    if (SAMPLE && fr >= 4) return;
#pragma unroll
    for (int db = 0; db < 8; ++db) { const int d = 16 * db + 4 * fq; const u32x2 zr = *(const u32x2*)(pr + C_MZ + h * 128 + d);
        u32x2 w; w.x = pk2(o[db][0] * siluf(bflo(zr.x)), o[db][1] * siluf(bfhi(zr.x))); w.y = pk2(o[db][2] * siluf(bflo(zr.y)), o[db][3] * siluf(bfhi(zr.y)));
        *(u32x2*)(mix + row * DM + 1536 + h * 128 + d) = w; }
}

constexpr int GL_CUM = 0, GL_TOT = 16384, GL_GA = 16640, GL_SEG = 20736, GL_A = 24576;
__device__ __forceinline__ void gla_cum(Ctx& F, int l, int h, const bf16_t* prow0) {
    LAS float* cumL = (LAS float*)(F.lds + GL_CUM); LAS float* totL = (LAS float*)(F.lds + GL_TOT); LAS float* gaL = (LAS float*)(F.lds + GL_GA); LAS float* segL = (LAS float*)(F.lds + GL_SEG);
    if (F.tid < 128) { const int s = F.tid >> 1, hf = F.tid & 1; float g[8]; unpack8(*(const u32x4*)(prow0 + (size_t)s * PN + C_GA + hf * 8), g);
#pragma unroll
        for (int j = 0; j < 8; ++j) gaL[s * 16 + hf * 8 + j] = g[j]; }
    const int dk = F.tid & 63, sg = F.tid >> 6;
    float wu[16];
#pragma unroll
    for (int r = 0; r < 16; ++r) wu[r] = F.a->in[IN_WUP][(size_t)(l * 16 + r) * 256 + h * 64 + dk];
    const float bias = F.a->in[IN_BA][l * 256 + h * 64 + dk];
    __syncthreads();
    float c[8]; float run = 0.f;
#pragma unroll
    for (int i = 0; i < 8; ++i) { const int s = sg * 8 + i; float x = bias;
#pragma unroll
        for (int r = 0; r < 16; ++r) x += gaL[s * 16 + r] * wu[r];
        run += logsigf(x) * (1.f / 16.f); c[i] = run; }
    segL[sg * 64 + dk] = run;
    __syncthreads();
    float off = 0.f, tot = 0.f;
#pragma unroll
    for (int s2 = 0; s2 < 8; ++s2) { const float v = segL[s2 * 64 + dk]; tot += v; if (s2 < sg) off += v; }
#pragma unroll
    for (int i = 0; i < 8; ++i) cumL[(sg * 8 + i) * 64 + dk] = off + c[i];
    if (sg == 0) totL[dk] = tot;
    __syncthreads();
}
__device__ __forceinline__ void glaA_unit(Ctx& F, int l, int un) {
    constexpr int PKT = 144, PV = 272, KT = GL_A, VL = GL_A + 64 * PKT;
    const bf16_t* proj = (const bf16_t*)(F.ws + WS_PROJ);
    const int c = un & 63, h = (un >> 6) & 3, b = un >> 8, fr = F.lane & 15, fq = F.lane >> 4;
    const bf16_t* prow0 = proj + (size_t)(b * SEQ + c * 64) * PN;
    LAS float* cumL = (LAS float*)(F.lds + GL_CUM); LAS float* totL = (LAS float*)(F.lds + GL_TOT);
    __syncthreads();
    gla_cum(F, l, h, prow0);
    {   const int s = F.tid >> 3, ch = F.tid & 7; float k[8]; unpack8(*(const u32x4*)(prow0 + (size_t)s * PN + C_GK + h * 64 + ch * 8), k);
#pragma unroll
        for (int j = 0; j < 8; ++j) k[j] *= __expf(totL[ch * 8 + j] - cumL[s * 64 + ch * 8 + j]);
        *(LAS u32x4*)(F.lds + KT + s * PKT + ch * 16) = pack8(k);
#pragma unroll
        for (int i = 0; i < 2; ++i) { const int p = F.tid + 512 * i, s2 = p >> 4, c2 = p & 15;
            *(LAS u32x4*)(F.lds + VL + s2 * PV + c2 * 16) = *(const u32x4*)(prow0 + (size_t)s2 * PN + C_GV + h * 128 + c2 * 8); }
    }
    __syncthreads();
    f32x4 acc[4];
#pragma unroll
    for (int db = 0; db < 4; ++db) acc[db] = (f32x4){0.f, 0.f, 0.f, 0.f};
#pragma unroll
    for (int ks = 0; ks < 2; ++ks) { const bf16x8 Bv = cat8(tr4(F.lds + VL, PV, 32 * ks + 8 * fq, 16 * F.wave, fr), tr4(F.lds + VL, PV, 32 * ks + 8 * fq + 4, 16 * F.wave, fr));
#pragma unroll
        for (int db = 0; db < 4; ++db) { const bf16x8 Ak = cat8(tr4(F.lds + KT, PKT, 32 * ks + 8 * fq, 16 * db, fr), tr4(F.lds + KT, PKT, 32 * ks + 8 * fq + 4, 16 * db, fr));
            acc[db] = MFMA16(Ak, Bv, acc[db]); } }
    float* kv = (float*)(F.ws + WS_GLAKV) + (size_t)un * 8192;
#pragma unroll
    for (int db = 0; db < 4; ++db)
#pragma unroll
        for (int i = 0; i < 4; ++i) kv[(16 * db + 4 * fq + i) * 128 + 16 * F.wave + fr] = acc[db][i];
    if (F.tid < 64) ((float*)(F.ws + WS_GLADEC))[un * 64 + F.tid] = __expf(totL[F.tid]);
}
__device__ __forceinline__ void gla_scan_item(Ctx& F, int l, int si) {
    const int gid = si * 512 + F.tid, bh = gid >> 13, d = (gid >> 7) & 63, v = gid & 127;
    const float* kv = (const float*)(F.ws + WS_GLAKV) + (size_t)bh * 64 * 8192 + d * 128 + v;
    const float* dec = (const float*)(F.ws + WS_GLADEC) + (size_t)bh * 64 * 64 + d;
    bf16_t* st = (bf16_t*)(F.ws + WS_GLAST) + (size_t)bh * 64 * 8192 + d * 128 + v;
    float S = 0.f;
    for (int c0 = 0; c0 < 64; c0 += 8) {
        float kk[8], dd[8];
#pragma unroll
        for (int i = 0; i < 8; ++i) { kk[i] = kv[(size_t)(c0 + i) * 8192]; dd[i] = dec[(c0 + i) * 64]; }
#pragma unroll
        for (int i = 0; i < 8; ++i) { st[(size_t)(c0 + i) * 8192] = (bf16_t)f2bf(S); S = dd[i] * S + kk[i]; }
    }
    F.out[O_GLAP + ((size_t)(l * 8 + bh) * 64 + d) * 128 + v] = S;
}
__device__ __forceinline__ void glaC_unit(Ctx& F, int l, int un) {
    constexpr int PQ = 144, PV = 272, QD = GL_A, KD = QD + 64 * PQ, VL = KD + 64 * PQ, SL = VL + 64 * PV, SSX = SL + 64 * PV;
    const bf16_t* proj = (const bf16_t*)(F.ws + WS_PROJ); bf16_t* mix = (bf16_t*)(F.ws + WS_MIX);
    const int c = un & 63, h = (un >> 6) & 3, b = un >> 8, fr = F.lane & 15, fq = F.lane >> 4;
    const bf16_t* prow0 = proj + (size_t)(b * SEQ + c * 64) * PN;
    LAS float* cumL = (LAS float*)(F.lds + GL_CUM);
    __syncthreads();
    gla_cum(F, l, h, prow0);
    {   const int s = F.tid >> 3, ch = F.tid & 7; float q[8], k[8];
        unpack8(*(const u32x4*)(prow0 + (size_t)s * PN + C_GQ + h * 64 + ch * 8), q); unpack8(*(const u32x4*)(prow0 + (size_t)s * PN + C_GK + h * 64 + ch * 8), k);
#pragma unroll
        for (int j = 0; j < 8; ++j) { const float cm = cumL[s * 64 + ch * 8 + j]; q[j] *= 0.125f * __expf(cm); k[j] *= __expf(-cm); }
        *(LAS u32x4*)(F.lds + QD + s * PQ + ch * 16) = pack8(q); *(LAS u32x4*)(F.lds + KD + s * PQ + ch * 16) = pack8(k);
        const bf16_t* st = (const bf16_t*)(F.ws + WS_GLAST) + (size_t)un * 8192;
#pragma unroll
        for (int i = 0; i < 2; ++i) { const int p = F.tid + 512 * i, s2 = p >> 4, c2 = p & 15;
            *(LAS u32x4*)(F.lds + VL + s2 * PV + c2 * 16) = *(const u32x4*)(prow0 + (size_t)s2 * PN + C_GV + h * 128 + c2 * 8);
            *(LAS u32x4*)(F.lds + SL + s2 * PV + c2 * 16) = *(const u32x4*)(st + s2 * 128 + c2 * 8); }
    }
    __syncthreads();
    const int tb = F.wave & 3, vh = F.wave >> 2;
    bf16x8 Qf[2];
#pragma unroll
    for (int ks = 0; ks < 2; ++ks) Qf[ks] = *(const LAS bf16x8*)(F.lds + QD + (16 * tb + fr) * PQ + (ks * 32 + fq * 8) * 2);
    f32x4 P[4];
#pragma unroll
    for (int sb = 0; sb < 4; ++sb) { f32x4 a = (f32x4){0.f, 0.f, 0.f, 0.f};
        if (sb <= tb) {
#pragma unroll
            for (int ks = 0; ks < 2; ++ks) { const bf16x8 kf = *(const LAS bf16x8*)(F.lds + KD + (16 * sb + fr) * PQ + (ks * 32 + fq * 8) * 2); a = MFMA16(kf, Qf[ks], a); }
            if (sb == tb) {
#pragma unroll
                for (int i = 0; i < 4; ++i) if (4 * fq + i > fr) a[i] = 0.f; } }
        P[sb] = a; }
    f32x4 o[4];
#pragma unroll
    for (int vb = 0; vb < 4; ++vb) o[vb] = (f32x4){0.f, 0.f, 0.f, 0.f};
#pragma unroll
    for (int p = 0; p < 2; ++p) {
        if (2 * p <= tb) { const bf16x8 Pb = pk8f(P[2 * p], P[2 * p + 1]);
#pragma unroll
            for (int vb = 0; vb < 4; ++vb) { const int v0 = 16 * (4 * vh + vb);
                const bf16x8 Va = cat8(tr4(F.lds + VL, PV, 32 * p + 4 * fq, v0, fr), tr4(F.lds + VL, PV, 32 * p + 16 + 4 * fq, v0, fr)); o[vb] = MFMA16(Va, Pb, o[vb]); } } }
#pragma unroll
    for (int ks = 0; ks < 2; ++ks)
#pragma unroll
        for (int vb = 0; vb < 4; ++vb) { const int v0 = 16 * (4 * vh + vb);
            const bf16x8 Sa = cat8(tr4(F.lds + SL, PV, 32 * ks + 8 * fq, v0, fr), tr4(F.lds + SL, PV, 32 * ks + 8 * fq + 4, v0, fr)); o[vb] = MFMA16(Sa, Qf[ks], o[vb]); }
    float ss = 0.f;
#pragma unroll
    for (int vb = 0; vb < 4; ++vb)
#pragma unroll
        for (int i = 0; i < 4; ++i) ss += o[vb][i] * o[vb][i];
    ss += __shfl_xor(ss, 16); ss += __shfl_xor(ss, 32);
    LAS float* ssx = (LAS float*)(F.lds + SSX);
    if (fq == 0) ssx[vh * 64 + 16 * tb + fr] = ss;
    __syncthreads();
    const float tot = ssx[16 * tb + fr] + ssx[64 + 16 * tb + fr];
    const float rs = rsqrtf(tot * (1.f / 128.f) + EPS);
    const size_t row = (size_t)(b * SEQ + c * 64 + 16 * tb + fr); const float* go = F.a->in[IN_GGLAO] + l * 128;
#pragma unroll
    for (int vb = 0; vb < 4; ++vb) { const int v = 16 * (4 * vh + vb) + 4 * fq; const u32x2 zr = *(const u32x2*)(proj + row * PN + C_GZ + h * 128 + v); const f32x4 g = *(const f32x4*)(go + v);
        u32x2 w; w.x = pk2(o[vb][0] * rs * g[0] * siluf(bflo(zr.x)), o[vb][1] * rs * g[1] * siluf(bfhi(zr.x))); w.y = pk2(o[vb][2] * rs * g[2] * siluf(bflo(zr.y)), o[vb][3] * rs * g[3] * siluf(bfhi(zr.y)));
        *(u32x2*)(mix + row * DM + 512 + h * 128 + v) = w; }
}

__device__ __forceinline__ void sgla_unit(Ctx& F, int l, int un) {
    const int b = un >> 2, h = un & 3;
    const bf16_t* projs = (const bf16_t*)(F.ws + WS_PROJS); bf16_t* mixs = (bf16_t*)(F.ws + WS_MIXS);
    LAS float* aL = (LAS float*)F.lds; LAS float* qL = aL + 256; LAS float* kL = qL + 256; LAS float* vL = kL + 256; LAS float* part = vL + 512; LAS float* oL = part + 512;
    __syncthreads();
    {   const int t = F.tid >> 7, v = F.tid & 127; vL[t * 128 + v] = bf1(projs[(size_t)(b * DS + t) * PN + C_GV + h * 128 + v]); }
    if (F.tid < 256) { const int t = F.tid >> 6, dk = F.tid & 63; const bf16_t* pr = projs + (size_t)(b * DS + t) * PN;
        float x = F.a->in[IN_BA][l * 256 + h * 64 + dk];
#pragma unroll
        for (int r = 0; r < 16; ++r) x += bf1(pr[C_GA + r]) * F.a->in[IN_WUP][(size_t)(l * 16 + r) * 256 + h * 64 + dk];
        aL[t * 64 + dk] = __expf(logsigf(x) * (1.f / 16.f)); qL[t * 64 + dk] = bf1(pr[C_GQ + h * 64 + dk]) * 0.125f; kL[t * 64 + dk] = bf1(pr[C_GK + h * 64 + dk]); }
    __syncthreads();
    const int v = F.tid & 127, dg = F.tid >> 7;
    const float* s0 = F.a->in[IN_SGLA] + ((size_t)((l * DB + b) * 4 + h) * 64 + 16 * dg) * 128 + v;
    float S[16];
#pragma unroll
    for (int i = 0; i < 16; ++i) S[i] = s0[i * 128];
    for (int t = 0; t < 4; ++t) { float po = 0.f; const float vv = vL[t * 128 + v];
#pragma unroll
        for (int i = 0; i < 16; ++i) { const int dk = 16 * dg + i; S[i] = aL[t * 64 + dk] * S[i] + kL[t * 64 + dk] * vv; po += qL[t * 64 + dk] * S[i]; }
        part[dg * 128 + v] = po;
        __syncthreads();
        if (dg == 0) oL[t * 128 + v] = (part[v] + part[128 + v]) + (part[256 + v] + part[384 + v]);
        __syncthreads(); }
    float* so = F.out + O_GLAS + ((size_t)((l * DB + b) * 4 + h) * 64 + 16 * dg) * 128 + v;
#pragma unroll
    for (int i = 0; i < 16; ++i) so[i * 128] = S[i];
    if (F.wave < 4) { const int t = F.wave; const float o0 = oL[t * 128 + F.lane], o1 = oL[t * 128 + 64 + F.lane];
        const float ss = wave_sum(o0 * o0 + o1 * o1); const float rs = rsqrtf(ss * (1.f / 128.f) + EPS);
        const size_t row = (size_t)(b * DS + t); const float* go = F.a->in[IN_GGLAO] + l * 128;
        mixs[row * DM + 512 + h * 128 + F.lane] = (bf16_t)f2bf(o0 * rs * go[F.lane] * siluf(bf1(projs[row * PN + C_GZ + h * 128 + F.lane])));
        mixs[row * DM + 512 + h * 128 + 64 + F.lane] = (bf16_t)f2bf(o1 * rs * go[64 + F.lane] * siluf(bf1(projs[row * PN + C_GZ + h * 128 + 64 + F.lane]))); }
}
__device__ __forceinline__ void sswa_unit(Ctx& F, int l, int un) {
    constexpr int PK = 144, VOFF = 160 * PK;
    const int b = un >> 1, kvh = un & 1, fr = F.lane & 15, fq = F.lane >> 4;
    const bf16_t* projs = (const bf16_t*)(F.ws + WS_PROJS); bf16_t* mixs = (bf16_t*)(F.ws + WS_MIXS);
    LAS unsigned char* Kl = F.lds; LAS unsigned char* Vl = F.lds + VOFF;
    __syncthreads();
    {   const float* gk = F.a->in[IN_GSWK] + l * 64;
        for (int p = F.tid; p < 1536; p += 512) { const int j = p >> 3, ch = p & 7;
            float k[8], v[8];
#pragma unroll
            for (int q = 0; q < 8; ++q) { k[q] = 0.f; v[q] = 0.f; }
            if (j < 128) { const float* ck = F.a->in[IN_CSWK] + ((size_t)((l * DB + b) * 128 + j) * 2 + kvh) * 64 + ch * 8; const float* cv = F.a->in[IN_CSWV] + ((size_t)((l * DB + b) * 128 + j) * 2 + kvh) * 64 + ch * 8;
                const f32x4 a0 = ((const f32x4*)ck)[0], a1 = ((const f32x4*)ck)[1], b0 = ((const f32x4*)cv)[0], b1 = ((const f32x4*)cv)[1];
                k[0] = a0.x; k[1] = a0.y; k[2] = a0.z; k[3] = a0.w; k[4] = a1.x; k[5] = a1.y; k[6] = a1.z; k[7] = a1.w;
                v[0] = b0.x; v[1] = b0.y; v[2] = b0.z; v[3] = b0.w; v[4] = b1.x; v[5] = b1.y; v[6] = b1.z; v[7] = b1.w; }
            else if (j < 132) { const bf16_t* pr = projs + (size_t)(b * DS + (j - 128)) * PN; unpack8(*(const u32x4*)(pr + C_SK + kvh * 64 + ch * 8), k); unpack8(*(const u32x4*)(pr + C_SV + kvh * 64 + ch * 8), v); }
            float ss = 0.f;
#pragma unroll
            for (int q = 0; q < 8; ++q) ss += k[q] * k[q];
            ss += __shfl_xor(ss, 1); ss += __shfl_xor(ss, 2); ss += __shfl_xor(ss, 4);
            if (j >= 128) { const float rs = rsqrtf(ss * (1.f / 64.f) + EPS);
#pragma unroll
                for (int q = 0; q < 8; ++q) k[q] = k[q] * rs * gk[ch * 8 + q]; }
            if (j < 160) { *(LAS u32x4*)(Kl + j * PK + ch * 16) = pack8(k); *(LAS u32x4*)(Vl + j * PK + ch * 16) = pack8(v); }
            if (j >= 4 && j < 132) { const size_t o = ((size_t)((l * DB + b) * 128 + (j - 4)) * 2 + kvh) * 64 + ch * 8;
#pragma unroll
                for (int q = 0; q < 8; ++q) { F.out[O_SWKS + o + q] = k[q]; F.out[O_SWVS + o + q] = v[q]; } }
        }
    }
    __syncthreads();
    if (F.wave != 0) return;
    const int t = fr & 3, h = kvh * 4 + (fr >> 2); const size_t row = (size_t)(b * DS + t); const bf16_t* pr = projs + row * PN;
    bf16x8 Qf[2];
    {   const float* gq = F.a->in[IN_GSWQ] + l * 64; float q[2][8]; float ss = 0.f;
#pragma unroll
        for (int ks = 0; ks < 2; ++ks) { unpack8(*(const u32x4*)(pr + C_SQ + h * 64 + ks * 32 + fq * 8), q[ks]);
#pragma unroll
            for (int j = 0; j < 8; ++j) ss += q[ks][j] * q[ks][j]; }
        ss += __shfl_xor(ss, 16); ss += __shfl_xor(ss, 32);
        const float rs = rsqrtf(ss * (1.f / 64.f) + EPS) * 0.125f;
#pragma unroll
        for (int ks = 0; ks < 2; ++ks) {
#pragma unroll
            for (int j = 0; j < 8; ++j) q[ks][j] = q[ks][j] * rs * gq[ks * 32 + fq * 8 + j];
            Qf[ks] = __builtin_bit_cast(bf16x8, pack8(q[ks])); }
    }
    f32x4 S[10];
#pragma unroll
    for (int kb = 0; kb < 10; ++kb) { f32x4 a = (f32x4){0.f, 0.f, 0.f, 0.f};
#pragma unroll
        for (int ks = 0; ks < 2; ++ks) { const bf16x8 kf = *(const LAS bf16x8*)(Kl + (16 * kb + fr) * PK + (ks * 32 + fq * 8) * 2); a = MFMA16(kf, Qf[ks], a); }
        S[kb] = a; }
    const float sink = F.a->in[IN_SINKS][l * 8 + h];
    float m = sink;
#pragma unroll
    for (int kb = 0; kb < 10; ++kb)
#pragma unroll
        for (int i = 0; i < 4; ++i) { const int kj = 16 * kb + 4 * fq + i; const bool valid = (kj >= t + 1) && (kj <= t + 128);
            if (!valid) S[kb][i] = -INFINITY; m = fmaxf(m, S[kb][i]); }
    m = fmaxf(m, __shfl_xor(m, 16)); m = fmaxf(m, __shfl_xor(m, 32));
    float sum = 0.f;
#pragma unroll
    for (int kb = 0; kb < 10; ++kb)
#pragma unroll
        for (int i = 0; i < 4; ++i) { const float ev = __expf(S[kb][i] - m); S[kb][i] = ev; sum += ev; }
    sum += __shfl_xor(sum, 16); sum += __shfl_xor(sum, 32);
    sum += __expf(sink - m);
    const float inv = 1.f / sum;
    f32x4 o[4];
#pragma unroll
    for (int db = 0; db < 4; ++db) o[db] = (f32x4){0.f, 0.f, 0.f, 0.f};
#pragma unroll
    for (int p = 0; p < 5; ++p) { const bf16x8 Pb = pk8f(S[2 * p] * inv, S[2 * p + 1] * inv);
#pragma unroll
        for (int db = 0; db < 4; ++db) { const bf16x8 Va = cat8(tr4(Vl, PK, 32 * p + 4 * fq, 16 * db, fr), tr4(Vl, PK, 32 * p + 16 + 4 * fq, 16 * db, fr)); o[db] = MFMA16(Va, Pb, o[db]); } }
#pragma unroll
    for (int db = 0; db < 4; ++db) { const int d = 16 * db + 4 * fq; const u32x2 zr = *(const u32x2*)(pr + C_SZ + h * 64 + d);
        u32x2 w; w.x = pk2(o[db][0] * siluf(bflo(zr.x)), o[db][1] * siluf(bfhi(zr.x))); w.y = pk2(o[db][2] * siluf(bflo(zr.y)), o[db][3] * siluf(bfhi(zr.y)));
        *(u32x2*)(mixs + row * DM + 1024 + h * 64 + d) = w; }
}
__device__ __forceinline__ void sconv_unit(Ctx& F, int l, int b) {
    const bf16_t* projs = (const bf16_t*)(F.ws + WS_PROJS); bf16_t* mixs = (bf16_t*)(F.ws + WS_MIXS);
    const int ch = F.tid; const float* cw = F.a->in[IN_CONVW] + l * 3 * 512; const float w0 = cw[ch], w1 = cw[512 + ch], w2 = cw[1024 + ch];
    float um2 = F.a->in[IN_SCONV][((size_t)(l * DB + b) * 2 + 0) * 512 + ch], um1 = F.a->in[IN_SCONV][((size_t)(l * DB + b) * 2 + 1) * 512 + ch];
    for (int t = 0; t < 4; ++t) { const size_t row = (size_t)(b * DS + t); const bf16_t* pr = projs + row * PN;
        const float u = bf1(pr[C_AC + ch]) * bf1(pr[C_AH + ch]); const float o = w0 * um2 + w1 * um1 + w2 * u;
        mixs[row * DM + ch] = (bf16_t)f2bf(bf1(pr[C_AB + ch]) * o * siluf(bf1(pr[C_AZ + ch])));
        um2 = um1; um1 = u; }
    F.out[O_CONVS + ((size_t)(l * DB + b) * 2 + 0) * 512 + ch] = um2; F.out[O_CONVS + ((size_t)(l * DB + b) * 2 + 1) * 512 + ch] = um1;
}

#ifndef DIS
#define DIS 0
#endif
constexpr int N_PHASES = 11;
__global__ void __launch_bounds__(NTHREADS, 2) hymba_fwd(const Args args) {
    extern __shared__ __attribute__((aligned(16))) unsigned char lds_raw[];
    Ctx F;
    F.lds = (LAS unsigned char*)lds_raw; F.tid = threadIdx.x; F.lane = F.tid & 63; F.wave = __builtin_amdgcn_readfirstlane(F.tid >> 6); F.G = gridDim.x; F.bid = blockIdx.x;
    F.a = &args;
    F.out = args.out; F.ws = args.ws; F.ctlf = (float*)(args.ws + WS_CTL);
    volatile LAS unsigned* MISC = (volatile LAS unsigned*)(F.lds + MISC_OFF);
    if (F.tid < 64) MISC[F.tid] = 0u;
    __syncthreads();
    XcdBarrier bar; bar.bar = (unsigned*)(args.ws + WS_CTL) + CW_BAR; bar.x = 0; bar.st = nullptr;
    if (MK_N_LAUNCHES == 1) bar = xcd_barrier_post((unsigned*)(args.ws + WS_CTL) + CW_BAR, MISC + 8);
    const int lo = args.ph_lo, hi = args.ph_hi;
#define IN(k) (lo <= (k) && (k) < hi)
#define SEAM(k) do { if (IN(k) && IN((k) + 1)) xcd_barrier(bar); } while (0)
#define PHASE_ENTER() do { int t_ = threadIdx.x; asm volatile("" : "+v"(t_)); F.tid = t_; F.lane = t_ & 63; F.wave = __builtin_amdgcn_readfirstlane(t_ >> 6); } while (0)

    if (IN(0) && !(DIS & 1)) { PHASE_ENTER(); p0_prologue(F); }
    SEAM(0);
    for (int l = 0; l < 2; ++l) {
        const int pb = 1 + 5 * l;
        float* ssP = F.ctlf + CW_SSP + l * NP; float* ssS = F.ctlf + CW_SSS + l * NS;
        bf16_t* WinT = (bf16_t*)(F.ws + WS_WIN + l * WIN_L); bf16_t* WoutT = (bf16_t*)(F.ws + WS_WOUT + l * WOUT_L);
        if (IN(pb) && !(DIS & 2)) {
            pg8::Gemm g{(const bf16_t*)(F.ws + WS_XB), WinT, NP, PN, DM}; pg8::StaticOrder S; S.init(NP, PN, F.G, F.bid);
            pg8::EpiProj E{(bf16_t*)(F.ws + WS_PROJ), PN, ssP};
            pg8::gemm_phase<pg8::EpiProj, pg8::StaticOrder, true, true>(F.lds, g, S, E);
        }
        SEAM(pb);
        if (IN(pb + 1)) {
            PHASE_ENTER();
            const int nsg = 96 + (l == 0 ? 128 : 0), NIT = 512 + 512 + 128 + nsg;
            for (int it = F.bid; it < NIT; it += F.G) {
                if (it < 512) { if (!(DIS & 4)) swa_unit(F, l, it); }
                else if (it < 1024) { if (!(DIS & 8)) glaA_unit(F, l, it - 512); }
                else if (it < 1152) { if (!(DIS & 16)) conv_unit(F, l, it - 1024); }
                else if (!(DIS & 32)) { const int s = it - 1152;
                    if (s < 96) { SgEpiBf16 E{(bf16_t*)(F.ws + WS_PROJS) + s * 64, PN, ssS}; sg_unit(F, (const bf16_t*)(F.ws + WS_XS), WinT + (size_t)s * 64 * DM, E); }
                    else { const int q = s - 96, rb = q >> 5, cb = q & 31;
                        SgEpiF32 E{(float*)(F.ws + WS_MEMKV) + (size_t)rb * 128 * 2048 + cb * 64, 2048, F.ctlf + CW_SSM + rb * 128};
                        sg_unit(F, (const bf16_t*)(F.ws + WS_MEMA) + (size_t)rb * 128 * DM, (const bf16_t*)(F.ws + WS_WMEM) + (size_t)cb * 64 * DM, E); } }
            }
        }
        SEAM(pb + 1);
        if (IN(pb + 2)) {
            PHASE_ENTER();
            constexpr int NIT = 256 + 128 + 128 + 128 + 64 + 32;
            for (int it = F.bid; it < NIT; it += F.G) {
                if (it < 256) { if (!(DIS & 64)) mem_unit<false>(F, l, it); }
                else if (it < 384) { if (!(DIS & 128)) gla_scan_item(F, l, it - 256); }
                else if (it < 512) { if (!(DIS & 256)) mem_unit<true>(F, l, it - 384); }
                else if (it < 640) { if (!(DIS & 512)) sgla_unit(F, l, it - 512); }
                else if (it < 704) { if (!(DIS & 1024)) sswa_unit(F, l, it - 640); }
                else { if (!(DIS & 2048)) sconv_unit(F, l, it - 704); }
            }
        }
        SEAM(pb + 2);
        if (IN(pb + 3)) {
            PHASE_ENTER();
            constexpr int NIT = 512 + 32;
            for (int it = F.bid; it < NIT; it += F.G) {
                if (it < 512) { if (!(DIS & 4096)) glaC_unit(F, l, it); }
                else if (!(DIS & 8192)) { const int s = it - 512;
                    SgEpiOut E{(l == 0 ? F.a->in[IN_XS] : F.out + O_YS) + s * 64, F.out + O_YS + s * 64, l == 0 ? (bf16_t*)(F.ws + WS_XS) + s * 64 : nullptr, F.ctlf + CW_SSS + NS};
                    sg_unit(F, (const bf16_t*)(F.ws + WS_MIXS), WoutT + (size_t)s * 64 * DM, E); }
            }
        }
        SEAM(pb + 3);
        if (IN(pb + 4) && !(DIS & 16384)) {
            pg8::Gemm g{(const bf16_t*)(F.ws + WS_MIX), WoutT, NP, DM, DM}; pg8::StaticOrder S; S.init(NP, DM, F.G, F.bid);
            pg8::EpiOut E{l == 0 ? F.a->in[IN_XP] : F.out + O_YP, F.out + O_YP, l == 0 ? (bf16_t*)(F.ws + WS_XB) : nullptr, F.ctlf + CW_SSP + NP};
            pg8::gemm_phase<pg8::EpiOut, pg8::StaticOrder, false, true>(F.lds, g, S, E);
        }
        if (l == 0) SEAM(pb + 4);
    }
#undef IN
#undef SEAM
}

extern "C" void kernel_launch(void* const* d_in, const int* in_sizes, int n_in, void* d_out, int out_size, void* d_ws, size_t ws_size, hipStream_t stream) {
    static int grid = 0;
    if (grid == 0) {
        if (n_in != 23 || out_size != (int)O_END || ws_size < WS_END) { fprintf(stderr, "kernel_launch: unexpected shapes (n_in %d out %d ws %zu)\n", n_in, out_size, ws_size); grid = -1; return; }
        int dev = 0, cus = 0, per_cu = 0;
        if (hipGetDevice(&dev) != hipSuccess || hipDeviceGetAttribute(&cus, hipDeviceAttributeMultiprocessorCount, dev) != hipSuccess) { grid = -1; return; }
        if (hipFuncSetAttribute((const void*)hymba_fwd, hipFuncAttributeMaxDynamicSharedMemorySize, LDS_BYTES) != hipSuccess) { fprintf(stderr, "kernel_launch: hipFuncSetAttribute failed\n"); grid = -1; return; }
        if (hipOccupancyMaxActiveBlocksPerMultiprocessor(&per_cu, (const void*)hymba_fwd, NTHREADS, LDS_BYTES) != hipSuccess || per_cu < 1) { fprintf(stderr, "kernel_launch: occupancy query reports %d\n", per_cu); }
        (void)hipGetLastError();
        grid = cus;
    }
    if (grid < 0) return;
    (void)hipMemsetAsync((char*)d_ws + WS_CTL, 0, CTL_ZERO_BYTES, stream);
    Args a{};
    for (int i = 0; i < 23; ++i) a.in[i] = (const float*)d_in[i];
    a.out = (float*)d_out; a.ws = (unsigned char*)d_ws;
    if (MK_N_LAUNCHES == 1) { a.ph_lo = 0; a.ph_hi = N_PHASES; hipLaunchKernelGGL(hymba_fwd, dim3(grid), dim3(NTHREADS), LDS_BYTES, stream, a); }
    else { for (int p = 0; p < N_PHASES; ++p) { a.ph_lo = p; a.ph_hi = p + 1; hipLaunchKernelGGL(hymba_fwd, dim3(grid), dim3(NTHREADS), LDS_BYTES, stream, a); } }
}
```

```cpp
#include <hip/hip_runtime.h>
#include <cstdio>
#include <cstdint>

#ifndef MK_N_LAUNCHES
#define MK_N_LAUNCHES 1
#endif

#define GAS __attribute__((address_space(1)))
#define LAS __attribute__((address_space(3)))
typedef unsigned short bf16_t;
typedef short bf16x8 __attribute__((ext_vector_type(8)));
typedef short s16x4 __attribute__((ext_vector_type(4)));
typedef short v4i16_t __attribute__((ext_vector_type(4)));
typedef float f32x4 __attribute__((ext_vector_type(4)));
typedef unsigned u32x4 __attribute__((ext_vector_type(4)));
typedef unsigned u32x2 __attribute__((ext_vector_type(2)));

constexpr int DM = 2048, SEQ = 4096, NP = 8192, NS = 128, DB = 32, DS = 4, DIN = 5904, PN = 6144, NMEMROWS = 512;
constexpr int C_AB = 0, C_AC = 512, C_AH = 1024, C_AZ = 1536, C_GQ = 2048, C_GK = 2304, C_GV = 2560, C_GA = 3072, C_GZ = 3088,
              C_SQ = 3600, C_SK = 4112, C_SV = 4240, C_SZ = 4368, C_MQ = 4880, C_MZ = 5392;
constexpr float EPS = 1e-6f;
constexpr size_t O_YP = 0, O_YS = 16777216, O_CONVP = 17039360, O_GLAP = 17043456, O_SWKP = 17174528, O_SWVP = 17240064, O_MKP = 17305600,
                 O_MVP = 17829888, O_CONVS = 18354176, O_GLAS = 18419712, O_SWKS = 20516864, O_SWVS = 21565440, O_END = 22614016;
constexpr size_t MiB = 1u << 20;
constexpr size_t WS_CTL = 0, CTL_ZERO_BYTES = 32768;
constexpr size_t WS_WIN = 2 * MiB, WIN_L = (size_t)PN * DM * 2;
constexpr size_t WS_WOUT = 50 * MiB, WOUT_L = (size_t)DM * DM * 2;
constexpr size_t WS_WMEM = 66 * MiB;
constexpr size_t WS_XB = 74 * MiB;
constexpr size_t WS_PROJ = 106 * MiB;
constexpr size_t WS_MIX = 202 * MiB;
constexpr size_t WS_GLAKV = 234 * MiB;
constexpr size_t WS_GLAST = 250 * MiB;
constexpr size_t WS_GLADEC = 258 * MiB;
constexpr size_t WS_MEMKV = 259 * MiB;
constexpr size_t WS_MEMA = 263 * MiB;
constexpr size_t WS_XS = 265 * MiB;
constexpr size_t WS_PROJS = 266 * MiB;
constexpr size_t WS_MIXS = 268 * MiB;
constexpr size_t WS_MEMKB = 270 * MiB;
constexpr size_t WS_MEMVB = 271 * MiB;
constexpr size_t WS_GLACUM = 272 * MiB;
constexpr size_t WS_END = 280 * MiB;
constexpr int CW_KN2 = 16384;
constexpr int CW_Q = 8192;
constexpr int CW_DEP = CW_Q + 6144;
constexpr int CW_RDY = CW_DEP + 512;
constexpr int CW_BAR = 4096;
constexpr int CW_SSP = 65536;
constexpr int CW_SSS = CW_SSP + 2 * 8192;
constexpr int CW_SSM = CW_SSS + 2 * 128;
static_assert(CW_BAR + 3456 <= 8192, "ctl");

constexpr int NWAVES = 8, NTHREADS = 512;
constexpr int LDS_BYTES = 151552, MISC_OFF = 147456;

__device__ __forceinline__ float bflo(unsigned u) { return __uint_as_float(u << 16); }
__device__ __forceinline__ float bfhi(unsigned u) { return __uint_as_float(u & 0xffff0000u); }
__device__ __forceinline__ float bf1(bf16_t h) { return __uint_as_float((unsigned)h << 16); }
__device__ __forceinline__ unsigned f2bf(float f) { unsigned u = __float_as_uint(f); return (u + 0x7fffu + ((u >> 16) & 1u)) >> 16; }
typedef float f32x2_t __attribute__((ext_vector_type(2))); typedef __bf16 bf16x2_t __attribute__((ext_vector_type(2)));
__device__ __forceinline__ unsigned pk2(float lo, float hi) { f32x2_t v = {lo, hi}; bf16x2_t b = __builtin_convertvector(v, bf16x2_t); return __builtin_bit_cast(unsigned, b); }
__device__ __forceinline__ void unpack8(const u32x4 r, float* f) { f[0] = bflo(r.x); f[1] = bfhi(r.x); f[2] = bflo(r.y); f[3] = bfhi(r.y); f[4] = bflo(r.z); f[5] = bfhi(r.z); f[6] = bflo(r.w); f[7] = bfhi(r.w); }
__device__ __forceinline__ u32x4 pack8(const float* f) { u32x4 r; r.x = pk2(f[0], f[1]); r.y = pk2(f[2], f[3]); r.z = pk2(f[4], f[5]); r.w = pk2(f[6], f[7]); return r; }
__device__ __forceinline__ float siluf(float x) { return x * __builtin_amdgcn_rcpf(1.f + __expf(-x)); }
__device__ __forceinline__ float logsigf(float x) { return fminf(x, 0.f) - __logf(1.f + __expf(-fabsf(x))); }
__device__ __forceinline__ float wave_sum(float v) {
#pragma unroll
    for (int o = 1; o < 64; o <<= 1) v += __shfl_xor(v, o);
    return v;
}
#define LDS_WAIT() asm volatile("s_waitcnt lgkmcnt(0)" ::: "memory")
__device__ __forceinline__ int lane_id() { int l; asm volatile("v_mbcnt_lo_u32_b32 %0, -1, 0\n\tv_mbcnt_hi_u32_b32 %0, -1, %0" : "=v"(l)); return l; }
__device__ __forceinline__ s16x4 tr4(const LAS unsigned char* base, int pitchB, int r0, int c0, int li) {
    const LAS unsigned char* p = base + (r0 + (li >> 2)) * pitchB + (c0 + 4 * (li & 3)) * 2;
    return __builtin_bit_cast(s16x4, __builtin_amdgcn_ds_read_tr16_b64_v4i16((LAS v4i16_t*)p));
}
__device__ __forceinline__ bf16x8 cat8(s16x4 a, s16x4 b) { return (bf16x8){a[0], a[1], a[2], a[3], b[0], b[1], b[2], b[3]}; }
__device__ __forceinline__ bf16x8 pk8f(f32x4 a, f32x4 b) { u32x4 r; r.x = pk2(a[0], a[1]); r.y = pk2(a[2], a[3]); r.z = pk2(b[0], b[1]); r.w = pk2(b[2], b[3]); return __builtin_bit_cast(bf16x8, r); }
#define MFMA16(a, b, c) __builtin_amdgcn_mfma_f32_16x16x32_bf16((a), (b), (c), 0, 0, 0)

namespace pg8 {
#define PG8_LAS __attribute__((address_space(3)))
constexpr int BM = 256, BK = 64, HALF = 128, HTB = HALF * BK * 2, STAGE_BYTES = 8 * HTB, NXCD = 8, WGM = 4;
__host__ __device__ __forceinline__ int lds_byte(int r, int c) { const int st = (r >> 4) * 2 + (c >> 5), rr = r & 15, cc = c & 31, ob = rr * 64 + cc * 2; return st * 1024 + (ob ^ (((ob >> 9) & 1) << 5)); }
__host__ __device__ __forceinline__ void stage_rc(int b, int& R, int& C) { const int st = b / 1024, sb = b % 1024, swz = sb ^ (((sb >> 9) & 1) << 5); R = (st >> 1) * 16 + swz / 64; C = (st & 1) * 32 + (swz % 64) / 2; }
__host__ __device__ __forceinline__ int perm32(int rho) { const int n = rho >> 4, i = rho & 15; return 8 * (i >> 2) + 4 * n + (i & 3); }
struct Unit { int pm, pn; };
struct Gemm { const bf16_t* A; const bf16_t* Bt; int M, N, K; };
struct StaticOrder {
    int nM, nN, nwg, G, c;
    __host__ __device__ void init(int M, int N, int G_, int c_) { nM = M / BM; nN = N / BM; nwg = nM * nN; G = G_; c = c_; }
    __host__ __device__ bool next(int i, Unit& u) const {
        const long L = (long)i * G + c; if (L >= nwg) return false;
        int wgid = (int)L; { const int q = nwg / NXCD, r = nwg % NXCD, xcd = wgid % NXCD, off = wgid / NXCD; wgid = (xcd < r ? xcd * (q + 1) : r * (q + 1) + (xcd - r) * q) + off; }
        const int nig = WGM * nN, gid = wgid / nig, fm = gid * WGM, gsz = (nM - fm) < WGM ? (nM - fm) : WGM;
        u.pm = fm + ((wgid % nig) % gsz); u.pn = (wgid % nig) / gsz; return true;
    }
    __device__ __forceinline__ void a_ready(const Unit&) const {}
    __device__ __forceinline__ void done(const Unit&) const {}
};
__device__ __forceinline__ unsigned cvt_pk_bf16(float lo, float hi) { unsigned r; asm volatile("v_cvt_pk_bf16_f32 %0, %1, %2" : "=v"(r) : "v"(lo), "v"(hi)); return r; }

struct EpiProj {
    static constexpr bool PERM = true, AFTER_DRAIN = false;
    bf16_t* O; int ldc; const float* ss; float* convp;
    __device__ __forceinline__ void operator()(const f32x4 (&acc)[2][2][4][2], const Unit& u, int wr, int wc, int fr, int fq) const {
        const int row0 = u.pm * BM + wr * 64 + fr, col0 = u.pn * BM + wc * 32 + 8 * fq;
        float sv[2][4];
#pragma unroll
        for (int ai = 0; ai < 2; ++ai)
#pragma unroll
            for (int m = 0; m < 4; ++m) sv[ai][m] = ss[row0 + ai * HALF + m * 16];
        if (u.pn < 8) {
            const int ch0 = 64 * u.pn + 32 * (wc & 1) + 8 * fq;
#pragma unroll
            for (int ai = 0; ai < 2; ++ai)
#pragma unroll
                for (int m = 0; m < 4; ++m) { const int row = row0 + ai * HALF + m * 16; const float sc = rsqrtf(sv[ai][m] * (1.0f / DM) + EPS);
                    const f32x4 a0 = acc[ai][0][m][0] * sc, a1 = acc[ai][0][m][1] * sc, b0 = acc[ai][1][m][0] * sc, b1 = acc[ai][1][m][1] * sc;
                    f32x4 r0, r1;
                    if (wc < 2) { r0 = a0 * b0; r1 = a1 * b1; }
                    else {
#pragma unroll
                        for (int j = 0; j < 4; ++j) { r0[j] = a0[j] * (b0[j] * __builtin_amdgcn_rcpf(1.f + __expf(-b0[j]))); r1[j] = a1[j] * (b1[j] * __builtin_amdgcn_rcpf(1.f + __expf(-b1[j]))); } }
                    u32x4 w; w.x = cvt_pk_bf16(r0[0], r0[1]); w.y = cvt_pk_bf16(r0[2], r0[3]); w.z = cvt_pk_bf16(r1[0], r1[1]); w.w = cvt_pk_bf16(r1[2], r1[3]);
                    *(u32x4*)(O + (size_t)row * ldc + (wc < 2 ? C_AC : C_AB) + ch0) = w;
                    const int t = row & (SEQ - 1);
                    if (wc < 2 && t >= SEQ - 2) { float* cp = convp + ((size_t)(row >> 12) * 2 + (t - (SEQ - 2))) * 512 + ch0; *(f32x4*)cp = r0; *(f32x4*)(cp + 4) = r1; } }
            return; }
#pragma unroll
        for (int ai = 0; ai < 2; ++ai)
#pragma unroll
            for (int m = 0; m < 4; ++m) { const int row = row0 + ai * HALF + m * 16; const float sc = rsqrtf(sv[ai][m] * (1.0f / DM) + EPS);
                bf16_t* rowp = O + (size_t)row * ldc + col0;
#pragma unroll
                for (int bj = 0; bj < 2; ++bj) { const f32x4 v0 = acc[ai][bj][m][0] * sc, v1 = acc[ai][bj][m][1] * sc;
                    u32x4 w; w.x = cvt_pk_bf16(v0[0], v0[1]); w.y = cvt_pk_bf16(v0[2], v0[3]); w.z = cvt_pk_bf16(v1[0], v1[1]); w.w = cvt_pk_bf16(v1[2], v1[3]);
                    *(u32x4*)(rowp + bj * HALF) = w; } }
    }
};
template <bool LAST> struct EpiOut {
    static constexpr bool PERM = true, AFTER_DRAIN = false;
    const float* base; float* out; bf16_t* xb; float* ssn;
    __device__ __forceinline__ void operator()(const f32x4 (&acc)[2][2][4][2], const Unit& u, int wr, int wc, int fr, int fq) const {
        const int row0 = u.pm * BM + wr * 64 + fr, col0 = u.pn * BM + wc * 32 + 8 * fq;
        u32x4 bw[2][4][2];
#pragma unroll
        for (int ai = 0; ai < 2; ++ai)
#pragma unroll
            for (int m = 0; m < 4; ++m)
#pragma unroll
                for (int bj = 0; bj < 2; ++bj) bw[ai][m][bj] = *(const u32x4*)(xb + (size_t)(row0 + ai * HALF + m * 16) * DM + col0 + bj * HALF);
#pragma unroll
        for (int ai = 0; ai < 2; ++ai)
#pragma unroll
            for (int m = 0; m < 4; ++m) { const int row = row0 + ai * HALF + m * 16; const size_t off = (size_t)row * DM + col0; float s = 0.f;
#pragma unroll
                for (int bj = 0; bj < 2; ++bj) { const size_t o2 = off + bj * HALF; const u32x4 b4 = bw[ai][m][bj];
                    f32x4 y0 = acc[ai][bj][m][0], y1 = acc[ai][bj][m][1];
                    y0[0] += bflo(b4.x); y0[1] += bfhi(b4.x); y0[2] += bflo(b4.y); y0[3] += bfhi(b4.y); y1[0] += bflo(b4.z); y1[1] += bfhi(b4.z); y1[2] += bflo(b4.w); y1[3] += bfhi(b4.w);
                    if (!LAST) { u32x4 w; w.x = cvt_pk_bf16(y0[0], y0[1]); w.y = cvt_pk_bf16(y0[2], y0[3]); w.z = cvt_pk_bf16(y1[0], y1[1]); w.w = cvt_pk_bf16(y1[2], y1[3]); *(u32x4*)(xb + o2) = w;
                        s += (y0[0] * y0[0] + y0[1] * y0[1]) + (y0[2] * y0[2] + y0[3] * y0[3]) + (y1[0] * y1[0] + y1[1] * y1[1]) + (y1[2] * y1[2] + y1[3] * y1[3]); }
                    else { *(f32x4*)(out + o2) = y0; *(f32x4*)(out + o2 + 4) = y1; } }
                if (!LAST) { s += __shfl_xor(s, 16); s += __shfl_xor(s, 32); if (fq == 0) atomicAdd(ssn + row, s); } }
    }
};

template <class Epi, class Sched, bool ALIGN_EPI = false, bool SP2 = false>
__device__ __forceinline__ void gemm_phase(PG8_LAS unsigned char* lds, const Gemm g, const Sched& S, const Epi& E, int wave_s) {
    int tid_ = wave_s * 64 + lane_id(); asm volatile("" : "+v"(tid_));
    const int tid = tid_, wid = __builtin_amdgcn_readfirstlane(tid >> 6), lane = tid & 63, wr = wid >> 2, wc = wid & 3, fr = lane & 15, fq = lane >> 4;
    const int K = g.K, nt = K / BK;
    unsigned voffA[2], voffB[2];
#pragma unroll
    for (int i = 0; i < 2; ++i) { int R, C; stage_rc(tid * 16 + i * 8192, R, C); const int Rb = Epi::PERM ? ((R & ~31) + perm32(R & 31)) : R;
        voffA[i] = (unsigned)(R * K + C) * 2u; voffB[i] = (unsigned)(Rb * K + C) * 2u; }
    const size_t kstep = (size_t)(BK * 2);
    const size_t hstep = (size_t)HALF * K * 2;
    const size_t tstep = 2 * hstep;
    const unsigned ldsw = (unsigned)wid * 1024u;
    const int aoff = lds_byte(wr * 64 + fr, fq * 8), boff = lds_byte(wc * 32 + fr, fq * 8);
#define PG8_SA(b, h) (((b) * 2 + (h)) * HTB)
#define PG8_SB(b, h) ((4 + (b) * 2 + (h)) * HTB)
#define PG8_STAGE(bufoff, gbase, voff) do { _Pragma("unroll") for (int _i = 0; _i < 2; ++_i) { unsigned _vo = (voff)[_i]; asm volatile("" : "+v"(_vo)); \
        __builtin_amdgcn_global_load_lds((const unsigned*)((const char*)(gbase) + _vo), (PG8_LAS unsigned*)(lds + (bufoff) + ldsw + _i * 8192), 16, 0, 0); } } while (0)
#define PG8_LDA(dst, b, h) do { _Pragma("unroll") for (int m = 0; m < 4; ++m) _Pragma("unroll") for (int k = 0; k < 2; ++k) dst[m][k] = *(const PG8_LAS bf16x8*)(lds + PG8_SA(b, h) + aoff + m * 2048 + k * 1024); } while (0)
#define PG8_LDB(dst, b, h) do { _Pragma("unroll") for (int n = 0; n < 2; ++n) _Pragma("unroll") for (int k = 0; k < 2; ++k) dst[n][k] = *(const PG8_LAS bf16x8*)(lds + PG8_SB(b, h) + boff + n * 2048 + k * 1024); } while (0)
#define PG8_MMA(ai, bj, At, Bt) do { __builtin_amdgcn_s_setprio(1); _Pragma("unroll") for (int m = 0; m < 4; ++m) _Pragma("unroll") for (int n = 0; n < 2; ++n) _Pragma("unroll") for (int k = 0; k < 2; ++k) \
        acc[ai][bj][m][n] = __builtin_amdgcn_mfma_f32_16x16x32_bf16(Bt[n][k], At[m][k], acc[ai][bj][m][n], 0, 0, 0); __builtin_amdgcn_s_setprio(0); } while (0)
#define PG8_WAIT_V(n) asm volatile("s_waitcnt vmcnt(" #n ")" ::: "memory")
#define PG8_WAIT_L(n) asm volatile("s_waitcnt lgkmcnt(" #n ")" ::: "memory")
#define PG8_BAR __builtin_amdgcn_s_barrier()
#define PG8_SCHED __builtin_amdgcn_sched_barrier(0)
    Unit cur, nxt; int ui = 0;
    if (!S.next(0, cur)) return;
    f32x4 acc[2][2][4][2];
#pragma unroll
    for (int a = 0; a < 2; ++a)
#pragma unroll
        for (int b = 0; b < 2; ++b)
#pragma unroll
            for (int m = 0; m < 4; ++m)
#pragma unroll
                for (int n = 0; n < 2; ++n) acc[a][b][m][n] = (f32x4){0.f, 0.f, 0.f, 0.f};
    bf16x8 At[4][2], B0[2][2], B1[2][2];
    const char* cA = (const char*)g.A + (size_t)cur.pm * tstep; const char* cB = (const char*)g.Bt + (size_t)cur.pn * tstep;
    S.a_ready(cur);
    if constexpr (SP2) {
        PG8_STAGE(PG8_SB(0, 0), cB, voffB); PG8_STAGE(PG8_SB(0, 1), cB + hstep, voffB); PG8_STAGE(PG8_SA(0, 0), cA, voffA); PG8_STAGE(PG8_SA(0, 1), cA + hstep, voffA);
        if (wr == 1) PG8_BAR;
        PG8_WAIT_V(2); PG8_BAR;
        PG8_STAGE(PG8_SB(1, 0), cB + kstep, voffB); PG8_STAGE(PG8_SA(1, 0), cA + kstep, voffA); PG8_STAGE(PG8_SB(1, 1), cB + hstep + kstep, voffB);
        PG8_WAIT_V(6); PG8_BAR;
    } else {
        PG8_STAGE(PG8_SB(0, 0), cB, voffB); PG8_STAGE(PG8_SA(0, 0), cA, voffA); PG8_STAGE(PG8_SB(0, 1), cB + hstep, voffB); PG8_STAGE(PG8_SA(0, 1), cA + hstep, voffA);
        if (wr == 1) PG8_BAR;
        PG8_WAIT_V(4); PG8_BAR;
        PG8_STAGE(PG8_SB(1, 0), cB + kstep, voffB); PG8_STAGE(PG8_SA(1, 0), cA + kstep, voffA); PG8_STAGE(PG8_SB(1, 1), cB + hstep + kstep, voffB);
        PG8_WAIT_V(6); PG8_BAR;
    }
    for (;;) {
        const bool has_next = S.next(ui + 1, nxt);
        const char* nA = has_next ? (const char*)g.A + (size_t)nxt.pm * tstep : cA; const char* nB = has_next ? (const char*)g.Bt + (size_t)nxt.pn * tstep : cB;
        for (int t = 0; t < nt; t += 2) {
            const bool last = (t == nt - 2);
            const char* a1 = cA + (size_t)(t + 1) * kstep;
            const char* a2 = last ? nA : cA + (size_t)(t + 2) * kstep; const char* b2 = last ? nB : cB + (size_t)(t + 2) * kstep;
            const char* a3 = a2 + kstep; const char* b3 = b2 + kstep;
            if (last && has_next) S.a_ready(nxt);
            if constexpr (SP2) {
            PG8_LDB(B0, 0, 0); PG8_LDB(B1, 0, 1); PG8_SCHED; PG8_LDA(At, 0, 0); PG8_STAGE(PG8_SA(1, 1), a1 + hstep, voffA);
            PG8_WAIT_V(8); PG8_WAIT_L(0); PG8_BAR; PG8_MMA(0, 0, At, B0); PG8_MMA(0, 1, At, B1); PG8_BAR; PG8_SCHED;
            PG8_LDA(At, 0, 1); PG8_STAGE(PG8_SB(0, 0), b2, voffB); PG8_STAGE(PG8_SB(0, 1), b2 + hstep, voffB); PG8_STAGE(PG8_SA(0, 0), a2, voffA);
            PG8_WAIT_V(8); PG8_WAIT_L(0); PG8_BAR; PG8_MMA(1, 0, At, B0); PG8_MMA(1, 1, At, B1); PG8_BAR; PG8_SCHED;
            PG8_LDB(B0, 1, 0); PG8_LDB(B1, 1, 1); PG8_SCHED; PG8_LDA(At, 1, 0); PG8_STAGE(PG8_SA(0, 1), a2 + hstep, voffA);
            PG8_WAIT_V(8); PG8_WAIT_L(0); PG8_BAR; PG8_MMA(0, 0, At, B0); PG8_MMA(0, 1, At, B1); PG8_BAR; PG8_SCHED;
            PG8_LDA(At, 1, 1); PG8_STAGE(PG8_SB(1, 0), b3, voffB); PG8_STAGE(PG8_SB(1, 1), b3 + hstep, voffB); PG8_STAGE(PG8_SA(1, 0), a3, voffA);
            PG8_WAIT_V(8); PG8_WAIT_L(0); PG8_BAR; PG8_MMA(1, 0, At, B0); PG8_MMA(1, 1, At, B1); PG8_BAR; PG8_SCHED;
            } else {
            PG8_LDB(B0, 0, 0); PG8_SCHED; PG8_LDA(At, 0, 0); PG8_STAGE(PG8_SA(1, 1), a1 + hstep, voffA);
            PG8_WAIT_L(8); PG8_BAR; PG8_WAIT_L(0); PG8_MMA(0, 0, At, B0); PG8_BAR; PG8_SCHED;
            PG8_LDB(B1, 0, 1); PG8_STAGE(PG8_SB(0, 0), b2, voffB);
            PG8_BAR; PG8_WAIT_L(0); PG8_MMA(0, 1, At, B1); PG8_BAR;
            PG8_LDA(At, 0, 1); PG8_STAGE(PG8_SA(0, 0), a2, voffA);
            PG8_BAR; PG8_WAIT_L(0); PG8_MMA(1, 0, At, B0); PG8_BAR; PG8_SCHED;
            PG8_STAGE(PG8_SB(0, 1), b2 + hstep, voffB);
            PG8_WAIT_V(6); PG8_BAR; PG8_MMA(1, 1, At, B1); PG8_BAR;
            PG8_LDB(B0, 1, 0); PG8_SCHED; PG8_LDA(At, 1, 0); PG8_STAGE(PG8_SA(0, 1), a2 + hstep, voffA);
            PG8_WAIT_L(8); PG8_BAR; PG8_WAIT_L(0); PG8_MMA(0, 0, At, B0); PG8_BAR; PG8_SCHED;
            PG8_LDB(B1, 1, 1); PG8_STAGE(PG8_SB(1, 0), b3, voffB);
            PG8_BAR; PG8_WAIT_L(0); PG8_MMA(0, 1, At, B1); PG8_BAR;
            PG8_LDA(At, 1, 1); PG8_STAGE(PG8_SA(1, 0), a3, voffA);
            PG8_BAR; PG8_WAIT_L(0); PG8_MMA(1, 0, At, B0); PG8_BAR; PG8_SCHED;
            PG8_STAGE(PG8_SB(1, 1), b3 + hstep, voffB);
            PG8_WAIT_V(6); PG8_BAR; PG8_MMA(1, 1, At, B1); PG8_BAR;
            }
        }
        if constexpr (ALIGN_EPI) { if (wr == 0) PG8_BAR; }
        if constexpr (!Epi::AFTER_DRAIN) { E(acc, cur, wr, wc, fr, fq); S.done(cur); }
        if (!has_next) break;
#pragma unroll
        for (int a = 0; a < 2; ++a)
#pragma unroll
            for (int b = 0; b < 2; ++b)
#pragma unroll
                for (int m = 0; m < 4; ++m)
#pragma unroll
                    for (int n = 0; n < 2; ++n) acc[a][b][m][n] = (f32x4){0.f, 0.f, 0.f, 0.f};
        cur = nxt; cA = nA; cB = nB; ++ui;
        if constexpr (ALIGN_EPI) { if (wr == 1) PG8_BAR; }
    }
    PG8_WAIT_V(0);
    if constexpr (!ALIGN_EPI) { if (wr == 0) PG8_BAR; }
    PG8_BAR;
#undef PG8_SA
#undef PG8_SB
#undef PG8_STAGE
#undef PG8_LDA
#undef PG8_LDB
#undef PG8_MMA
#undef PG8_WAIT_V
#undef PG8_WAIT_L
#undef PG8_BAR
#undef PG8_SCHED
}
}

typedef GAS unsigned gu32;
#define RLX_AGENT __ATOMIC_RELAXED, __HIP_MEMORY_SCOPE_AGENT
#define XB_TMO      128
#define XB_XCNT(j)  (256  + 64 * (j))
#define XB_XSUB(j)  (1280 + 64 * (j))
#define XB_XGEN(j)  (2304 + 64 * (j))
#define XB_TOP      3328
#define XB_TOPGEN   3392
#define XCD_BAR_WORDS 3456
#define XB_SPIN_CAP (1u << 18)
__device__ __forceinline__ unsigned xb_ld(unsigned* p)              { return __hip_atomic_load(p, __ATOMIC_RELAXED, __HIP_MEMORY_SCOPE_AGENT); }
__device__ __forceinline__ unsigned xb_add(unsigned* p, unsigned v) { return __hip_atomic_fetch_add(p, v, __ATOMIC_RELAXED, __HIP_MEMORY_SCOPE_AGENT); }
__device__ __forceinline__ unsigned xb_xcc_id() { return (unsigned)__builtin_amdgcn_s_getreg((3 << 11) | 20) & 0xFu; }
#define XB_SPIN(cond, bar) do { unsigned _sp = 0; while (cond) { __builtin_amdgcn_s_sleep(1); \
    if ((++_sp & 255u) == 0u) { if (xb_ld(&(bar)[XB_TMO])) break; if (_sp > XB_SPIN_CAP) { atomicAdd(&(bar)[XB_TMO], 1u); break; } } } } while (0)
struct XcdBarrier { unsigned* bar; unsigned x; volatile LAS unsigned* st; };
__device__ __forceinline__ XcdBarrier xcd_barrier_post(unsigned* bar, volatile LAS unsigned* st, bool leader) {
    XcdBarrier b; b.bar = bar; b.x = xb_xcc_id(); b.st = st;
    if (leader) (void)xb_add(&bar[XB_XCNT(b.x)], 1u);
    return b;
}
__device__ __forceinline__ void xcd_barrier_complete(unsigned* bar, unsigned x, unsigned& nloc, unsigned& nx) {
    const unsigned G = gridDim.x * gridDim.y * gridDim.z;
    unsigned sum, cnt, mine, sp = 0u;
    for (;;) {
        sum = 0u; cnt = 0u; mine = 0u;
#pragma unroll
        for (unsigned j = 0; j < 16; ++j) { const unsigned c = xb_ld(&bar[XB_XCNT(j)]); sum += c; cnt += (c > 0u) ? 1u : 0u; mine = (j == x) ? c : mine; }
        if (sum == G) break;
        __builtin_amdgcn_s_sleep(1);
        if ((++sp & 255u) == 0u) { if (xb_ld(&bar[XB_TMO])) break; if (sp > XB_SPIN_CAP) { atomicAdd(&bar[XB_TMO], 1u); break; } }
    }
    nloc = mine > 0u ? mine : 1u; nx = cnt > 0u ? cnt : 1u;
}
__device__ __forceinline__ void xcd_barrier(const XcdBarrier& b, bool leader) {
    asm volatile("s_waitcnt vmcnt(0)" ::: "memory");
    __syncthreads();
    if (leader) {
        unsigned* bar = b.bar;
        __builtin_amdgcn_s_waitcnt(0);
        unsigned nloc = b.st[0], nx = b.st[1];
        if (nloc == 0u) { xcd_barrier_complete(bar, b.x, nloc, nx); b.st[0] = nloc; b.st[1] = nx; }
        const unsigned old = xb_add(&bar[XB_XSUB(b.x)], 1u);
        const unsigned gen = old / nloc;
        if (old + 1u == (gen + 1u) * nloc) {
            __builtin_amdgcn_fence(__ATOMIC_RELEASE, "agent");
            asm volatile("s_waitcnt vmcnt(0)" ::: "memory");
            const unsigned og = xb_add(&bar[XB_TOP], 1u);
            const unsigned tg = og / nx;
            if (og + 1u == (tg + 1u) * nx) xb_add(&bar[XB_TOPGEN], 1u);
            else XB_SPIN(xb_ld(&bar[XB_TOPGEN]) == tg, bar);
            __builtin_amdgcn_fence(__ATOMIC_ACQUIRE, "agent");
            asm volatile("s_waitcnt vmcnt(0)" ::: "memory");
        } else {
            XB_SPIN(xb_ld(&bar[XB_TOPGEN]) == gen, bar);
            __builtin_amdgcn_fence(__ATOMIC_ACQUIRE, "agent");
            asm volatile("s_waitcnt vmcnt(0)" ::: "memory");
        }
    }
    __syncthreads();
}

struct DepOrder : pg8::StaticOrder {
    unsigned* cnt; unsigned target; unsigned* tmo;
    __device__ __forceinline__ void a_ready(const pg8::Unit& u) const {
        const bool leader = (__builtin_amdgcn_readfirstlane((int)threadIdx.x >> 6) == 0) && (lane_id() == 0);
        if (leader) { unsigned* c_ = cnt + u.pm * 16; XB_SPIN(xb_ld(c_) < target, tmo); __builtin_amdgcn_fence(__ATOMIC_ACQUIRE, "agent"); asm volatile("s_waitcnt vmcnt(0)" ::: "memory"); }
        __syncthreads();
    }
};

__device__ __forceinline__ unsigned xcd_barrier_arrive(const XcdBarrier& b, bool leader) {
    unsigned gen = 0u;
    asm volatile("s_waitcnt vmcnt(0)" ::: "memory");
    __syncthreads();
    if (leader) {
        unsigned* bar = b.bar;
        __builtin_amdgcn_s_waitcnt(0);
        unsigned nloc = b.st[0], nx = b.st[1];
        if (nloc == 0u) { xcd_barrier_complete(bar, b.x, nloc, nx); b.st[0] = nloc; b.st[1] = nx; }
        const unsigned old = xb_add(&bar[XB_XSUB(b.x)], 1u);
        gen = old / nloc;
        if (old + 1u == (gen + 1u) * nloc) {
            __builtin_amdgcn_fence(__ATOMIC_RELEASE, "agent");
            asm volatile("s_waitcnt vmcnt(0)" ::: "memory");
            const unsigned og = xb_add(&bar[XB_TOP], 1u);
            const unsigned tg = og / nx;
            if (og + 1u == (tg + 1u) * nx) xb_add(&bar[XB_TOPGEN], 1u);
        }
    }
    return gen;
}
__device__ __forceinline__ void xcd_barrier_wait(const XcdBarrier& b, bool leader, unsigned gen) {
    if (leader) {
        XB_SPIN(xb_ld(&b.bar[XB_TOPGEN]) == gen, b.bar);
        __builtin_amdgcn_fence(__ATOMIC_ACQUIRE, "agent");
        asm volatile("s_waitcnt vmcnt(0)" ::: "memory");
    }
    __syncthreads();
}

struct Args { const float* in[23]; float* out; unsigned char* ws; int ph_lo, ph_hi; };
struct Ctx {
    LAS unsigned char* lds; int tid, lane, wave, G, bid;
    const Args* a; float* out; unsigned char* ws; float* ctlf;
    unsigned* pend;
    unsigned* qctr; unsigned tk;
};
#define QPUBLISH(F) do { if ((F).pend) { asm volatile("s_waitcnt vmcnt(0)" ::: "memory"); __syncthreads(); if ((F).tid == 0) (void)__hip_atomic_fetch_add((F).pend, 1u, __ATOMIC_RELAXED, __HIP_MEMORY_SCOPE_AGENT); (F).pend = nullptr; } } while (0)
#define QTICKET(F) do { QPUBLISH(F); if ((F).tid == 0) (F).tk = __hip_atomic_fetch_add((F).qctr, 1u, __ATOMIC_RELAXED, __HIP_MEMORY_SCOPE_AGENT); } while (0)
#define IN_XP 0
#define IN_XS 1
#define IN_MEM 2
#define IN_SCONV 3
#define IN_SGLA 4
#define IN_CSWK 5
#define IN_CSWV 6
#define IN_CMK 7
#define IN_CMV 8
#define IN_GNORM 9
#define IN_WIN 10
#define IN_CONVW 11
#define IN_WUP 12
#define IN_BA 13
#define IN_GGLAO 14
#define IN_GSWQ 15
#define IN_GSWK 16
#define IN_SINKS 17
#define IN_GMEM 18
#define IN_WMEM 19
#define IN_GMEMQ 20
#define IN_GMEMK 21
#define IN_WOUT 22

__device__ __forceinline__ int win_src_block(int nb) { if (nb >= 32) return nb; const int j = nb >> 2, t = nb & 3; return (t == 0 ? 8 : t == 1 ? 0 : t == 2 ? 16 : 24) + j; }
template <bool HASG>
__device__ __forceinline__ void p0_transpose_item(const float* W, const float* gk, int K, int N, int Npad, bf16_t* WT, LAS float* scr, int kb, int nb, int lane, int nbs = -1) {
    const int k0 = 64 * kb, n0 = 64 * nb, ns0 = 64 * (nbs < 0 ? nb : nbs), n4 = (lane & 15) * 4, kr = lane >> 4; const bool ok = (ns0 + n4) < N;
    f32x4 v[16];
#pragma unroll
    for (int i = 0; i < 16; ++i) { const int k = 4 * i + kr; v[i] = ok ? __builtin_nontemporal_load((const f32x4*)(W + (size_t)(k0 + k) * N + ns0 + n4)) : (f32x4){0.f, 0.f, 0.f, 0.f}; }
    float gv[16];
#pragma unroll
    for (int i = 0; i < 16; ++i) gv[i] = HASG ? gk[k0 + 4 * i + kr] : 1.f;
#pragma unroll
    for (int i = 0; i < 16; ++i) { const int k = 4 * i + kr; const float g = gv[i]; LAS float* d = scr + k * 65 + n4;
        d[0] = v[i].x * g; d[1] = v[i].y * g; d[2] = v[i].z * g; d[3] = v[i].w * g; }
    LDS_WAIT(); asm volatile("" ::: "memory");
    const int c = lane & 7;
#pragma unroll
    for (int j = 0; j < 8; ++j) { const int n = (lane >> 3) + 8 * j; const LAS float* s = scr + (8 * c) * 65 + n;
        u32x4 o; o.x = pk2(s[0 * 65], s[1 * 65]); o.y = pk2(s[2 * 65], s[3 * 65]); o.z = pk2(s[4 * 65], s[5 * 65]); o.w = pk2(s[6 * 65], s[7 * 65]);
        if (n0 + n < Npad) *(u32x4*)(WT + (size_t)(n0 + n) * K + k0 + 8 * c) = o; }
    LDS_WAIT(); asm volatile("" ::: "memory");
}
__device__ __forceinline__ void row_to_bf16(const float* xrow, bf16_t* orow, float* ss, int lane) {
    const f32x4* xr = (const f32x4*)xrow + lane; f32x4 v[8]; float s = 0.f;
#pragma unroll
    for (int j = 0; j < 8; ++j) { v[j] = __builtin_nontemporal_load(xr + 64 * j); s += (v[j].x * v[j].x + v[j].y * v[j].y) + (v[j].z * v[j].z + v[j].w * v[j].w); }
    s = wave_sum(s);
    u32x2* o8 = (u32x2*)orow + lane;
#pragma unroll
    for (int j = 0; j < 8; ++j) { u32x2 w; w.x = pk2(v[j].x, v[j].y); w.y = pk2(v[j].z, v[j].w); o8[64 * j] = w; }
    if (lane == 0) *ss = s;
}
__device__ __forceinline__ void p0_prologue(Ctx& F) {
    LAS float* scr = (LAS float*)(F.lds + F.wave * 16640);
    const int gw = F.bid * NWAVES + F.wave, NGW = F.G * NWAVES;
    constexpr int T_IN = 32 * 96, T_OUT = 32 * 32, T_MEM = 2 * 32 * 16, T_XP = NP, T_XS = NS, T_M = NMEMROWS;
    constexpr int NIT = T_IN + T_OUT + T_MEM + T_XP + T_XS + T_M;
    if (F.bid == 0) { for (int i = F.tid; i < 8192 + 64; i += NTHREADS) ((unsigned*)F.ctlf)[CW_Q + i] = 0u; }
    for (int i = gw * 64 + F.lane; i < NP + NS; i += NGW * 64) { if (i < NP) F.ctlf[CW_SSP + NP + i] = 0.f; else F.ctlf[CW_SSS + NS + (i - NP)] = 0.f; }
    for (int it = gw; it < NIT; it += NGW) {
        int r = it; { int ln_ = F.lane; asm volatile("" : "+v"(ln_)); F.lane = ln_; }
        if (r < T_IN) { p0_transpose_item<true>(F.a->in[IN_WIN], F.a->in[IN_GNORM], DM, DIN, PN, (bf16_t*)(F.ws + WS_WIN), scr, r / 96, r % 96, F.lane, win_src_block(r % 96)); continue; }
        r -= T_IN;
        if (r < T_OUT) { p0_transpose_item<false>(F.a->in[IN_WOUT], nullptr, DM, DM, DM, (bf16_t*)(F.ws + WS_WOUT), scr, r / 32, r % 32, F.lane); continue; }
        r -= T_OUT;
        if (r < T_MEM) { const int l = r / 512, q = r % 512;
            p0_transpose_item<true>(F.a->in[IN_WMEM] + (size_t)l * DM * 1024, F.a->in[IN_GMEM] + l * DM, DM, 1024, 1024, (bf16_t*)(F.ws + WS_WMEM) + (size_t)l * 1024 * DM, scr, q / 16, q % 16, F.lane); continue; }
        r -= T_MEM;
        if (r < T_XP) { row_to_bf16(F.a->in[IN_XP] + (size_t)r * DM, (bf16_t*)(F.ws + WS_XB) + (size_t)r * DM, F.ctlf + CW_SSP + r, F.lane); continue; }
        r -= T_XP;
        if (r < T_XS) { row_to_bf16(F.a->in[IN_XS] + (size_t)r * DM, (bf16_t*)(F.ws + WS_XS) + (size_t)r * DM, F.ctlf + CW_SSS + r, F.lane); continue; }
        r -= T_XS;
        row_to_bf16(F.a->in[IN_MEM] + (size_t)r * DM, (bf16_t*)(F.ws + WS_MEMA) + (size_t)r * DM, F.ctlf + CW_SSM + r, F.lane);
    }
}

__device__ __forceinline__ void cvt1_item(Ctx& F, int item) {
    QTICKET(F);
    LAS float* scr = (LAS float*)(F.lds + F.wave * 16640);
    const int w = item * 8 + F.wave;
    if (w < 32 * 96) p0_transpose_item<true>(F.a->in[IN_WIN] + (size_t)DM * DIN, F.a->in[IN_GNORM] + DM, DM, DIN, PN, (bf16_t*)(F.ws + WS_WIN + WIN_L), scr, w / 96, w % 96, F.lane, win_src_block(w % 96));
    else if (w < 32 * 96 + 32 * 32) { const int q = w - 32 * 96; p0_transpose_item<false>(F.a->in[IN_WOUT] + (size_t)DM * DM, nullptr, DM, DM, DM, (bf16_t*)(F.ws + WS_WOUT + WOUT_L), scr, q / 32, q % 32, F.lane); }
}

template <class Epi>
__device__ __forceinline__ void sg_unit(Ctx& F, const bf16_t* A, const bf16_t* Bt, const Epi& E) {
    constexpr int NSL = 6, D = 5, SLOT = 24576, BO = 16384;
    LAS unsigned char* lds = F.lds;
    const int tid = F.tid, fr = F.lane & 15, fq = F.lane >> 4, wm = F.wave & 3, wn = F.wave >> 2;
    unsigned voffA[2], voffB;
#pragma unroll
    for (int i = 0; i < 2; ++i) { int R, C; pg8::stage_rc(tid * 16 + i * 8192, R, C); voffA[i] = (unsigned)(R * DM + C) * 2u; if (i == 0) voffB = voffA[0]; }
    const unsigned ldsw = (unsigned)F.wave * 1024u;
    const int aoff = pg8::lds_byte(32 * wm + fr, 8 * fq), boff = BO + pg8::lds_byte(32 * wn + fr, 8 * fq);
#define SG_STAGE(t) do { const int so_ = ((t) % NSL) * SLOT; const char* ga_ = (const char*)A + (size_t)(t) * 128; const char* gb_ = (const char*)Bt + (size_t)(t) * 128; \
        _Pragma("unroll") for (int _i = 0; _i < 2; ++_i) { unsigned _vo = voffA[_i]; asm volatile("" : "+v"(_vo)); \
            __builtin_amdgcn_global_load_lds((const unsigned*)(ga_ + _vo), (LAS unsigned*)(lds + so_ + ldsw + _i * 8192), 16, 0, 0); } \
        { unsigned _vo = voffB; asm volatile("" : "+v"(_vo)); __builtin_amdgcn_global_load_lds((const unsigned*)(gb_ + _vo), (LAS unsigned*)(lds + so_ + BO + ldsw), 16, 0, 0); } } while (0)
    f32x4 acc[2][2];
#pragma unroll
    for (int a = 0; a < 2; ++a)
#pragma unroll
        for (int b = 0; b < 2; ++b) acc[a][b] = (f32x4){0.f, 0.f, 0.f, 0.f};
    QTICKET(F);
    __syncthreads();
#pragma unroll
    for (int t = 0; t < D; ++t) SG_STAGE(t);
    for (int t = 0; t < 32; ++t) {
        if (t + D <= 32) asm volatile("s_waitcnt vmcnt(12)" ::: "memory"); else asm volatile("s_waitcnt vmcnt(0)" ::: "memory");
        __builtin_amdgcn_s_barrier(); asm volatile("" ::: "memory");
        if (t + D < 32) SG_STAGE(t + D);
        const int so = (t % NSL) * SLOT;
        bf16x8 Af[2][2], Bf[2][2];
#pragma unroll
        for (int i = 0; i < 2; ++i)
#pragma unroll
            for (int ks = 0; ks < 2; ++ks) { Af[i][ks] = *(const LAS bf16x8*)(lds + so + aoff + i * 2048 + ks * 1024); Bf[i][ks] = *(const LAS bf16x8*)(lds + so + boff + i * 2048 + ks * 1024); }
        asm volatile("s_waitcnt lgkmcnt(0)" ::: "memory");
#pragma unroll
        for (int ks = 0; ks < 2; ++ks)
#pragma unroll
            for (int mi = 0; mi < 2; ++mi)
#pragma unroll
                for (int ni = 0; ni < 2; ++ni) acc[mi][ni] = MFMA16(Bf[ni][ks], Af[mi][ks], acc[mi][ni]);
    }
#undef SG_STAGE
    E(acc, wm, wn, fr, fq);
}
__device__ __forceinline__ void st16_sc1u(bf16_t* p, u32x4 v) { asm volatile("global_store_dwordx4 %0, %1, off sc1\n\ts_nop 1" :: "v"(p), "v"(v) : "memory"); }
__device__ __forceinline__ void pair16(const unsigned long long (&w)[4], bool odd, u32x4& o0, u32x4& o1) {
    const unsigned long long s0 = odd ? w[0] : w[1], s1 = odd ? w[2] : w[3];
    const unsigned long long r0 = __shfl_xor(s0, 16), r1 = __shfl_xor(s1, 16);
    const unsigned long long k0 = odd ? w[1] : w[0], k1 = odd ? w[3] : w[2];
    const unsigned long long lo0 = odd ? r0 : k0, hi0 = odd ? k0 : r0, lo1 = odd ? r1 : k1, hi1 = odd ? k1 : r1;
    o0.x = (unsigned)lo0; o0.y = (unsigned)(lo0 >> 32); o0.z = (unsigned)hi0; o0.w = (unsigned)(hi0 >> 32);
    o1.x = (unsigned)lo1; o1.y = (unsigned)(lo1 >> 32); o1.z = (unsigned)hi1; o1.w = (unsigned)(hi1 >> 32);
}
__device__ __forceinline__ void st16_sc1(float* p, f32x4 v) { asm volatile("global_store_dwordx4 %0, %1, off sc1\n\ts_nop 1" :: "v"(p), "v"(v) : "memory"); }
struct SgEpiBf16 { bf16_t* O; int ldc; const float* ss;
    __device__ __forceinline__ void operator()(const f32x4 (&acc)[2][2], int wm, int wn, int fr, int fq) const {
        const float sv[2] = {ss[32 * wm + fr], ss[32 * wm + 16 + fr]};
        unsigned long long w[4];
#pragma unroll
        for (int mi = 0; mi < 2; ++mi) { const float sc = rsqrtf(sv[mi] * (1.0f / DM) + EPS);
#pragma unroll
            for (int ni = 0; ni < 2; ++ni) { const f32x4 a = acc[mi][ni]; w[mi * 2 + ni] = (unsigned long long)pk2(a[0] * sc, a[1] * sc) | ((unsigned long long)pk2(a[2] * sc, a[3] * sc) << 32); } }
        const bool odd = (fq & 1) != 0; u32x4 o0, o1; pair16(w, odd, o0, o1);
        const int col = 32 * wn + (odd ? 16 : 0) + 4 * (fq & ~1);
        st16_sc1u(O + (size_t)(32 * wm + fr) * ldc + col, o0); st16_sc1u(O + (size_t)(32 * wm + 16 + fr) * ldc + col, o1); } };
struct SgEpiF32 { float* O; int ldc; const float* ss;
    __device__ __forceinline__ void operator()(const f32x4 (&acc)[2][2], int wm, int wn, int fr, int fq) const {
        const float sv[2] = {ss[32 * wm + fr], ss[32 * wm + 16 + fr]};
#pragma unroll
        for (int mi = 0; mi < 2; ++mi) { const int row = 32 * wm + 16 * mi + fr; const float sc = rsqrtf(sv[mi] * (1.0f / DM) + EPS);
#pragma unroll
            for (int ni = 0; ni < 2; ++ni) { const int col = 32 * wn + 16 * ni + 4 * fq; st16_sc1(O + (size_t)row * ldc + col, acc[mi][ni] * sc); } } } };
struct SgEpiOut { const float* base; float* out; bf16_t* xb; float* ssn;
    __device__ __forceinline__ void operator()(const f32x4 (&acc)[2][2], int wm, int wn, int fr, int fq) const {
        f32x4 bv[2][2];
#pragma unroll
        for (int mi = 0; mi < 2; ++mi)
#pragma unroll
            for (int ni = 0; ni < 2; ++ni) bv[mi][ni] = *(const f32x4*)(base + (size_t)(32 * wm + 16 * mi + fr) * DM + 32 * wn + 16 * ni + 4 * fq);
#pragma unroll
        for (int mi = 0; mi < 2; ++mi) { const int row = 32 * wm + 16 * mi + fr; float s = 0.f;
#pragma unroll
            for (int ni = 0; ni < 2; ++ni) { const int col = 32 * wn + 16 * ni + 4 * fq; const size_t o = (size_t)row * DM + col; const f32x4 y = bv[mi][ni] + acc[mi][ni]; *(f32x4*)(out + o) = y;
                if (xb) { u32x2 w; w.x = pk2(y[0], y[1]); w.y = pk2(y[2], y[3]); *(u32x2*)(xb + o) = w; s += (y[0] * y[0] + y[1] * y[1]) + (y[2] * y[2] + y[3] * y[3]); } }
            if (xb) { s += __shfl_xor(s, 16); s += __shfl_xor(s, 32); if (fq == 0) atomicAdd(ssn + row, s); } } } };

__device__ __forceinline__ void conv_unit(Ctx& F, int l, int cu) {
    const bf16_t* proj = (const bf16_t*)(F.ws + WS_PROJ); bf16_t* mix = (bf16_t*)(F.ws + WS_MIX);
    const int R0 = cu * 32, b = R0 >> 12, t0 = R0 & 4095, tg = F.tid >> 6, c8 = (F.tid & 63) * 8, ts = t0 + tg * 4;
    const float* cw = F.a->in[IN_CONVW] + l * 3 * 512;
    const bool halo = ts >= 2; const int th = halo ? ts - 2 : 0;
    const bf16_t* ph = proj + (size_t)(b * SEQ + th) * PN; const bf16_t* p0 = proj + (size_t)(b * SEQ + ts) * PN;
    u32x4 ru[6], rg[4];
#pragma unroll
    for (int i = 0; i < 2; ++i) ru[i] = *(const u32x4*)(ph + (size_t)i * PN + C_AC + c8);
#pragma unroll
    for (int i = 0; i < 4; ++i) { ru[2 + i] = *(const u32x4*)(p0 + (size_t)i * PN + C_AC + c8); rg[i] = __builtin_nontemporal_load((const u32x4*)(p0 + (size_t)i * PN + C_AB + c8)); }
    float w0[8], w1[8], w2[8], u[6][8];
#pragma unroll
    for (int j = 0; j < 8; ++j) { w0[j] = cw[c8 + j]; w1[j] = cw[512 + c8 + j]; w2[j] = cw[1024 + c8 + j]; }
    QTICKET(F);
#pragma unroll
    for (int i = 0; i < 6; ++i) { unpack8(ru[i], u[i]);
        if (i < 2 && !halo) {
#pragma unroll
            for (int j = 0; j < 8; ++j) u[i][j] = 0.f; } }
#pragma unroll
    for (int i = 0; i < 4; ++i) { const size_t row = (size_t)(b * SEQ + ts + i); float g[8], y[8]; unpack8(rg[i], g);
#pragma unroll
        for (int j = 0; j < 8; ++j) y[j] = g[j] * (w0[j] * u[i][j] + w1[j] * u[i + 1][j] + w2[j] * u[i + 2][j]);
        *(u32x4*)(mix + row * DM + c8) = pack8(y); }
}

__device__ __forceinline__ void swa_unit(Ctx& F, int l, int un) {
    constexpr int PK = 144, VOFF = 256 * PK;
    const bf16_t* proj = (const bf16_t*)(F.ws + WS_PROJ); bf16_t* mix = (bf16_t*)(F.ws + WS_MIX);
    LAS unsigned char* Kl = F.lds; LAS unsigned char* Vl = F.lds + VOFF;
    const int blk = un & 31, kvh = (un >> 5) & 1, b = un >> 6, t0 = blk * 128;
    const int fr = F.lane & 15, fq = F.lane >> 4;
    const int qi = 16 * F.wave + fr; const size_t row = (size_t)(b * SEQ + t0 + qi); const bf16_t* pr = proj + row * PN;
    u32x4 kraw[4], vraw[4], qraw[4][2];
#pragma unroll
    for (int i = 0; i < 4; ++i) { const int p = F.tid + 512 * i, kj = p >> 3, ch = p & 7, tok = t0 - 128 + kj; const int tk = tok >= 0 ? tok : 0;
        const bf16_t* pp = proj + (size_t)(b * SEQ + tk) * PN; kraw[i] = *(const u32x4*)(pp + C_SK + kvh * 64 + ch * 8); vraw[i] = *(const u32x4*)(pp + C_SV + kvh * 64 + ch * 8);
        if (tok < 0) { kraw[i] = (u32x4){0u, 0u, 0u, 0u}; vraw[i] = kraw[i]; } }
#pragma unroll
    for (int g = 0; g < 4; ++g) {
#pragma unroll
        for (int ks = 0; ks < 2; ++ks) qraw[g][ks] = *(const u32x4*)(pr + C_SQ + (kvh * 4 + g) * 64 + ks * 32 + fq * 8);
    }
    f32x4 gkv[2], gqv[2][2]; float sinkv[4];
    {   const float* gkp = F.a->in[IN_GSWK] + l * 64 + (F.tid & 7) * 8; gkv[0] = ((const f32x4*)gkp)[0]; gkv[1] = ((const f32x4*)gkp)[1];
        const float* gqp = F.a->in[IN_GSWQ] + l * 64;
#pragma unroll
        for (int ks = 0; ks < 2; ++ks) { gqv[ks][0] = *(const f32x4*)(gqp + ks * 32 + fq * 8); gqv[ks][1] = *(const f32x4*)(gqp + ks * 32 + fq * 8 + 4); }
        const float* skp = F.a->in[IN_SINKS] + l * 8 + kvh * 4;
#pragma unroll
        for (int g = 0; g < 4; ++g) sinkv[g] = skp[g]; }
    QTICKET(F);
    __syncthreads();
    {   const float gk[8] = {gkv[0].x, gkv[0].y, gkv[0].z, gkv[0].w, gkv[1].x, gkv[1].y, gkv[1].z, gkv[1].w};
        const bool wout = (blk == 31);
#pragma unroll
        for (int i = 0; i < 4; ++i) { const int p = F.tid + 512 * i, kj = p >> 3, ch = p & 7;
            float k[8]; unpack8(kraw[i], k); float ss = 0.f;
#pragma unroll
            for (int j = 0; j < 8; ++j) ss += k[j] * k[j];
            ss += __shfl_xor(ss, 1); ss += __shfl_xor(ss, 2); ss += __shfl_xor(ss, 4);
            const float rs = rsqrtf(ss * (1.f / 64.f) + EPS);
#pragma unroll
            for (int j = 0; j < 8; ++j) k[j] = k[j] * rs * gk[j];
            *(LAS u32x4*)(Kl + kj * PK + ch * 16) = pack8(k); *(LAS u32x4*)(Vl + kj * PK + ch * 16) = vraw[i];
            if (wout && kj >= 128) { const size_t o = ((size_t)(l * 2 + b) * 128 + (kj - 128)) * 128 + kvh * 64 + ch * 8; float v[8]; unpack8(vraw[i], v);
#pragma unroll
                for (int j = 0; j < 8; ++j) { F.out[O_SWKP + o + j] = k[j]; F.out[O_SWVP + o + j] = v[j]; } }
        }
    }
    __syncthreads();
    const int e = F.wave & ~1;
#define SCHED_FENCE() __builtin_amdgcn_sched_barrier(0)
#pragma unroll 1
    for (int g = 0; g < 4; ++g) {
        const int h = kvh * 4 + g;
        u32x2 zq[4];
#pragma unroll
        for (int db = 0; db < 4; ++db) zq[db] = *(const u32x2*)(pr + C_SZ + h * 64 + 16 * db + 4 * fq);
        bf16x8 kf[20];
#pragma unroll
        for (int kb = 0; kb < 10; ++kb)
#pragma unroll
            for (int ks = 0; ks < 2; ++ks) kf[2 * kb + ks] = *(const LAS bf16x8*)(Kl + (16 * (e + kb) + fr) * PK + (ks * 32 + fq * 8) * 2);
        bf16x8 Qf[2];
        {   float q[2][8]; float ss = 0.f;
#pragma unroll
            for (int ks = 0; ks < 2; ++ks) { unpack8(g == 0 ? qraw[0][ks] : g == 1 ? qraw[1][ks] : g == 2 ? qraw[2][ks] : qraw[3][ks], q[ks]);
#pragma unroll
                for (int j = 0; j < 8; ++j) ss += q[ks][j] * q[ks][j]; }
            ss += __shfl_xor(ss, 16); ss += __shfl_xor(ss, 32);
            const float rs = rsqrtf(ss * (1.f / 64.f) + EPS) * (0.125f * 1.4426950408889634f);
#pragma unroll
            for (int ks = 0; ks < 2; ++ks) {
#pragma unroll
                for (int j = 0; j < 8; ++j) q[ks][j] = q[ks][j] * rs * gqv[ks][j >> 2][j & 3];
                Qf[ks] = __builtin_bit_cast(bf16x8, pack8(q[ks])); }
        }
        SCHED_FENCE();
        f32x4 S[10];
#pragma unroll
        for (int kb = 0; kb < 10; ++kb) { f32x4 a = (f32x4){0.f, 0.f, 0.f, 0.f}; a = MFMA16(kf[2 * kb], Qf[0], a); a = MFMA16(kf[2 * kb + 1], Qf[1], a); S[kb] = a; }
        SCHED_FENCE();
        s16x4 vf[40];
#pragma unroll
        for (int p = 0; p < 5; ++p)
#pragma unroll
            for (int db = 0; db < 4; ++db) { vf[(p * 4 + db) * 2] = tr4(Vl, PK, 16 * (e + 2 * p) + 4 * fq, 16 * db, fr); vf[(p * 4 + db) * 2 + 1] = tr4(Vl, PK, 16 * (e + 2 * p + 1) + 4 * fq, 16 * db, fr); }
        SCHED_FENCE();
        const float sink = (g == 0 ? sinkv[0] : g == 1 ? sinkv[1] : g == 2 ? sinkv[2] : sinkv[3]) * 1.4426950408889634f;
        float m = sink;
#pragma unroll
        for (int kb = 0; kb < 10; ++kb) { const int d = e + kb - F.wave;
            const bool hidden = (d < 0) || (d > 8) || (blk == 0 && (e + kb) < 8);
            if (hidden) { S[kb] = (f32x4){-INFINITY, -INFINITY, -INFINITY, -INFINITY}; }
            else if (d == 0) {
#pragma unroll
                for (int i = 0; i < 4; ++i) if (4 * fq + i <= fr) S[kb][i] = -INFINITY; }
            else if (d == 8) {
#pragma unroll
                for (int i = 0; i < 4; ++i) if (4 * fq + i > fr) S[kb][i] = -INFINITY; }
#pragma unroll
            for (int i = 0; i < 4; ++i) m = fmaxf(m, S[kb][i]); }
        m = fmaxf(m, __shfl_xor(m, 16)); m = fmaxf(m, __shfl_xor(m, 32));
        float sum = 0.f;
#pragma unroll
        for (int kb = 0; kb < 10; ++kb)
#pragma unroll
            for (int i = 0; i < 4; ++i) { const float ev = __builtin_amdgcn_exp2f(S[kb][i] - m); S[kb][i] = ev; sum += ev; }
        sum += __shfl_xor(sum, 16); sum += __shfl_xor(sum, 32);
        sum += __builtin_amdgcn_exp2f(sink - m);
        const float inv = __builtin_amdgcn_rcpf(sum);
        bf16x8 Pb[5];
#pragma unroll
        for (int p = 0; p < 5; ++p) Pb[p] = pk8f(S[2 * p], S[2 * p + 1]);
        SCHED_FENCE();
        f32x4 o[4];
#pragma unroll
        for (int db = 0; db < 4; ++db) o[db] = (f32x4){0.f, 0.f, 0.f, 0.f};
#pragma unroll
        for (int p = 0; p < 5; ++p)
#pragma unroll
            for (int db = 0; db < 4; ++db) o[db] = MFMA16(cat8(vf[(p * 4 + db) * 2], vf[(p * 4 + db) * 2 + 1]), Pb[p], o[db]);
        SCHED_FENCE();
#pragma unroll
        for (int db = 0; db < 4; ++db) { const int d = 16 * db + 4 * fq; const u32x2 z = zq[db];
            u32x2 w; w.x = pk2(o[db][0] * inv * siluf(bflo(z.x)), o[db][1] * inv * siluf(bfhi(z.x))); w.y = pk2(o[db][2] * inv * siluf(bflo(z.y)), o[db][3] * inv * siluf(bfhi(z.y)));
            *(u32x2*)(mix + row * DM + 1024 + h * 64 + d) = w; }
    }
}

__device__ __forceinline__ void memfin_item(Ctx& F, int it) {
    const int rr = it * 8 + F.wave, lw = rr >> 9, rem = rr & 511, b = rem >> 8, m = rem & 255, head = F.lane >> 4, d0 = (F.lane & 15) * 8;
    const float* src = (const float*)(F.ws + WS_MEMKV) + (size_t)rem * 2048 + lw * 1024 + F.lane * 8;
    const f32x4 k0 = ((const f32x4*)src)[0], k1 = ((const f32x4*)src)[1], v0 = ((const f32x4*)(src + 512))[0], v1 = ((const f32x4*)(src + 512))[1];
    const float* g = F.a->in[IN_GMEMK] + lw * 128 + d0; const f32x4 g0 = ((const f32x4*)g)[0], g1 = ((const f32x4*)g)[1];
    QTICKET(F);
    float ss = (k0.x * k0.x + k0.y * k0.y) + (k0.z * k0.z + k0.w * k0.w) + (k1.x * k1.x + k1.y * k1.y) + (k1.z * k1.z + k1.w * k1.w);
    ss += __shfl_xor(ss, 1); ss += __shfl_xor(ss, 2); ss += __shfl_xor(ss, 4); ss += __shfl_xor(ss, 8);
    const float rs = rsqrtf(ss * (1.f / 128.f) + EPS);
    const f32x4 n0 = k0 * rs * g0, n1 = k1 * rs * g1;
    {   float nn = (n0.x * n0.x + n0.y * n0.y) + (n0.z * n0.z + n0.w * n0.w) + (n1.x * n1.x + n1.y * n1.y) + (n1.z * n1.z + n1.w * n1.w);
        nn += __shfl_xor(nn, 1); nn += __shfl_xor(nn, 2); nn += __shfl_xor(nn, 4); nn += __shfl_xor(nn, 8);
        if ((F.lane & 15) == 0) atomicMax((unsigned*)(F.ctlf + CW_KN2) + (lw * 2 + b) * 4 + head, __float_as_uint(nn)); }
    float* ko = F.out + O_MKP + ((size_t)(lw * 2 + b) * 256 + m) * 512 + F.lane * 8; float* vo = F.out + O_MVP + ((size_t)(lw * 2 + b) * 256 + m) * 512 + F.lane * 8;
    __builtin_nontemporal_store(n0, (f32x4*)ko); __builtin_nontemporal_store(n1, (f32x4*)ko + 1); __builtin_nontemporal_store(v0, (f32x4*)vo); __builtin_nontemporal_store(v1, (f32x4*)vo + 1);
    const size_t bo = ((size_t)((lw * 2 + b) * 4 + head) * 256 + m) * 128 + d0;
    u32x4 kw, vw; kw.x = pk2(n0.x, n0.y); kw.y = pk2(n0.z, n0.w); kw.z = pk2(n1.x, n1.y); kw.w = pk2(n1.z, n1.w);
    vw.x = pk2(v0.x, v0.y); vw.y = pk2(v0.z, v0.w); vw.z = pk2(v1.x, v1.y); vw.w = pk2(v1.z, v1.w);
    *(u32x4*)((bf16_t*)(F.ws + WS_MEMKB) + bo) = kw; *(u32x4*)((bf16_t*)(F.ws + WS_MEMVB) + bo) = vw;
}

template <bool SAMPLE>
__device__ __forceinline__ void mem_unit(Ctx& F, int l, int un) {
    constexpr int PK = 272, VOFF = 256 * PK;
    LAS unsigned char* Kl = F.lds; LAS unsigned char* Vl = F.lds + VOFF;
    const int fr = F.lane & 15, fq = F.lane >> 4;
    int b, h, qb;
    if (SAMPLE) { b = un >> 2; h = un & 3; qb = 0; } else { qb = un & 31; h = (un >> 5) & 3; b = un >> 7; }
    const bf16_t* proj; bf16_t* mix; size_t row;
    if (SAMPLE) { proj = (const bf16_t*)(F.ws + WS_PROJS); mix = (bf16_t*)(F.ws + WS_MIXS); row = (size_t)(b * DS + (fr & 3)); }
    else { proj = (const bf16_t*)(F.ws + WS_PROJ); mix = (bf16_t*)(F.ws + WS_MIX); row = (size_t)(b * SEQ + qb * 128 + 16 * F.wave + fr); }
    const bf16_t* pr = proj + row * PN;
    u32x4 qraw[4]; u32x2 zr[8];
#pragma unroll
    for (int ks = 0; ks < 4; ++ks) qraw[ks] = *(const u32x4*)(pr + C_MQ + h * 128 + ks * 32 + fq * 8);
#pragma unroll
    for (int db = 0; db < 8; ++db) zr[db] = *(const u32x2*)(pr + C_MZ + h * 128 + 16 * db + 4 * fq);
    QTICKET(F);
    if (!SAMPLE) {
        const bf16_t* kb = (const bf16_t*)(F.ws + WS_MEMKB) + (size_t)((l * 2 + b) * 4 + h) * 256 * 128; const bf16_t* vb = (const bf16_t*)(F.ws + WS_MEMVB) + (size_t)((l * 2 + b) * 4 + h) * 256 * 128;
        u32x4 kr[8], vr[8];
#pragma unroll
        for (int i = 0; i < 8; ++i) { const int p = F.tid + 512 * i; kr[i] = *(const u32x4*)(kb + (size_t)p * 8); vr[i] = *(const u32x4*)(vb + (size_t)p * 8); }
        __syncthreads();
#pragma unroll
        for (int i = 0; i < 8; ++i) { const int p = F.tid + 512 * i, m = p >> 4, ch = p & 15; *(LAS u32x4*)(Kl + m * PK + ch * 16) = kr[i]; *(LAS u32x4*)(Vl + m * PK + ch * 16) = vr[i]; }
    } else {
        const float* ck = F.a->in[IN_CMK] + (size_t)(l * DB + b) * 256 * 512 + h * 128; const float* cv = F.a->in[IN_CMV] + (size_t)(l * DB + b) * 256 * 512 + h * 128;
        {   f32x4 kr[16], vr[16];
#pragma unroll
            for (int i = 0; i < 16; ++i) { const int p = F.tid + 512 * i, m = p >> 5, c4 = p & 31; kr[i] = __builtin_nontemporal_load((const f32x4*)(ck + (size_t)m * 512 + c4 * 4)); vr[i] = __builtin_nontemporal_load((const f32x4*)(cv + (size_t)m * 512 + c4 * 4)); }
            __syncthreads();
#pragma unroll
            for (int i = 0; i < 16; ++i) { const int p = F.tid + 512 * i, m = p >> 5, c4 = p & 31;
                u32x2 kw, vw; kw.x = pk2(kr[i].x, kr[i].y); kw.y = pk2(kr[i].z, kr[i].w); vw.x = pk2(vr[i].x, vr[i].y); vw.y = pk2(vr[i].z, vr[i].w);
                *(LAS u32x2*)(Kl + m * PK + c4 * 8) = kw; *(LAS u32x2*)(Vl + m * PK + c4 * 8) = vw; } }
    }
    bf16x8 Qf[4];
    {   const float* gq = F.a->in[IN_GMEMQ] + l * 128; float q[4][8]; float ss = 0.f;
#pragma unroll
        for (int ks = 0; ks < 4; ++ks) { unpack8(qraw[ks], q[ks]);
#pragma unroll
            for (int j = 0; j < 8; ++j) ss += q[ks][j] * q[ks][j]; }
        ss += __shfl_xor(ss, 16); ss += __shfl_xor(ss, 32);
        const float rs = rsqrtf(ss * (1.f / 128.f) + EPS) * 0.08838834764831845f;
#pragma unroll
        for (int ks = 0; ks < 4; ++ks) {
#pragma unroll
            for (int j = 0; j < 8; ++j) q[ks][j] = q[ks][j] * rs * gq[ks * 32 + fq * 8 + j];
            Qf[ks] = __builtin_bit_cast(bf16x8, pack8(q[ks])); }
    }
    __syncthreads();
    if (SAMPLE && F.wave != 0) return;
    f32x4 S[16];
#pragma unroll
    for (int kb = 0; kb < 16; ++kb) { f32x4 a = (f32x4){0.f, 0.f, 0.f, 0.f};
#pragma unroll
        for (int ks = 0; ks < 4; ++ks) { const bf16x8 kf = *(const LAS bf16x8*)(Kl + (16 * kb + fr) * PK + (ks * 32 + fq * 8) * 2); a = MFMA16(kf, Qf[ks], a); }
        S[kb] = a; }
    float m = -INFINITY;
#pragma unroll
    for (int kb = 0; kb < 16; ++kb)
#pragma unroll
        for (int i = 0; i < 4; ++i) m = fmaxf(m, S[kb][i]);
    m = fmaxf(m, __shfl_xor(m, 16)); m = fmaxf(m, __shfl_xor(m, 32));
    float sum = 0.f;
#pragma unroll
    for (int kb = 0; kb < 16; ++kb)
#pragma unroll
        for (int i = 0; i < 4; ++i) { const float ev = __expf(S[kb][i] - m); S[kb][i] = ev; sum += ev; }
    sum += __shfl_xor(sum, 16); sum += __shfl_xor(sum, 32);
    const float inv = __builtin_amdgcn_rcpf(sum);
    f32x4 o[8];
#pragma unroll
    for (int db = 0; db < 8; ++db) o[db] = (f32x4){0.f, 0.f, 0.f, 0.f};
#pragma unroll
    for (int p = 0; p < 8; ++p) { const bf16x8 Pb = pk8f(S[2 * p] * inv, S[2 * p + 1] * inv);
#pragma unroll
        for (int db = 0; db < 8; ++db) { const bf16x8 Va = cat8(tr4(Vl, PK, 32 * p + 4 * fq, 16 * db, fr), tr4(Vl, PK, 32 * p + 16 + 4 * fq, 16 * db, fr));
            o[db] = MFMA16(Va, Pb, o[db]); } }
    if (SAMPLE && fr >= 4) return;
#pragma unroll
    for (int db = 0; db < 8; ++db) { const int d = 16 * db + 4 * fq;
        u32x2 w; w.x = pk2(o[db][0] * siluf(bflo(zr[db].x)), o[db][1] * siluf(bfhi(zr[db].x))); w.y = pk2(o[db][2] * siluf(bflo(zr[db].y)), o[db][3] * siluf(bfhi(zr[db].y)));
        *(u32x2*)(mix + row * DM + 1536 + h * 128 + d) = w; }
}

template <bool SC1>
__device__ __forceinline__ void memp_unit(Ctx& F, int l, int un) {
    constexpr int PK = 272, VOFF = 256 * PK;
    LAS unsigned char* Kl = F.lds; LAS unsigned char* Vl = F.lds + VOFF;
    const int fr = F.lane & 15, fq = F.lane >> 4;
    const int qb = un & 15, h = (un >> 4) & 3, b = un >> 6;
    const bf16_t* proj = (const bf16_t*)(F.ws + WS_PROJ); bf16_t* mix = (bf16_t*)(F.ws + WS_MIX);
    const size_t row0 = (size_t)(b * SEQ + qb * 256 + 32 * F.wave + fr);
    u32x4 qraw[2][4];
#pragma unroll
    for (int qq = 0; qq < 2; ++qq)
#pragma unroll
        for (int ks = 0; ks < 4; ++ks) qraw[qq][ks] = __builtin_nontemporal_load((const u32x4*)(proj + (row0 + 16 * qq) * PN + C_MQ + h * 128 + ks * 32 + fq * 8));
    f32x4 gqv[4][2];
#pragma unroll
    for (int ks = 0; ks < 4; ++ks) { const float* gqp = F.a->in[IN_GMEMQ] + l * 128 + ks * 32 + fq * 8; gqv[ks][0] = ((const f32x4*)gqp)[0]; gqv[ks][1] = ((const f32x4*)gqp)[1]; }
    const float kn2 = F.ctlf[CW_KN2 + (l * 2 + b) * 4 + h];
    {   const bf16_t* kb = (const bf16_t*)(F.ws + WS_MEMKB) + (size_t)((l * 2 + b) * 4 + h) * 256 * 128; const bf16_t* vb = (const bf16_t*)(F.ws + WS_MEMVB) + (size_t)((l * 2 + b) * 4 + h) * 256 * 128;
        u32x4 kr[8], vr[8];
#pragma unroll
        for (int i = 0; i < 8; ++i) { const int p = F.tid + 512 * i; kr[i] = *(const u32x4*)(kb + (size_t)p * 8); vr[i] = *(const u32x4*)(vb + (size_t)p * 8); }
        QTICKET(F);
        __syncthreads();
#pragma unroll
        for (int i = 0; i < 8; ++i) { const int p = F.tid + 512 * i, m = p >> 4, ch = p & 15; *(LAS u32x4*)(Kl + m * PK + ch * 16) = kr[i]; *(LAS u32x4*)(Vl + m * PK + ch * 16) = vr[i]; }
    }
    bf16x8 Qf[2][4]; float shift[2];
    {
#pragma unroll
        for (int qq = 0; qq < 2; ++qq) { float q[4][8]; float ss = 0.f, nn = 0.f;
#pragma unroll
            for (int ks = 0; ks < 4; ++ks) { unpack8(qraw[qq][ks], q[ks]);
#pragma unroll
                for (int j = 0; j < 8; ++j) ss += q[ks][j] * q[ks][j]; }
            ss += __shfl_xor(ss, 16); ss += __shfl_xor(ss, 32);
            const float rs = rsqrtf(ss * (1.f / 128.f) + EPS) * (0.08838834764831845f * 1.4426950408889634f);
#pragma unroll
            for (int ks = 0; ks < 4; ++ks) {
#pragma unroll
                for (int j = 0; j < 8; ++j) { q[ks][j] = q[ks][j] * rs * gqv[ks][j >> 2][j & 3]; nn += q[ks][j] * q[ks][j]; }
                Qf[qq][ks] = __builtin_bit_cast(bf16x8, pack8(q[ks])); }
            nn += __shfl_xor(nn, 16); nn += __shfl_xor(nn, 32);
            shift[qq] = sqrtf(nn * kn2) * 1.01f; }
    }
    __syncthreads();
    u32x2 zr2[2][8];
#pragma unroll
    for (int qq = 0; qq < 2; ++qq)
#pragma unroll
        for (int db = 0; db < 8; ++db) zr2[qq][db] = __builtin_nontemporal_load((const u32x2*)(proj + (row0 + 16 * qq) * PN + C_MZ + h * 128 + 16 * db + 4 * fq));
    f32x4 o[2][8]; float sum[2] = {0.f, 0.f};
#pragma unroll
    for (int qq = 0; qq < 2; ++qq)
#pragma unroll
        for (int db = 0; db < 8; ++db) o[qq][db] = (f32x4){0.f, 0.f, 0.f, 0.f};
#pragma unroll 2
    for (int p = 0; p < 8; ++p) {
        f32x4 S[2][2];
#pragma unroll
        for (int kk = 0; kk < 2; ++kk) { f32x4 a0 = (f32x4){0.f, 0.f, 0.f, 0.f}, a1 = a0;
#pragma unroll
            for (int ks = 0; ks < 4; ++ks) { const bf16x8 kf = *(const LAS bf16x8*)(Kl + (16 * (2 * p + kk) + fr) * PK + (ks * 32 + fq * 8) * 2); a0 = MFMA16(kf, Qf[0][ks], a0); a1 = MFMA16(kf, Qf[1][ks], a1); }
            S[0][kk] = a0; S[1][kk] = a1; }
        bf16x8 Pb[2];
#pragma unroll
        for (int qq = 0; qq < 2; ++qq) {
#pragma unroll
            for (int kk = 0; kk < 2; ++kk)
#pragma unroll
                for (int i = 0; i < 4; ++i) { const float ev = __builtin_amdgcn_exp2f(S[qq][kk][i] - shift[qq]); S[qq][kk][i] = ev; sum[qq] += ev; }
            Pb[qq] = pk8f(S[qq][0], S[qq][1]); }
#pragma unroll
        for (int db = 0; db < 8; ++db) { const bf16x8 Va = cat8(tr4(Vl, PK, 32 * p + 4 * fq, 16 * db, fr), tr4(Vl, PK, 32 * p + 16 + 4 * fq, 16 * db, fr));
            o[0][db] = MFMA16(Va, Pb[0], o[0][db]); o[1][db] = MFMA16(Va, Pb[1], o[1][db]); }
    }
#pragma unroll
    for (int qq = 0; qq < 2; ++qq) { float sm = sum[qq]; sm += __shfl_xor(sm, 16); sm += __shfl_xor(sm, 32); const float inv = __builtin_amdgcn_rcpf(sm);
        const size_t row = row0 + 16 * qq; unsigned long long wq[4];
#pragma unroll
        for (int db = 0; db < 8; ++db) { const int d = 16 * db + 4 * fq; const u32x2 z = zr2[qq][db];
            u32x2 w; w.x = pk2(o[qq][db][0] * inv * siluf(bflo(z.x)), o[qq][db][1] * inv * siluf(bfhi(z.x))); w.y = pk2(o[qq][db][2] * inv * siluf(bflo(z.y)), o[qq][db][3] * inv * siluf(bfhi(z.y)));
            if (!SC1) *(u32x2*)(mix + row * DM + 1536 + h * 128 + d) = w;
            else { wq[db & 3] = (unsigned long long)w.x | ((unsigned long long)w.y << 32);
                if ((db & 3) == 3) { const bool odd = (fq & 1) != 0; u32x4 o0, o1; pair16(wq, odd, o0, o1);
                    bf16_t* mp = mix + row * DM + 1536 + h * 128 + 16 * ((db & 4) + (odd ? 1 : 0)) + 4 * (fq & ~1); st16_sc1u(mp, o0); st16_sc1u(mp + 32, o1); } } } }
}

constexpr int GL_CUM = 0, GL_TOT = 16384, GL_GA = 16640, GL_SEG = 20736, GL_A = 24576;
struct GlaPar { float wu[16]; float bias; u32x4 garaw; };
__device__ __forceinline__ void gla_par_load(Ctx& F, int l, int h, const bf16_t* prow0, GlaPar& P) {
    const int dk = F.tid & 63;
    const float* wup = F.a->in[IN_WUP] + (size_t)l * 16 * 256 + h * 64 + dk; const float* bap = F.a->in[IN_BA] + l * 256 + h * 64 + dk;
#pragma unroll
    for (int r = 0; r < 16; ++r) P.wu[r] = wup[r * 256];
    P.bias = bap[0];
    const int t = F.tid & 127; P.garaw = *(const u32x4*)(prow0 + (size_t)(t >> 1) * PN + C_GA + (t & 1) * 8);
}
__device__ __forceinline__ void gla_cum(Ctx& F, const GlaPar& P) {
    LAS float* cumL = (LAS float*)(F.lds + GL_CUM); LAS float* totL = (LAS float*)(F.lds + GL_TOT); LAS float* gaL = (LAS float*)(F.lds + GL_GA); LAS float* segL = (LAS float*)(F.lds + GL_SEG);
    if (F.tid < 128) { const int s = F.tid >> 1, hf = F.tid & 1; float g[8]; unpack8(P.garaw, g);
#pragma unroll
        for (int j = 0; j < 8; ++j) gaL[s * 16 + hf * 8 + j] = g[j]; }
    const int dk = F.tid & 63, sg = F.tid >> 6;
    const float* wu = P.wu; const float bias = P.bias;
    __syncthreads();
    float c[8]; float run = 0.f;
#pragma unroll
    for (int i = 0; i < 8; ++i) { const int s = sg * 8 + i; float x = bias;
#pragma unroll
        for (int r = 0; r < 16; ++r) x += gaL[s * 16 + r] * wu[r];
        run += logsigf(x) * (1.f / 16.f); c[i] = run; }
    segL[sg * 64 + dk] = run;
    __syncthreads();
    float off = 0.f, tot = 0.f;
#pragma unroll
    for (int s2 = 0; s2 < 8; ++s2) { const float v = segL[s2 * 64 + dk]; tot += v; if (s2 < sg) off += v; }
#pragma unroll
    for (int i = 0; i < 8; ++i) cumL[(sg * 8 + i) * 64 + dk] = off + c[i];
    if (sg == 0) totL[dk] = tot;
    __syncthreads();
}
__device__ __forceinline__ void glaA_unit(Ctx& F, int l, int un) {
    constexpr int PKT = 144, PV = 272, KT = GL_A, VL = GL_A + 64 * PKT;
    const bf16_t* proj = (const bf16_t*)(F.ws + WS_PROJ);
    const int c = un & 63, h = (un >> 6) & 3, b = un >> 8, fr = F.lane & 15, fq = F.lane >> 4;
    const bf16_t* prow0 = proj + (size_t)(b * SEQ + c * 64) * PN;
    LAS float* cumL = (LAS float*)(F.lds + GL_CUM); LAS float* totL = (LAS float*)(F.lds + GL_TOT);
    const int s = F.tid >> 3, ch = F.tid & 7;
    const u32x4 kraw = *(const u32x4*)(prow0 + (size_t)s * PN + C_GK + h * 64 + ch * 8);
    u32x4 vraw[2];
#pragma unroll
    for (int i = 0; i < 2; ++i) { const int p = F.tid + 512 * i, s2 = p >> 4, c2 = p & 15; vraw[i] = *(const u32x4*)(prow0 + (size_t)s2 * PN + C_GV + h * 128 + c2 * 8); }
    GlaPar GP; gla_par_load(F, l, h, prow0, GP);
    QTICKET(F);
    __syncthreads();
    gla_cum(F, GP);
    {   float k[8]; unpack8(kraw, k);
        const f32x4 c0 = *(const LAS f32x4*)(cumL + s * 64 + ch * 8), c1 = *(const LAS f32x4*)(cumL + s * 64 + ch * 8 + 4);
        float* cg = (float*)(F.ws + WS_GLACUM) + (size_t)un * 4096 + s * 64 + ch * 8; *(f32x4*)cg = c0; *(f32x4*)(cg + 4) = c1;
        const float cm[8] = {c0.x, c0.y, c0.z, c0.w, c1.x, c1.y, c1.z, c1.w};
#pragma unroll
        for (int j = 0; j < 8; ++j) k[j] *= __expf(totL[ch * 8 + j] - cm[j]);
        *(LAS u32x4*)(F.lds + KT + s * PKT + ch * 16) = pack8(k);
#pragma unroll
        for (int i = 0; i < 2; ++i) { const int p = F.tid + 512 * i, s2 = p >> 4, c2 = p & 15; *(LAS u32x4*)(F.lds + VL + s2 * PV + c2 * 16) = vraw[i]; }
    }
    __syncthreads();
    f32x4 acc[4];
#pragma unroll
    for (int db = 0; db < 4; ++db) acc[db] = (f32x4){0.f, 0.f, 0.f, 0.f};
#pragma unroll
    for (int ks = 0; ks < 2; ++ks) { const bf16x8 Bv = cat8(tr4(F.lds + VL, PV, 32 * ks + 8 * fq, 16 * F.wave, fr), tr4(F.lds + VL, PV, 32 * ks + 8 * fq + 4, 16 * F.wave, fr));
#pragma unroll
        for (int db = 0; db < 4; ++db) { const bf16x8 Ak = cat8(tr4(F.lds + KT, PKT, 32 * ks + 8 * fq, 16 * db, fr), tr4(F.lds + KT, PKT, 32 * ks + 8 * fq + 4, 16 * db, fr));
            acc[db] = MFMA16(Bv, Ak, acc[db]); } }
    bf16_t* kv = (bf16_t*)(F.ws + WS_GLAKV) + (size_t)un * 8192;
    {   unsigned long long w[4];
#pragma unroll
        for (int db = 0; db < 4; ++db) w[db] = (unsigned long long)pk2(acc[db][0], acc[db][1]) | ((unsigned long long)pk2(acc[db][2], acc[db][3]) << 32);
        const bool odd = (fq & 1) != 0; u32x4 o0, o1; pair16(w, odd, o0, o1);
        bf16_t* kp = kv + (16 * (odd ? 1 : 0) + fr) * 128 + 16 * F.wave + 4 * (fq & ~1);
        st16_sc1u(kp, o0); st16_sc1u(kp + 32 * 128, o1); }
    if (F.tid < 64) __hip_atomic_store((float*)(F.ws + WS_GLADEC) + un * 64 + F.tid, __expf(totL[F.tid]), RLX_AGENT);
}
constexpr int GL2 = 51200;
__device__ __forceinline__ void glaA2_unit(Ctx& F, int l, int un2) {
    constexpr int PKT = 144, PV = 272, KT = GL_A, VL = GL_A + 64 * PKT;
    const bf16_t* proj = (const bf16_t*)(F.ws + WS_PROJ);
    const int cc = un2 & 31, h = (un2 >> 5) & 3, b = un2 >> 7, fr = F.lane & 15, fq = F.lane >> 4;
    const int s = F.tid >> 3, ch = F.tid & 7, dk = F.tid & 63, sg = F.tid >> 6;
    u32x4 kraw[2], vraw[2][2], garaw[2]; float wu[16], bias;
#pragma unroll
    for (int j = 0; j < 2; ++j) { const bf16_t* prow0 = proj + (size_t)(b * SEQ + (2 * cc + j) * 64) * PN;
        kraw[j] = *(const u32x4*)(prow0 + (size_t)s * PN + C_GK + h * 64 + ch * 8);
#pragma unroll
        for (int i = 0; i < 2; ++i) { const int p = F.tid + 512 * i, s2 = p >> 4, c2 = p & 15; vraw[j][i] = *(const u32x4*)(prow0 + (size_t)s2 * PN + C_GV + h * 128 + c2 * 8); }
        const int t = F.tid & 127; garaw[j] = *(const u32x4*)(prow0 + (size_t)(t >> 1) * PN + C_GA + (t & 1) * 8); }
    {   const float* wup = F.a->in[IN_WUP] + (size_t)l * 16 * 256 + h * 64 + dk; const float* bap = F.a->in[IN_BA] + l * 256 + h * 64 + dk;
#pragma unroll
        for (int r = 0; r < 16; ++r) wu[r] = wup[r * 256];
        bias = bap[0]; }
    QTICKET(F);
    if (F.tid < 256) { const int j = F.tid >> 7, t = F.tid & 127, s_ = t >> 1, hf = t & 1; float g[8]; unpack8(j == 0 ? garaw[0] : garaw[1], g); LAS float* gaL = (LAS float*)(F.lds + j * GL2 + GL_GA);
#pragma unroll
        for (int q = 0; q < 8; ++q) gaL[s_ * 16 + hf * 8 + q] = g[q]; }
    __syncthreads();
    float cp[2][8];
#pragma unroll
    for (int j = 0; j < 2; ++j) { const LAS float* gaL = (const LAS float*)(F.lds + j * GL2 + GL_GA); LAS float* segL = (LAS float*)(F.lds + j * GL2 + GL_SEG); float run = 0.f;
#pragma unroll
        for (int i = 0; i < 8; ++i) { const int s_ = sg * 8 + i; float x = bias;
#pragma unroll
            for (int r = 0; r < 16; ++r) x += gaL[s_ * 16 + r] * wu[r];
            run += logsigf(x) * (1.f / 16.f); cp[j][i] = run; }
        segL[sg * 64 + dk] = run; }
    __syncthreads();
#pragma unroll
    for (int j = 0; j < 2; ++j) { const LAS float* segL = (const LAS float*)(F.lds + j * GL2 + GL_SEG); LAS float* cumL = (LAS float*)(F.lds + j * GL2 + GL_CUM); LAS float* totL = (LAS float*)(F.lds + j * GL2 + GL_TOT);
        float off = 0.f, tot = 0.f;
#pragma unroll
        for (int s2 = 0; s2 < 8; ++s2) { const float v = segL[s2 * 64 + dk]; tot += v; if (s2 < sg) off += v; }
#pragma unroll
        for (int i = 0; i < 8; ++i) cumL[(sg * 8 + i) * 64 + dk] = off + cp[j][i];
        if (sg == 0) totL[dk] = tot; }
    __syncthreads();
#pragma unroll
    for (int j = 0; j < 2; ++j) { const int un = (b * 4 + h) * 64 + 2 * cc + j; LAS unsigned char* L = F.lds + j * GL2; const LAS float* cumL = (const LAS float*)(L + GL_CUM); const LAS float* totL = (const LAS float*)(L + GL_TOT);
        float k[8]; unpack8(kraw[j], k);
        const f32x4 c0 = *(const LAS f32x4*)(cumL + s * 64 + ch * 8), c1 = *(const LAS f32x4*)(cumL + s * 64 + ch * 8 + 4);
        float* cg = (float*)(F.ws + WS_GLACUM) + (size_t)un * 4096 + s * 64 + ch * 8; *(f32x4*)cg = c0; *(f32x4*)(cg + 4) = c1;
        const float cm[8] = {c0.x, c0.y, c0.z, c0.w, c1.x, c1.y, c1.z, c1.w};
#pragma unroll
        for (int q = 0; q < 8; ++q) k[q] *= __expf(totL[ch * 8 + q] - cm[q]);
        *(LAS u32x4*)(L + KT + s * PKT + ch * 16) = pack8(k);
#pragma unroll
        for (int i = 0; i < 2; ++i) { const int p = F.tid + 512 * i, s2 = p >> 4, c2 = p & 15; *(LAS u32x4*)(L + VL + s2 * PV + c2 * 16) = vraw[j][i]; } }
    __syncthreads();
#pragma unroll
    for (int j = 0; j < 2; ++j) { const int un = (b * 4 + h) * 64 + 2 * cc + j; LAS unsigned char* L = F.lds + j * GL2;
        f32x4 acc[4];
#pragma unroll
        for (int db = 0; db < 4; ++db) acc[db] = (f32x4){0.f, 0.f, 0.f, 0.f};
#pragma unroll
        for (int ks = 0; ks < 2; ++ks) { const bf16x8 Bv = cat8(tr4(L + VL, PV, 32 * ks + 8 * fq, 16 * F.wave, fr), tr4(L + VL, PV, 32 * ks + 8 * fq + 4, 16 * F.wave, fr));
#pragma unroll
            for (int db = 0; db < 4; ++db) { const bf16x8 Ak = cat8(tr4(L + KT, PKT, 32 * ks + 8 * fq, 16 * db, fr), tr4(L + KT, PKT, 32 * ks + 8 * fq + 4, 16 * db, fr));
                acc[db] = MFMA16(Bv, Ak, acc[db]); } }
        bf16_t* kv = (bf16_t*)(F.ws + WS_GLAKV) + (size_t)un * 8192;
        unsigned long long w[4];
#pragma unroll
        for (int db = 0; db < 4; ++db) w[db] = (unsigned long long)pk2(acc[db][0], acc[db][1]) | ((unsigned long long)pk2(acc[db][2], acc[db][3]) << 32);
        const bool odd = (fq & 1) != 0; u32x4 o0, o1; pair16(w, odd, o0, o1);
        bf16_t* kp = kv + (16 * (odd ? 1 : 0) + fr) * 128 + 16 * F.wave + 4 * (fq & ~1);
        st16_sc1u(kp, o0); st16_sc1u(kp + 32 * 128, o1); }
    if (F.tid < 128) { const int j = F.tid >> 6, d_ = F.tid & 63; const LAS float* totL = (const LAS float*)(F.lds + j * GL2 + GL_TOT);
        __hip_atomic_store((float*)(F.ws + WS_GLADEC) + ((b * 4 + h) * 64 + 2 * cc + j) * 64 + d_, __expf(totL[d_]), RLX_AGENT); }
}
__device__ __forceinline__ void gla_scan_item(Ctx& F, int l, int si) {
    const int gid = si * 512 + F.tid, bh = gid >> 13, d = (gid >> 7) & 63, v = gid & 127;
    const bf16_t* kv = (const bf16_t*)(F.ws + WS_GLAKV) + (size_t)bh * 64 * 8192 + d * 128 + v;
    const float* dec = (const float*)(F.ws + WS_GLADEC) + (size_t)bh * 64 * 64 + d;
    bf16_t* st = (bf16_t*)(F.ws + WS_GLAST) + (size_t)bh * 64 * 8192 + d * 128 + v;
    float S = 0.f;
    unsigned short kr[64]; float dd[64];
#pragma unroll
    for (int i = 0; i < 64; ++i) { kr[i] = __builtin_nontemporal_load(kv + (size_t)i * 8192); dd[i] = dec[i * 64]; }
    QTICKET(F);
#pragma unroll
    for (int i = 0; i < 64; ++i) { st[(size_t)i * 8192] = (bf16_t)f2bf(S); S = dd[i] * S + bf1(kr[i]); }
    __builtin_nontemporal_store(S, F.out + O_GLAP + ((size_t)(l * 8 + bh) * 64 + d) * 128 + v);
}
__device__ __forceinline__ void glaC_unit(Ctx& F, int l, int un) {
    constexpr int PQ = 144, PV = 272, QD = GL_A, KD = QD + 64 * PQ, VL = KD + 64 * PQ, SL = VL + 64 * PV, SSX = SL + 64 * PV;
    const bf16_t* proj = (const bf16_t*)(F.ws + WS_PROJ); bf16_t* mix = (bf16_t*)(F.ws + WS_MIX);
    const int c = un & 63, h = (un >> 6) & 3, b = un >> 8, fr = F.lane & 15, fq = F.lane >> 4;
    const bf16_t* prow0 = proj + (size_t)(b * SEQ + c * 64) * PN;
    LAS float* cumL = (LAS float*)(F.lds + GL_CUM);
    const int tb = F.wave & 3, vh = F.wave >> 2;
    const size_t row = (size_t)(b * SEQ + c * 64 + 16 * tb + fr);
    const int s = F.tid >> 3, ch = F.tid & 7;
    const u32x4 qraw = __builtin_nontemporal_load((const u32x4*)(prow0 + (size_t)s * PN + C_GQ + h * 64 + ch * 8)), kraw = __builtin_nontemporal_load((const u32x4*)(prow0 + (size_t)s * PN + C_GK + h * 64 + ch * 8));
    u32x4 vraw[2], sraw[2]; u32x2 zr[4]; f32x4 cmr[2];
    {   const float* cg = (const float*)(F.ws + WS_GLACUM) + (size_t)un * 4096 + s * 64 + ch * 8; cmr[0] = __builtin_nontemporal_load((const f32x4*)cg); cmr[1] = __builtin_nontemporal_load((const f32x4*)(cg + 4)); }
    {   const bf16_t* st = (const bf16_t*)(F.ws + WS_GLAST) + (size_t)un * 8192;
#pragma unroll
        for (int i = 0; i < 2; ++i) { const int p = F.tid + 512 * i, s2 = p >> 4, c2 = p & 15;
            vraw[i] = __builtin_nontemporal_load((const u32x4*)(prow0 + (size_t)s2 * PN + C_GV + h * 128 + c2 * 8)); sraw[i] = __builtin_nontemporal_load((const u32x4*)(st + s2 * 128 + c2 * 8)); }
#pragma unroll
        for (int vb = 0; vb < 4; ++vb) zr[vb] = __builtin_nontemporal_load((const u32x2*)(proj + row * PN + C_GZ + h * 128 + 16 * (4 * vh + vb) + 4 * fq));
    }
    f32x4 gov[4];
    const float* gop = F.a->in[IN_GGLAO] + l * 128 + 64 * vh + 4 * fq;
#pragma unroll
    for (int vb = 0; vb < 4; ++vb) gov[vb] = *(const f32x4*)(gop + 16 * vb);
    QTICKET(F);
    __syncthreads();
    {   float q[8], k[8]; unpack8(qraw, q); unpack8(kraw, k);
        const float cmv[8] = {cmr[0].x, cmr[0].y, cmr[0].z, cmr[0].w, cmr[1].x, cmr[1].y, cmr[1].z, cmr[1].w};
#pragma unroll
        for (int j = 0; j < 8; ++j) { const float cm = cmv[j]; q[j] *= 0.125f * __expf(cm); k[j] *= __expf(-cm); }
        *(LAS u32x4*)(F.lds + QD + s * PQ + ch * 16) = pack8(q); *(LAS u32x4*)(F.lds + KD + s * PQ + ch * 16) = pack8(k);
#pragma unroll
        for (int i = 0; i < 2; ++i) { const int p = F.tid + 512 * i, s2 = p >> 4, c2 = p & 15;
            *(LAS u32x4*)(F.lds + VL + s2 * PV + c2 * 16) = vraw[i]; *(LAS u32x4*)(F.lds + SL + s2 * PV + c2 * 16) = sraw[i]; }
    }
    __syncthreads();
    bf16x8 Qf[2];
#pragma unroll
    for (int ks = 0; ks < 2; ++ks) Qf[ks] = *(const LAS bf16x8*)(F.lds + QD + (16 * tb + fr) * PQ + (ks * 32 + fq * 8) * 2);
    f32x4 P[4];
#pragma unroll
    for (int sb = 0; sb < 4; ++sb) { f32x4 a = (f32x4){0.f, 0.f, 0.f, 0.f};
        if (sb <= tb) {
#pragma unroll
            for (int ks = 0; ks < 2; ++ks) { const bf16x8 kf = *(const LAS bf16x8*)(F.lds + KD + (16 * sb + fr) * PQ + (ks * 32 + fq * 8) * 2); a = MFMA16(kf, Qf[ks], a); }
            if (sb == tb) {
#pragma unroll
                for (int i = 0; i < 4; ++i) if (4 * fq + i > fr) a[i] = 0.f; } }
        P[sb] = a; }
    f32x4 o[4];
#pragma unroll
    for (int vb = 0; vb < 4; ++vb) o[vb] = (f32x4){0.f, 0.f, 0.f, 0.f};
#pragma unroll
    for (int p = 0; p < 2; ++p) {
        if (2 * p <= tb) { const bf16x8 Pb = pk8f(P[2 * p], P[2 * p + 1]);
#pragma unroll
            for (int vb = 0; vb < 4; ++vb) { const int v0 = 16 * (4 * vh + vb);
                const bf16x8 Va = cat8(tr4(F.lds + VL, PV, 32 * p + 4 * fq, v0, fr), tr4(F.lds + VL, PV, 32 * p + 16 + 4 * fq, v0, fr)); o[vb] = MFMA16(Va, Pb, o[vb]); } } }
#pragma unroll
    for (int ks = 0; ks < 2; ++ks)
#pragma unroll
        for (int vb = 0; vb < 4; ++vb) { const int v0 = 16 * (4 * vh + vb);
            const bf16x8 Sa = cat8(tr4(F.lds + SL, PV, 32 * ks + 8 * fq, v0, fr), tr4(F.lds + SL, PV, 32 * ks + 8 * fq + 4, v0, fr)); o[vb] = MFMA16(Sa, Qf[ks], o[vb]); }
    float ss = 0.f;
#pragma unroll
    for (int vb = 0; vb < 4; ++vb)
#pragma unroll
        for (int i = 0; i < 4; ++i) ss += o[vb][i] * o[vb][i];
    ss += __shfl_xor(ss, 16); ss += __shfl_xor(ss, 32);
    LAS float* ssx = (LAS float*)(F.lds + SSX);
    if (fq == 0) ssx[vh * 64 + 16 * tb + fr] = ss;
    __syncthreads();
    const float tot = ssx[16 * tb + fr] + ssx[64 + 16 * tb + fr];
    const float rs = rsqrtf(tot * (1.f / 128.f) + EPS);
    unsigned long long wq[4];
#pragma unroll
    for (int vb = 0; vb < 4; ++vb) { const f32x4 g = gov[vb];
        wq[vb] = (unsigned long long)pk2(o[vb][0] * rs * g[0] * siluf(bflo(zr[vb].x)), o[vb][1] * rs * g[1] * siluf(bfhi(zr[vb].x)))
               | ((unsigned long long)pk2(o[vb][2] * rs * g[2] * siluf(bflo(zr[vb].y)), o[vb][3] * rs * g[3] * siluf(bfhi(zr[vb].y))) << 32); }
    {   const bool odd = (fq & 1) != 0; u32x4 o0, o1; pair16(wq, odd, o0, o1);
        bf16_t* mp = mix + row * DM + 512 + h * 128 + 16 * (4 * vh + (odd ? 1 : 0)) + 4 * (fq & ~1); st16_sc1u(mp, o0); st16_sc1u(mp + 32, o1); }
}
__device__ __forceinline__ void sgla_unit(Ctx& F, int l, int un) {
    const int b = un >> 2, h = un & 3;
    const bf16_t* projs = (const bf16_t*)(F.ws + WS_PROJS); bf16_t* mixs = (bf16_t*)(F.ws + WS_MIXS);
    float S[16];
    {   const int v_ = F.tid & 127, dg_ = F.tid >> 7; const float* s0_ = F.a->in[IN_SGLA] + ((size_t)((l * DB + b) * 4 + h) * 64 + 16 * dg_) * 128 + v_;
#pragma unroll
        for (int i = 0; i < 16; ++i) S[i] = __builtin_nontemporal_load(s0_ + i * 128); }
    QTICKET(F);
    LAS float* aL = (LAS float*)F.lds; LAS float* qL = aL + 256; LAS float* kL = qL + 256; LAS float* vL = kL + 256; LAS float* part = vL + 512; LAS float* oL = part + 512;
    __syncthreads();
    {   const int t = F.tid >> 7, v = F.tid & 127; vL[t * 128 + v] = bf1(projs[(size_t)(b * DS + t) * PN + C_GV + h * 128 + v]); }
    if (F.tid < 256) { const int t = F.tid >> 6, dk = F.tid & 63; const bf16_t* pr = projs + (size_t)(b * DS + t) * PN;
        const float* wup = F.a->in[IN_WUP] + (size_t)l * 16 * 256 + h * 64 + dk; float x = F.a->in[IN_BA][l * 256 + h * 64 + dk];
        float wv[16]; const u32x4 g0 = *(const u32x4*)(pr + C_GA), g1 = *(const u32x4*)(pr + C_GA + 8); float gaf[16]; unpack8(g0, gaf); unpack8(g1, gaf + 8);
#pragma unroll
        for (int r = 0; r < 16; ++r) wv[r] = wup[r * 256];
#pragma unroll
        for (int r = 0; r < 16; ++r) x += gaf[r] * wv[r];
        aL[t * 64 + dk] = __expf(logsigf(x) * (1.f / 16.f)); qL[t * 64 + dk] = bf1(pr[C_GQ + h * 64 + dk]) * 0.125f; kL[t * 64 + dk] = bf1(pr[C_GK + h * 64 + dk]); }
    __syncthreads();
    const int v = F.tid & 127, dg = F.tid >> 7;
    for (int t = 0; t < 4; ++t) { float po = 0.f; const float vv = vL[t * 128 + v];
#pragma unroll
        for (int i = 0; i < 16; ++i) { const int dk = 16 * dg + i; S[i] = aL[t * 64 + dk] * S[i] + kL[t * 64 + dk] * vv; po += qL[t * 64 + dk] * S[i]; }
        part[dg * 128 + v] = po;
        __syncthreads();
        if (dg == 0) oL[t * 128 + v] = (part[v] + part[128 + v]) + (part[256 + v] + part[384 + v]);
        __syncthreads(); }
    float* so = F.out + O_GLAS + ((size_t)((l * DB + b) * 4 + h) * 64 + 16 * dg) * 128 + v;
#pragma unroll
    for (int i = 0; i < 16; ++i) __builtin_nontemporal_store(S[i], so + i * 128);
    if (F.wave < 4) { const int t = F.wave; const float o0 = oL[t * 128 + F.lane], o1 = oL[t * 128 + 64 + F.lane];
        const float ss = wave_sum(o0 * o0 + o1 * o1); const float rs = rsqrtf(ss * (1.f / 128.f) + EPS);
        const size_t row = (size_t)(b * DS + t); const float* go = F.a->in[IN_GGLAO] + l * 128;
        mixs[row * DM + 512 + h * 128 + F.lane] = (bf16_t)f2bf(o0 * rs * go[F.lane] * siluf(bf1(projs[row * PN + C_GZ + h * 128 + F.lane])));
        mixs[row * DM + 512 + h * 128 + 64 + F.lane] = (bf16_t)f2bf(o1 * rs * go[64 + F.lane] * siluf(bf1(projs[row * PN + C_GZ + h * 128 + 64 + F.lane]))); }
}
__device__ __forceinline__ void sswa_unit(Ctx& F, int l, int un) {
    constexpr int PK = 144, VOFF = 160 * PK;
    const int b = un >> 1, kvh = un & 1, fr = F.lane & 15, fq = F.lane >> 4;
    const bf16_t* projs = (const bf16_t*)(F.ws + WS_PROJS); bf16_t* mixs = (bf16_t*)(F.ws + WS_MIXS);
    LAS unsigned char* Kl = F.lds; LAS unsigned char* Vl = F.lds + VOFF;
    QTICKET(F);
    __syncthreads();
    {   const float* gk = F.a->in[IN_GSWK] + l * 64;
        for (int p = F.tid; p < 1536; p += 512) { const int j = p >> 3, ch = p & 7;
            float k[8], v[8];
#pragma unroll
            for (int q = 0; q < 8; ++q) { k[q] = 0.f; v[q] = 0.f; }
            if (j < 128) { const float* ck = F.a->in[IN_CSWK] + ((size_t)((l * DB + b) * 128 + j) * 2 + kvh) * 64 + ch * 8; const float* cv = F.a->in[IN_CSWV] + ((size_t)((l * DB + b) * 128 + j) * 2 + kvh) * 64 + ch * 8;
                const f32x4 a0 = __builtin_nontemporal_load((const f32x4*)ck), a1 = __builtin_nontemporal_load((const f32x4*)ck + 1), b0 = __builtin_nontemporal_load((const f32x4*)cv), b1 = __builtin_nontemporal_load((const f32x4*)cv + 1);
                k[0] = a0.x; k[1] = a0.y; k[2] = a0.z; k[3] = a0.w; k[4] = a1.x; k[5] = a1.y; k[6] = a1.z; k[7] = a1.w;
                v[0] = b0.x; v[1] = b0.y; v[2] = b0.z; v[3] = b0.w; v[4] = b1.x; v[5] = b1.y; v[6] = b1.z; v[7] = b1.w; }
            else if (j < 132) { const bf16_t* pr = projs + (size_t)(b * DS + (j - 128)) * PN; unpack8(*(const u32x4*)(pr + C_SK + kvh * 64 + ch * 8), k); unpack8(*(const u32x4*)(pr + C_SV + kvh * 64 + ch * 8), v); }
            float ss = 0.f;
#pragma unroll
            for (int q = 0; q < 8; ++q) ss += k[q] * k[q];
            ss += __shfl_xor(ss, 1); ss += __shfl_xor(ss, 2); ss += __shfl_xor(ss, 4);
            if (j >= 128) { const float rs = rsqrtf(ss * (1.f / 64.f) + EPS);
#pragma unroll
                for (int q = 0; q < 8; ++q) k[q] = k[q] * rs * gk[ch * 8 + q]; }
            if (j < 160) { *(LAS u32x4*)(Kl + j * PK + ch * 16) = pack8(k); *(LAS u32x4*)(Vl + j * PK + ch * 16) = pack8(v); }
            if (j >= 4 && j < 132) { const size_t o = ((size_t)((l * DB + b) * 128 + (j - 4)) * 2 + kvh) * 64 + ch * 8;
                { f32x4 t0 = {k[0], k[1], k[2], k[3]}, t1 = {k[4], k[5], k[6], k[7]}, t2 = {v[0], v[1], v[2], v[3]}, t3 = {v[4], v[5], v[6], v[7]};
                  __builtin_nontemporal_store(t0, (f32x4*)(F.out + O_SWKS + o)); __builtin_nontemporal_store(t1, (f32x4*)(F.out + O_SWKS + o + 4)); __builtin_nontemporal_store(t2, (f32x4*)(F.out + O_SWVS + o)); __builtin_nontemporal_store(t3, (f32x4*)(F.out + O_SWVS + o + 4)); } }
        }
    }
    __syncthreads();
    if (F.wave != 0) return;
    const int t = fr & 3, h = kvh * 4 + (fr >> 2); const size_t row = (size_t)(b * DS + t); const bf16_t* pr = projs + row * PN;
    bf16x8 Qf[2];
    {   const float* gq = F.a->in[IN_GSWQ] + l * 64; float q[2][8]; float ss = 0.f;
#pragma unroll
        for (int ks = 0; ks < 2; ++ks) { unpack8(*(const u32x4*)(pr + C_SQ + h * 64 + ks * 32 + fq * 8), q[ks]);
#pragma unroll
            for (int j = 0; j < 8; ++j) ss += q[ks][j] * q[ks][j]; }
        ss += __shfl_xor(ss, 16); ss += __shfl_xor(ss, 32);
        const float rs = rsqrtf(ss * (1.f / 64.f) + EPS) * 0.125f;
#pragma unroll
        for (int ks = 0; ks < 2; ++ks) {
#pragma unroll
            for (int j = 0; j < 8; ++j) q[ks][j] = q[ks][j] * rs * gq[ks * 32 + fq * 8 + j];
            Qf[ks] = __builtin_bit_cast(bf16x8, pack8(q[ks])); }
    }
    f32x4 S[10];
#pragma unroll
    for (int kb = 0; kb < 10; ++kb) { f32x4 a = (f32x4){0.f, 0.f, 0.f, 0.f};
#pragma unroll
        for (int ks = 0; ks < 2; ++ks) { const bf16x8 kf = *(const LAS bf16x8*)(Kl + (16 * kb + fr) * PK + (ks * 32 + fq * 8) * 2); a = MFMA16(kf, Qf[ks], a); }
        S[kb] = a; }
    const float sink = F.a->in[IN_SINKS][l * 8 + h];
    float m = sink;
#pragma unroll
    for (int kb = 0; kb < 10; ++kb)
#pragma unroll
        for (int i = 0; i < 4; ++i) { const int kj = 16 * kb + 4 * fq + i; const bool valid = (kj >= t + 1) && (kj <= t + 128);
            if (!valid) S[kb][i] = -INFINITY; m = fmaxf(m, S[kb][i]); }
    m = fmaxf(m, __shfl_xor(m, 16)); m = fmaxf(m, __shfl_xor(m, 32));
    float sum = 0.f;
#pragma unroll
    for (int kb = 0; kb < 10; ++kb)
#pragma unroll
        for (int i = 0; i < 4; ++i) { const float ev = __expf(S[kb][i] - m); S[kb][i] = ev; sum += ev; }
    sum += __shfl_xor(sum, 16); sum += __shfl_xor(sum, 32);
    sum += __expf(sink - m);
    const float inv = __builtin_amdgcn_rcpf(sum);
    f32x4 o[4];
#pragma unroll
    for (int db = 0; db < 4; ++db) o[db] = (f32x4){0.f, 0.f, 0.f, 0.f};
#pragma unroll
    for (int p = 0; p < 5; ++p) { const bf16x8 Pb = pk8f(S[2 * p] * inv, S[2 * p + 1] * inv);
#pragma unroll
        for (int db = 0; db < 4; ++db) { const bf16x8 Va = cat8(tr4(Vl, PK, 32 * p + 4 * fq, 16 * db, fr), tr4(Vl, PK, 32 * p + 16 + 4 * fq, 16 * db, fr)); o[db] = MFMA16(Va, Pb, o[db]); } }
#pragma unroll
    for (int db = 0; db < 4; ++db) { const int d = 16 * db + 4 * fq; const u32x2 zr = *(const u32x2*)(pr + C_SZ + h * 64 + d);
        u32x2 w; w.x = pk2(o[db][0] * siluf(bflo(zr.x)), o[db][1] * siluf(bfhi(zr.x))); w.y = pk2(o[db][2] * siluf(bflo(zr.y)), o[db][3] * siluf(bfhi(zr.y)));
        *(u32x2*)(mixs + row * DM + 1024 + h * 64 + d) = w; }
}
__device__ __forceinline__ void sconv_unit(Ctx& F, int l, int b) {
    const bf16_t* projs = (const bf16_t*)(F.ws + WS_PROJS); bf16_t* mixs = (bf16_t*)(F.ws + WS_MIXS);
    QTICKET(F);
    const int ch = F.tid; const float* cw = F.a->in[IN_CONVW] + l * 3 * 512; const float w0 = cw[ch], w1 = cw[512 + ch], w2 = cw[1024 + ch];
    float um2 = F.a->in[IN_SCONV][((size_t)(l * DB + b) * 2 + 0) * 512 + ch], um1 = F.a->in[IN_SCONV][((size_t)(l * DB + b) * 2 + 1) * 512 + ch];
    float ac[4], ah[4], ab[4], az[4];
#pragma unroll
    for (int t = 0; t < 4; ++t) { const bf16_t* pr = projs + (size_t)(b * DS + t) * PN + 256 * (ch >> 6) + (ch & 63); ac[t] = bf1(pr[0]); ab[t] = bf1(pr[64]); ah[t] = bf1(pr[128]); az[t] = bf1(pr[192]); }
#pragma unroll
    for (int t = 0; t < 4; ++t) { const size_t row = (size_t)(b * DS + t);
        const float u = ac[t] * ah[t]; const float o = w0 * um2 + w1 * um1 + w2 * u;
        mixs[row * DM + ch] = (bf16_t)f2bf(ab[t] * o * siluf(az[t]));
        um2 = um1; um1 = u; }
    F.out[O_CONVS + ((size_t)(l * DB + b) * 2 + 0) * 512 + ch] = um2; F.out[O_CONVS + ((size_t)(l * DB + b) * 2 + 1) * 512 + ch] = um1;
}

#ifndef TPA
#define TPA -1
#endif
#ifndef TPB
#define TPB -1
#endif
constexpr int CW_TS = 120000;
constexpr int N_PHASES = 11;
__global__ void __launch_bounds__(NTHREADS, 2) hymba_fwd(const Args args) {
    extern __shared__ __attribute__((aligned(16))) unsigned char lds_raw[];
    Ctx F;
    const int wave_s = __builtin_amdgcn_readfirstlane((int)threadIdx.x >> 6);
#define LEADER (wave_s == 0 && lane_id() == 0)
    F.lds = (LAS unsigned char*)lds_raw; F.tid = wave_s * 64 + lane_id(); F.lane = F.tid & 63; F.wave = wave_s; F.G = gridDim.x; F.bid = blockIdx.x;
    F.a = &args;
    F.pend = nullptr;
    F.out = args.out; F.ws = args.ws; F.ctlf = (float*)(args.ws + WS_CTL);
    volatile LAS unsigned* MISC = (volatile LAS unsigned*)(F.lds + MISC_OFF);
    if (F.tid < 64) MISC[F.tid] = 0u;
    __syncthreads();
    XcdBarrier bar; bar.bar = (unsigned*)(args.ws + WS_CTL) + CW_BAR; bar.x = 0; bar.st = nullptr;
    if (MK_N_LAUNCHES == 1) bar = xcd_barrier_post((unsigned*)(args.ws + WS_CTL) + CW_BAR, MISC + 8, LEADER);
    const int lo = args.ph_lo, hi = args.ph_hi;
#define IN(k) (lo <= (k) && (k) < hi)
#define STAMP(k) do { if (TPA >= 0 && F.bid == 0 && LEADER) ((unsigned long long*)(F.ctlf + CW_TS))[k] = __builtin_amdgcn_s_memrealtime(); } while (0)
#define SEAM(k) do { if (IN(k) && IN((k) + 1)) { xcd_barrier(bar, LEADER); STAMP((k) + 1); } } while (0)
#define PHASE_ENTER() do { int t_ = wave_s * 64 + lane_id(); asm volatile("" : "+v"(t_)); F.tid = t_; F.lane = t_ & 63; F.wave = __builtin_amdgcn_readfirstlane(t_ >> 6); } while (0)
#define QUEUE_BEGIN(ph, NIT) { const int qg_ = F.bid & 7; F.qctr = (unsigned*)(args.ws + WS_CTL) + CW_Q + ((ph) * 8 + qg_) * 64; int it = qg_ + 8 * (F.bid >> 3); \
        while (it < (NIT)) { F.tk = 0u; PHASE_ENTER();
#define QUEUE_END() __syncthreads(); if (F.tid == 0) MISC[16] = (unsigned)(F.bid & 7) + 8u * ((unsigned)(F.G >> 3) + F.tk); __syncthreads(); it = __builtin_amdgcn_readfirstlane((int)MISC[16]); } }

    STAMP(0);
    if (IN(0)) { PHASE_ENTER(); p0_prologue(F); }
    SEAM(0);
    for (int l = 0; l < 2; ++l) {
        const int pb = 1 + 5 * l;
        float* ssP = F.ctlf + CW_SSP + l * NP; float* ssS = F.ctlf + CW_SSS + l * NS;
        bf16_t* WinT = (bf16_t*)(F.ws + WS_WIN + l * WIN_L); bf16_t* WoutT = (bf16_t*)(F.ws + WS_WOUT + l * WOUT_L);
        if (IN(pb)) {
            pg8::Gemm g{(const bf16_t*)(F.ws + WS_XB), WinT, NP, PN, DM}; pg8::StaticOrder S; S.init(NP, PN, F.G, F.bid);
            pg8::EpiProj E{(bf16_t*)(F.ws + WS_PROJ), PN, ssP, F.out + O_CONVP + (size_t)l * 2 * 2 * 512};
            pg8::gemm_phase<pg8::EpiProj, pg8::StaticOrder, true, true>(F.lds, g, S, E, wave_s);
        }
        unsigned bgen = 0u; bool bwait = false;
        if (IN(pb) && IN(pb + 1)) { bgen = xcd_barrier_arrive(bar, LEADER); bwait = true; }
        if (IN(pb + 1)) {
            unsigned* dep = (unsigned*)(args.ws + WS_CTL) + CW_DEP + l * 256;
            const int a1 = 96, a2 = a1 + 128, a3 = a2 + 128, a4 = a3 + 256, a5 = a4, a6 = a5 + (l == 0 ? 171 : 0);
            const int c1 = a6 + (l == 0 ? 128 : 0), c2 = c1 + 128, c3 = c2 + 128, c4 = c3 + 64, c5 = c4 + 32, c6 = c5 + 128, c7 = c6 + 256, NIT = c7 + (l == 0 ? 171 : 0);
            bool depS = false, depG = false;
            QUEUE_BEGIN(pb + 1, NIT)
                unsigned* done_ = nullptr;
                if (bwait && !(it < (l == 0 ? a2 : a1))) { xcd_barrier_wait(bar, LEADER, bgen); STAMP(pb + 1); bwait = false; }
                if (it >= a6 && it < c5 && !depS) {
                    QPUBLISH(F);
                    if (F.tid == 0) {
                        XB_SPIN(xb_ld(dep) < 96u || (l == 0 && xb_ld(dep + 128) < 128u), bar.bar);
                        __builtin_amdgcn_fence(__ATOMIC_ACQUIRE, "agent");
                        asm volatile("s_waitcnt vmcnt(0)" ::: "memory");
                    }
                    __syncthreads();
                    depS = true;
                }
                if (it >= c5 && it < c6 && !depG) {
                    QPUBLISH(F);
                    if (F.tid == 0) {
                        XB_SPIN(xb_ld(dep + 64) < 256u, bar.bar);
                        __builtin_amdgcn_fence(__ATOMIC_ACQUIRE, "agent");
                        asm volatile("s_waitcnt vmcnt(0)" ::: "memory");
                    }
                    __syncthreads();
                    depG = true;
                }
                if (it < a1) { SgEpiBf16 E{(bf16_t*)(F.ws + WS_PROJS) + it * 64, PN, ssS}; sg_unit(F, (const bf16_t*)(F.ws + WS_XS), WinT + (size_t)it * 64 * DM, E); done_ = dep; }
                else if (it < a2) {
                    if (l == 0) { const int q = it - a1, rb = q >> 5, cb = q & 31;
                        SgEpiF32 E{(float*)(F.ws + WS_MEMKV) + (size_t)rb * 128 * 2048 + cb * 64, 2048, F.ctlf + CW_SSM + rb * 128};
                        sg_unit(F, (const bf16_t*)(F.ws + WS_MEMA) + (size_t)rb * 128 * DM, (const bf16_t*)(F.ws + WS_WMEM) + (size_t)cb * 64 * DM, E); done_ = dep + 128; }
                    else memp_unit<false>(F, l, it - a1); }
                else if (it < a3) swa_unit(F, l, it - a2);
                else if (it < a4) { glaA2_unit(F, l, it - a3); done_ = dep + 64; }
                else if (it < a6) cvt1_item(F, it - a5);
                else if (it < c1) memfin_item(F, it - a6);
                else if (it < c2) mem_unit<true>(F, l, it - c1);
                else if (it < c3) sgla_unit(F, l, it - c2);
                else if (it < c4) sswa_unit(F, l, it - c3);
                else if (it < c5) sconv_unit(F, l, it - c4);
                else if (it < c6) gla_scan_item(F, l, it - c5);
                else if (it < c7) conv_unit(F, l, it - c6);
                else cvt1_item(F, 171 + it - c7);
                F.pend = done_;
            QUEUE_END()
            QPUBLISH(F);
        }
        if (bwait) { xcd_barrier_wait(bar, LEADER, bgen); bwait = false; }
        SEAM(pb + 2);
        unsigned* rdy = (unsigned*)(args.ws + WS_CTL) + CW_RDY + l * 512;
        if (IN(pb + 3)) {
            const int n1 = 32, n2 = n1 + (l == 0 ? 128 : 0), n3 = n2 + 512, NIT = n3 + (l == 0 ? 170 : 0);
            QUEUE_BEGIN(pb + 3, NIT)
                unsigned* done_ = nullptr;
                if (it < n1) { SgEpiOut E{(l == 0 ? F.a->in[IN_XS] : F.out + O_YS) + it * 64, F.out + O_YS + it * 64, l == 0 ? (bf16_t*)(F.ws + WS_XS) + it * 64 : nullptr, F.ctlf + CW_SSS + NS};
                    sg_unit(F, (const bf16_t*)(F.ws + WS_MIXS), WoutT + (size_t)it * 64 * DM, E); }
                else if (it < n2) { const int q = it - n1, h = q & 3, qb = (q >> 2) & 15, b = q >> 6; memp_unit<true>(F, l, b * 64 + h * 16 + qb); done_ = rdy + (b * 16 + qb) * 16; }
                else if (it < n3) { const int q = it - n2, h = q & 3, c = (q >> 2) & 63, b = q >> 8; glaC_unit(F, l, (b * 4 + h) * 64 + c); done_ = rdy + (b * 16 + (c >> 2)) * 16; }
                else cvt1_item(F, 342 + it - n3);
                F.pend = done_;
            QUEUE_END()
            QPUBLISH(F);
        }
        if (IN(pb + 4)) {
            pg8::Gemm g{(const bf16_t*)(F.ws + WS_MIX), WoutT, NP, DM, DM}; DepOrder S; S.init(NP, DM, F.G, F.bid); S.cnt = rdy; S.target = (l == 0 ? 20u : 16u); S.tmo = bar.bar;
            if (l == 0) { pg8::EpiOut<false> E{nullptr, nullptr, (bf16_t*)(F.ws + WS_XB), F.ctlf + CW_SSP + NP}; pg8::gemm_phase<pg8::EpiOut<false>, DepOrder, false, true>(F.lds, g, S, E, wave_s); }
            else { pg8::EpiOut<true> E{nullptr, F.out + O_YP, (bf16_t*)(F.ws + WS_XB), nullptr}; pg8::gemm_phase<pg8::EpiOut<true>, DepOrder, false, true>(F.lds, g, S, E, wave_s); }
        }
        if (l == 0) SEAM(pb + 4);
    }
    if (TPA >= 0) {
        xcd_barrier(bar, LEADER); STAMP(11);
        if (F.bid == 0) { __syncthreads();
            const unsigned long long* ts = (const unsigned long long*)(F.ctlf + CW_TS);
            const float T1 = (float)(ts[TPA + 1] - ts[TPA]) * 0.01f, T2 = (float)(ts[TPB + 1] - ts[TPB]) * 0.01f;
            float* cp = F.out + O_CONVP; const float sc = 1.f + T1 * 0.001f;
            for (int i = wave_s * 64 + lane_id(); i < 4096; i += NTHREADS) cp[i] *= sc;
            if (LEADER) F.out[O_YP] += T2 * 0.25f; }
    }
#undef IN
#undef SEAM
}

extern "C" void kernel_launch(void* const* d_in, const int* in_sizes, int n_in, void* d_out, int out_size, void* d_ws, size_t ws_size, hipStream_t stream) {
    static int grid = 0;
    if (grid == 0) {
        if (n_in != 23 || out_size != (int)O_END || ws_size < WS_END) { fprintf(stderr, "kernel_launch: unexpected shapes (n_in %d out %d ws %zu)\n", n_in, out_size, ws_size); grid = -1; return; }
        int dev = 0, cus = 0, per_cu = 0;
        if (hipGetDevice(&dev) != hipSuccess || hipDeviceGetAttribute(&cus, hipDeviceAttributeMultiprocessorCount, dev) != hipSuccess) { grid = -1; return; }
        if (hipFuncSetAttribute((const void*)hymba_fwd, hipFuncAttributeMaxDynamicSharedMemorySize, LDS_BYTES) != hipSuccess) { fprintf(stderr, "kernel_launch: hipFuncSetAttribute failed\n"); grid = -1; return; }
        if (hipOccupancyMaxActiveBlocksPerMultiprocessor(&per_cu, (const void*)hymba_fwd, NTHREADS, LDS_BYTES) != hipSuccess || per_cu < 1) { fprintf(stderr, "kernel_launch: occupancy query reports %d\n", per_cu); }
        (void)hipGetLastError();
        grid = cus - (cus % 8);
    }
    if (grid < 0) return;
    (void)hipMemsetAsync((char*)d_ws + WS_CTL, 0, CTL_ZERO_BYTES, stream);
    Args a{};
    for (int i = 0; i < 23; ++i) a.in[i] = (const float*)d_in[i];
    a.out = (float*)d_out; a.ws = (unsigned char*)d_ws;
    if (MK_N_LAUNCHES == 1) { a.ph_lo = 0; a.ph_hi = N_PHASES; hipLaunchKernelGGL(hymba_fwd, dim3(grid), dim3(NTHREADS), LDS_BYTES, stream, a); }
    else { for (int p = 0; p < N_PHASES; ++p) { a.ph_lo = p; a.ph_hi = p + 1; hipLaunchKernelGGL(hymba_fwd, dim3(grid), dim3(NTHREADS), LDS_BYTES, stream, a); } }
}
```

```cpp
#include <hip/hip_runtime.h>
#include <cstdio>
#include <cstdint>

#ifndef MK_N_LAUNCHES
#define MK_N_LAUNCHES 1
#endif

#define GAS __attribute__((address_space(1)))
#define LAS __attribute__((address_space(3)))
typedef unsigned short bf16_t;
typedef short bf16x8 __attribute__((ext_vector_type(8)));
typedef short s16x4 __attribute__((ext_vector_type(4)));
typedef short v4i16_t __attribute__((ext_vector_type(4)));
typedef float f32x4 __attribute__((ext_vector_type(4)));
typedef unsigned u32x4 __attribute__((ext_vector_type(4)));
typedef unsigned u32x2 __attribute__((ext_vector_type(2)));

constexpr int DM = 2048, SEQ = 4096, NP = 8192, NS = 128, DB = 32, DS = 4, DIN = 5904, PN = 6144, NMEMROWS = 512;
constexpr int C_AB = 0, C_AC = 512, C_AH = 1024, C_AZ = 1536, C_GQ = 2048, C_GK = 2304, C_GV = 2560, C_GA = 3072, C_GZ = 3088,
              C_SQ = 3600, C_SK = 4112, C_SV = 4240, C_SZ = 4368, C_MQ = 4880, C_MZ = 5392;
constexpr float EPS = 1e-6f;
constexpr size_t O_YP = 0, O_YS = 16777216, O_CONVP = 17039360, O_GLAP = 17043456, O_SWKP = 17174528, O_SWVP = 17240064, O_MKP = 17305600,
                 O_MVP = 17829888, O_CONVS = 18354176, O_GLAS = 18419712, O_SWKS = 20516864, O_SWVS = 21565440, O_END = 22614016;
constexpr size_t MiB = 1u << 20;
constexpr size_t WS_CTL = 0, CTL_ZERO_BYTES = 32768;
constexpr size_t WS_WIN = 2 * MiB, WIN_L = (size_t)PN * DM * 2;
constexpr size_t WS_WOUT = 50 * MiB, WOUT_L = (size_t)DM * DM * 2;
constexpr size_t WS_WMEM = 66 * MiB;
constexpr size_t WS_XB = 74 * MiB;
constexpr size_t WS_PROJ = 106 * MiB;
constexpr size_t WS_MIX = 202 * MiB;
constexpr size_t WS_GLAKV = 234 * MiB;
constexpr size_t WS_GLAST = 250 * MiB;
constexpr size_t WS_GLADEC = 258 * MiB;
constexpr size_t WS_MEMKV = 259 * MiB;
constexpr size_t WS_MEMA = 263 * MiB;
constexpr size_t WS_XS = 265 * MiB;
constexpr size_t WS_PROJS = 266 * MiB;
constexpr size_t WS_MIXS = 268 * MiB;
constexpr size_t WS_MEMKB = 270 * MiB;
constexpr size_t WS_MEMVB = 271 * MiB;
constexpr size_t WS_GLACUM = 272 * MiB;
constexpr size_t WS_END = 280 * MiB;
constexpr int CW_KN2 = 16384;
constexpr int CW_Q = 8192;
constexpr int CW_DEP = CW_Q + 6144;
constexpr int CW_RDY = CW_DEP + 512;
constexpr int CW_BAR = 4096;
constexpr int CW_SSP = 65536;
constexpr int CW_SSS = CW_SSP + 2 * 8192;
constexpr int CW_SSM = CW_SSS + 2 * 128;
static_assert(CW_BAR + 3456 <= 8192, "ctl");

constexpr int NWAVES = 8, NTHREADS = 512;
constexpr int LDS_BYTES = 151552, MISC_OFF = 147456;

__device__ __forceinline__ float bflo(unsigned u) { return __uint_as_float(u << 16); }
__device__ __forceinline__ float bfhi(unsigned u) { return __uint_as_float(u & 0xffff0000u); }
__device__ __forceinline__ float bf1(bf16_t h) { return __uint_as_float((unsigned)h << 16); }
__device__ __forceinline__ unsigned f2bf(float f) { unsigned u = __float_as_uint(f); return (u + 0x7fffu + ((u >> 16) & 1u)) >> 16; }
typedef float f32x2_t __attribute__((ext_vector_type(2))); typedef __bf16 bf16x2_t __attribute__((ext_vector_type(2)));
__device__ __forceinline__ unsigned pk2(float lo, float hi) { f32x2_t v = {lo, hi}; bf16x2_t b = __builtin_convertvector(v, bf16x2_t); return __builtin_bit_cast(unsigned, b); }
__device__ __forceinline__ void unpack8(const u32x4 r, float* f) { f[0] = bflo(r.x); f[1] = bfhi(r.x); f[2] = bflo(r.y); f[3] = bfhi(r.y); f[4] = bflo(r.z); f[5] = bfhi(r.z); f[6] = bflo(r.w); f[7] = bfhi(r.w); }
__device__ __forceinline__ u32x4 pack8(const float* f) { u32x4 r; r.x = pk2(f[0], f[1]); r.y = pk2(f[2], f[3]); r.z = pk2(f[4], f[5]); r.w = pk2(f[6], f[7]); return r; }
__device__ __forceinline__ float siluf(float x) { return x * __builtin_amdgcn_rcpf(1.f + __expf(-x)); }
__device__ __forceinline__ float logsigf(float x) { return fminf(x, 0.f) - __logf(1.f + __expf(-fabsf(x))); }
__device__ __forceinline__ float wave_sum(float v) {
#pragma unroll
    for (int o = 1; o < 64; o <<= 1) v += __shfl_xor(v, o);
    return v;
}
#define LDS_WAIT() asm volatile("s_waitcnt lgkmcnt(0)" ::: "memory")
__device__ __forceinline__ int lane_id() { int l; asm volatile("v_mbcnt_lo_u32_b32 %0, -1, 0\n\tv_mbcnt_hi_u32_b32 %0, -1, %0" : "=v"(l)); return l; }
__device__ __forceinline__ s16x4 tr4(const LAS unsigned char* base, int pitchB, int r0, int c0, int li) {
    const LAS unsigned char* p = base + (r0 + (li >> 2)) * pitchB + (c0 + 4 * (li & 3)) * 2;
    return __builtin_bit_cast(s16x4, __builtin_amdgcn_ds_read_tr16_b64_v4i16((LAS v4i16_t*)p));
}
__device__ __forceinline__ bf16x8 cat8(s16x4 a, s16x4 b) { return (bf16x8){a[0], a[1], a[2], a[3], b[0], b[1], b[2], b[3]}; }
__device__ __forceinline__ bf16x8 pk8f(f32x4 a, f32x4 b) { u32x4 r; r.x = pk2(a[0], a[1]); r.y = pk2(a[2], a[3]); r.z = pk2(b[0], b[1]); r.w = pk2(b[2], b[3]); return __builtin_bit_cast(bf16x8, r); }
#define MFMA16(a, b, c) __builtin_amdgcn_mfma_f32_16x16x32_bf16((a), (b), (c), 0, 0, 0)

namespace pg8 {
#define PG8_LAS __attribute__((address_space(3)))
constexpr int BM = 256, BK = 64, HALF = 128, HTB = HALF * BK * 2, STAGE_BYTES = 8 * HTB, NXCD = 8, WGM = 4;
__host__ __device__ __forceinline__ int lds_byte(int r, int c) { const int st = (r >> 4) * 2 + (c >> 5), rr = r & 15, cc = c & 31, ob = rr * 64 + cc * 2; return st * 1024 + (ob ^ (((ob >> 9) & 1) << 5)); }
__host__ __device__ __forceinline__ void stage_rc(int b, int& R, int& C) { const int st = b / 1024, sb = b % 1024, swz = sb ^ (((sb >> 9) & 1) << 5); R = (st >> 1) * 16 + swz / 64; C = (st & 1) * 32 + (swz % 64) / 2; }
__host__ __device__ __forceinline__ int perm32(int rho) { const int n = rho >> 4, i = rho & 15; return 8 * (i >> 2) + 4 * n + (i & 3); }
struct Unit { int pm, pn; };
struct Gemm { const bf16_t* A; const bf16_t* Bt; int M, N, K; };
struct StaticOrder {
    int nM, nN, nwg, G, c;
    __host__ __device__ void init(int M, int N, int G_, int c_) { nM = M / BM; nN = N / BM; nwg = nM * nN; G = G_; c = c_; }
    __host__ __device__ bool next(int i, Unit& u) const {
        const long L = (long)i * G + c; if (L >= nwg) return false;
        int wgid = (int)L; { const int q = nwg / NXCD, r = nwg % NXCD, xcd = wgid % NXCD, off = wgid / NXCD; wgid = (xcd < r ? xcd * (q + 1) : r * (q + 1) + (xcd - r) * q) + off; }
        const int nig = WGM * nN, gid = wgid / nig, fm = gid * WGM, gsz = (nM - fm) < WGM ? (nM - fm) : WGM;
        u.pm = fm + ((wgid % nig) % gsz); u.pn = (wgid % nig) / gsz; return true;
    }
    __device__ __forceinline__ void a_ready(const Unit&) const {}
    __device__ __forceinline__ void done(const Unit&) const {}
};
__device__ __forceinline__ unsigned cvt_pk_bf16(float lo, float hi) { unsigned r; asm volatile("v_cvt_pk_bf16_f32 %0, %1, %2" : "=v"(r) : "v"(lo), "v"(hi)); return r; }

struct EpiProj {
    static constexpr bool PERM = true, AFTER_DRAIN = false;
    bf16_t* O; int ldc; const float* ss; float* convp;
    __device__ __forceinline__ void operator()(const f32x4 (&acc)[2][2][4][2], const Unit& u, int wr, int wc, int fr, int fq) const {
        const int row0 = u.pm * BM + wr * 64 + fr, col0 = u.pn * BM + wc * 32 + 8 * fq;
        float sv[2][4];
#pragma unroll
        for (int ai = 0; ai < 2; ++ai)
#pragma unroll
            for (int m = 0; m < 4; ++m) sv[ai][m] = ss[row0 + ai * HALF + m * 16];
        if (u.pn < 8) {
            const int ch0 = 64 * u.pn + 32 * (wc & 1) + 8 * fq;
#pragma unroll
            for (int ai = 0; ai < 2; ++ai)
#pragma unroll
                for (int m = 0; m < 4; ++m) { const int row = row0 + ai * HALF + m * 16; const float sc = rsqrtf(sv[ai][m] * (1.0f / DM) + EPS);
                    const f32x4 a0 = acc[ai][0][m][0] * sc, a1 = acc[ai][0][m][1] * sc, b0 = acc[ai][1][m][0] * sc, b1 = acc[ai][1][m][1] * sc;
                    f32x4 r0, r1;
                    if (wc < 2) { r0 = a0 * b0; r1 = a1 * b1; }
                    else {
#pragma unroll
                        for (int j = 0; j < 4; ++j) { r0[j] = a0[j] * (b0[j] * __builtin_amdgcn_rcpf(1.f + __expf(-b0[j]))); r1[j] = a1[j] * (b1[j] * __builtin_amdgcn_rcpf(1.f + __expf(-b1[j]))); } }
                    u32x4 w; w.x = cvt_pk_bf16(r0[0], r0[1]); w.y = cvt_pk_bf16(r0[2], r0[3]); w.z = cvt_pk_bf16(r1[0], r1[1]); w.w = cvt_pk_bf16(r1[2], r1[3]);
                    *(u32x4*)(O + (size_t)row * ldc + (wc < 2 ? C_AC : C_AB) + ch0) = w;
                    const int t = row & (SEQ - 1);
                    if (wc < 2 && t >= SEQ - 2) { float* cp = convp + ((size_t)(row >> 12) * 2 + (t - (SEQ - 2))) * 512 + ch0; *(f32x4*)cp = r0; *(f32x4*)(cp + 4) = r1; } }
            return; }
#pragma unroll
        for (int ai = 0; ai < 2; ++ai)
#pragma unroll
            for (int m = 0; m < 4; ++m) { const int row = row0 + ai * HALF + m * 16; const float sc = rsqrtf(sv[ai][m] * (1.0f / DM) + EPS);
                bf16_t* rowp = O + (size_t)row * ldc + col0;
#pragma unroll
                for (int bj = 0; bj < 2; ++bj) { const f32x4 v0 = acc[ai][bj][m][0] * sc, v1 = acc[ai][bj][m][1] * sc;
                    u32x4 w; w.x = cvt_pk_bf16(v0[0], v0[1]); w.y = cvt_pk_bf16(v0[2], v0[3]); w.z = cvt_pk_bf16(v1[0], v1[1]); w.w = cvt_pk_bf16(v1[2], v1[3]);
                    *(u32x4*)(rowp + bj * HALF) = w; } }
    }
};
template <bool LAST> struct EpiOut {
    static constexpr bool PERM = true, AFTER_DRAIN = false;
    const float* base; float* out; bf16_t* xb; float* ssn;
    __device__ __forceinline__ void operator()(const f32x4 (&acc)[2][2][4][2], const Unit& u, int wr, int wc, int fr, int fq) const {
        const int row0 = u.pm * BM + wr * 64 + fr, col0 = u.pn * BM + wc * 32 + 8 * fq;
        u32x4 bw[2][4][2];
#pragma unroll
        for (int ai = 0; ai < 2; ++ai)
#pragma unroll
            for (int m = 0; m < 4; ++m)
#pragma unroll
                for (int bj = 0; bj < 2; ++bj) bw[ai][m][bj] = *(const u32x4*)(xb + (size_t)(row0 + ai * HALF + m * 16) * DM + col0 + bj * HALF);
#pragma unroll
        for (int ai = 0; ai < 2; ++ai)
#pragma unroll
            for (int m = 0; m < 4; ++m) { const int row = row0 + ai * HALF + m * 16; const size_t off = (size_t)row * DM + col0; float s = 0.f;
#pragma unroll
                for (int bj = 0; bj < 2; ++bj) { const size_t o2 = off + bj * HALF; const u32x4 b4 = bw[ai][m][bj];
                    f32x4 y0 = acc[ai][bj][m][0], y1 = acc[ai][bj][m][1];
                    y0[0] += bflo(b4.x); y0[1] += bfhi(b4.x); y0[2] += bflo(b4.y); y0[3] += bfhi(b4.y); y1[0] += bflo(b4.z); y1[1] += bfhi(b4.z); y1[2] += bflo(b4.w); y1[3] += bfhi(b4.w);
                    if (!LAST) { u32x4 w; w.x = cvt_pk_bf16(y0[0], y0[1]); w.y = cvt_pk_bf16(y0[2], y0[3]); w.z = cvt_pk_bf16(y1[0], y1[1]); w.w = cvt_pk_bf16(y1[2], y1[3]); *(u32x4*)(xb + o2) = w;
                        s += (y0[0] * y0[0] + y0[1] * y0[1]) + (y0[2] * y0[2] + y0[3] * y0[3]) + (y1[0] * y1[0] + y1[1] * y1[1]) + (y1[2] * y1[2] + y1[3] * y1[3]); }
                    else { *(f32x4*)(out + o2) = y0; *(f32x4*)(out + o2 + 4) = y1; } }
                if (!LAST) { s += __shfl_xor(s, 16); s += __shfl_xor(s, 32); if (fq == 0) atomicAdd(ssn + row, s); } }
    }
};

template <class Epi, class Sched, bool ALIGN_EPI = false, bool SP2 = false>
__device__ __forceinline__ void gemm_phase(PG8_LAS unsigned char* lds, const Gemm g, const Sched& S, const Epi& E, int wave_s) {
    int tid_ = wave_s * 64 + lane_id(); asm volatile("" : "+v"(tid_));
    const int tid = tid_, wid = __builtin_amdgcn_readfirstlane(tid >> 6), lane = tid & 63, wr = wid >> 2, wc = wid & 3, fr = lane & 15, fq = lane >> 4;
    const int K = g.K, nt = K / BK;
    unsigned voffA[2], voffB[2];
#pragma unroll
    for (int i = 0; i < 2; ++i) { int R, C; stage_rc(tid * 16 + i * 8192, R, C); const int Rb = Epi::PERM ? ((R & ~31) + perm32(R & 31)) : R;
        voffA[i] = (unsigned)(R * K + C) * 2u; voffB[i] = (unsigned)(Rb * K + C) * 2u; }
    const size_t kstep = (size_t)(BK * 2);
    const size_t hstep = (size_t)HALF * K * 2;
    const size_t tstep = 2 * hstep;
    const unsigned ldsw = (unsigned)wid * 1024u;
    const int aoff = lds_byte(wr * 64 + fr, fq * 8), boff = lds_byte(wc * 32 + fr, fq * 8);
#define PG8_SA(b, h) (((b) * 2 + (h)) * HTB)
#define PG8_SB(b, h) ((4 + (b) * 2 + (h)) * HTB)
#define PG8_STAGE(bufoff, gbase, voff) do { _Pragma("unroll") for (int _i = 0; _i < 2; ++_i) { unsigned _vo = (voff)[_i]; asm volatile("" : "+v"(_vo)); \
        __builtin_amdgcn_global_load_lds((const unsigned*)((const char*)(gbase) + _vo), (PG8_LAS unsigned*)(lds + (bufoff) + ldsw + _i * 8192), 16, 0, 0); } } while (0)
#define PG8_LDA(dst, b, h) do { _Pragma("unroll") for (int m = 0; m < 4; ++m) _Pragma("unroll") for (int k = 0; k < 2; ++k) dst[m][k] = *(const PG8_LAS bf16x8*)(lds + PG8_SA(b, h) + aoff + m * 2048 + k * 1024); } while (0)
#define PG8_LDB(dst, b, h) do { _Pragma("unroll") for (int n = 0; n < 2; ++n) _Pragma("unroll") for (int k = 0; k < 2; ++k) dst[n][k] = *(const PG8_LAS bf16x8*)(lds + PG8_SB(b, h) + boff + n * 2048 + k * 1024); } while (0)
#define PG8_MMA(ai, bj, At, Bt) do { __builtin_amdgcn_s_setprio(1); _Pragma("unroll") for (int m = 0; m < 4; ++m) _Pragma("unroll") for (int n = 0; n < 2; ++n) _Pragma("unroll") for (int k = 0; k < 2; ++k) \
        acc[ai][bj][m][n] = __builtin_amdgcn_mfma_f32_16x16x32_bf16(Bt[n][k], At[m][k], acc[ai][bj][m][n], 0, 0, 0); __builtin_amdgcn_s_setprio(0); } while (0)
#define PG8_WAIT_V(n) asm volatile("s_waitcnt vmcnt(" #n ")" ::: "memory")
#define PG8_WAIT_L(n) asm volatile("s_waitcnt lgkmcnt(" #n ")" ::: "memory")
#define PG8_BAR __builtin_amdgcn_s_barrier()
#define PG8_SCHED __builtin_amdgcn_sched_barrier(0)
    Unit cur, nxt; int ui = 0;
    if (!S.next(0, cur)) return;
    f32x4 acc[2][2][4][2];
#pragma unroll
    for (int a = 0; a < 2; ++a)
#pragma unroll
        for (int b = 0; b < 2; ++b)
#pragma unroll
            for (int m = 0; m < 4; ++m)
#pragma unroll
                for (int n = 0; n < 2; ++n) acc[a][b][m][n] = (f32x4){0.f, 0.f, 0.f, 0.f};
    bf16x8 At[4][2], B0[2][2], B1[2][2];
    const char* cA = (const char*)g.A + (size_t)cur.pm * tstep; const char* cB = (const char*)g.Bt + (size_t)cur.pn * tstep;
    S.a_ready(cur);
    if constexpr (SP2) {
        PG8_STAGE(PG8_SB(0, 0), cB, voffB); PG8_STAGE(PG8_SB(0, 1), cB + hstep, voffB); PG8_STAGE(PG8_SA(0, 0), cA, voffA); PG8_STAGE(PG8_SA(0, 1), cA + hstep, voffA);
        if (wr == 1) PG8_BAR;
        PG8_WAIT_V(2); PG8_BAR;
        PG8_STAGE(PG8_SB(1, 0), cB + kstep, voffB); PG8_STAGE(PG8_SA(1, 0), cA + kstep, voffA); PG8_STAGE(PG8_SB(1, 1), cB + hstep + kstep, voffB);
        PG8_WAIT_V(6); PG8_BAR;
    } else {
        PG8_STAGE(PG8_SB(0, 0), cB, voffB); PG8_STAGE(PG8_SA(0, 0), cA, voffA); PG8_STAGE(PG8_SB(0, 1), cB + hstep, voffB); PG8_STAGE(PG8_SA(0, 1), cA + hstep, voffA);
        if (wr == 1) PG8_BAR;
        PG8_WAIT_V(4); PG8_BAR;
        PG8_STAGE(PG8_SB(1, 0), cB + kstep, voffB); PG8_STAGE(PG8_SA(1, 0), cA + kstep, voffA); PG8_STAGE(PG8_SB(1, 1), cB + hstep + kstep, voffB);
        PG8_WAIT_V(6); PG8_BAR;
    }
    for (;;) {
        const bool has_next = S.next(ui + 1, nxt);
        const char* nA = has_next ? (const char*)g.A + (size_t)nxt.pm * tstep : cA; const char* nB = has_next ? (const char*)g.Bt + (size_t)nxt.pn * tstep : cB;
        for (int t = 0; t < nt; t += 2) {
            const bool last = (t == nt - 2);
            const char* a1 = cA + (size_t)(t + 1) * kstep;
            const char* a2 = last ? nA : cA + (size_t)(t + 2) * kstep; const char* b2 = last ? nB : cB + (size_t)(t + 2) * kstep;
            const char* a3 = a2 + kstep; const char* b3 = b2 + kstep;
            if (last && has_next) S.a_ready(nxt);
            if constexpr (SP2) {
            PG8_LDB(B0, 0, 0); PG8_LDB(B1, 0, 1); PG8_SCHED; PG8_LDA(At, 0, 0); PG8_STAGE(PG8_SA(1, 1), a1 + hstep, voffA);
            PG8_WAIT_V(8); PG8_WAIT_L(0); PG8_BAR; PG8_MMA(0, 0, At, B0); PG8_MMA(0, 1, At, B1); PG8_BAR; PG8_SCHED;
            PG8_LDA(At, 0, 1); PG8_STAGE(PG8_SB(0, 0), b2, voffB); PG8_STAGE(PG8_SB(0, 1), b2 + hstep, voffB); PG8_STAGE(PG8_SA(0, 0), a2, voffA);
            PG8_WAIT_V(8); PG8_WAIT_L(0); PG8_BAR; PG8_MMA(1, 0, At, B0); PG8_MMA(1, 1, At, B1); PG8_BAR; PG8_SCHED;
            PG8_LDB(B0, 1, 0); PG8_LDB(B1, 1, 1); PG8_SCHED; PG8_LDA(At, 1, 0); PG8_STAGE(PG8_SA(0, 1), a2 + hstep, voffA);
            PG8_WAIT_V(8); PG8_WAIT_L(0); PG8_BAR; PG8_MMA(0, 0, At, B0); PG8_MMA(0, 1, At, B1); PG8_BAR; PG8_SCHED;
            PG8_LDA(At, 1, 1); PG8_STAGE(PG8_SB(1, 0), b3, voffB); PG8_STAGE(PG8_SB(1, 1), b3 + hstep, voffB); PG8_STAGE(PG8_SA(1, 0), a3, voffA);
            PG8_WAIT_V(8); PG8_WAIT_L(0); PG8_BAR; PG8_MMA(1, 0, At, B0); PG8_MMA(1, 1, At, B1); PG8_BAR; PG8_SCHED;
            } else {
            PG8_LDB(B0, 0, 0); PG8_SCHED; PG8_LDA(At, 0, 0); PG8_STAGE(PG8_SA(1, 1), a1 + hstep, voffA);
            PG8_WAIT_L(8); PG8_BAR; PG8_WAIT_L(0); PG8_MMA(0, 0, At, B0); PG8_BAR; PG8_SCHED;
            PG8_LDB(B1, 0, 1); PG8_STAGE(PG8_SB(0, 0), b2, voffB);
            PG8_BAR; PG8_WAIT_L(0); PG8_MMA(0, 1, At, B1); PG8_BAR;
            PG8_LDA(At, 0, 1); PG8_STAGE(PG8_SA(0, 0), a2, voffA);
            PG8_BAR; PG8_WAIT_L(0); PG8_MMA(1, 0, At, B0); PG8_BAR; PG8_SCHED;
            PG8_STAGE(PG8_SB(0, 1), b2 + hstep, voffB);
            PG8_WAIT_V(6); PG8_BAR; PG8_MMA(1, 1, At, B1); PG8_BAR;
            PG8_LDB(B0, 1, 0); PG8_SCHED; PG8_LDA(At, 1, 0); PG8_STAGE(PG8_SA(0, 1), a2 + hstep, voffA);
            PG8_WAIT_L(8); PG8_BAR; PG8_WAIT_L(0); PG8_MMA(0, 0, At, B0); PG8_BAR; PG8_SCHED;
            PG8_LDB(B1, 1, 1); PG8_STAGE(PG8_SB(1, 0), b3, voffB);
            PG8_BAR; PG8_WAIT_L(0); PG8_MMA(0, 1, At, B1); PG8_BAR;
            PG8_LDA(At, 1, 1); PG8_STAGE(PG8_SA(1, 0), a3, voffA);
            PG8_BAR; PG8_WAIT_L(0); PG8_MMA(1, 0, At, B0); PG8_BAR; PG8_SCHED;
            PG8_STAGE(PG8_SB(1, 1), b3 + hstep, voffB);
            PG8_WAIT_V(6); PG8_BAR; PG8_MMA(1, 1, At, B1); PG8_BAR;
            }
        }
        if constexpr (ALIGN_EPI) { if (wr == 0) PG8_BAR; }
        if constexpr (!Epi::AFTER_DRAIN) { E(acc, cur, wr, wc, fr, fq); S.done(cur); }
        if (!has_next) break;
#pragma unroll
        for (int a = 0; a < 2; ++a)
#pragma unroll
            for (int b = 0; b < 2; ++b)
#pragma unroll
                for (int m = 0; m < 4; ++m)
#pragma unroll
                    for (int n = 0; n < 2; ++n) acc[a][b][m][n] = (f32x4){0.f, 0.f, 0.f, 0.f};
        cur = nxt; cA = nA; cB = nB; ++ui;
        if constexpr (ALIGN_EPI) { if (wr == 1) PG8_BAR; }
    }
    PG8_WAIT_V(0);
    if constexpr (!ALIGN_EPI) { if (wr == 0) PG8_BAR; }
    PG8_BAR;
#undef PG8_SA
#undef PG8_SB
#undef PG8_STAGE
#undef PG8_LDA
#undef PG8_LDB
#undef PG8_MMA
#undef PG8_WAIT_V
#undef PG8_WAIT_L
#undef PG8_BAR
#undef PG8_SCHED
}
}

typedef GAS unsigned gu32;
#define RLX_AGENT __ATOMIC_RELAXED, __HIP_MEMORY_SCOPE_AGENT
#define XB_TMO      128
#define XB_XCNT(j)  (256  + 64 * (j))
#define XB_XSUB(j)  (1280 + 64 * (j))
#define XB_XGEN(j)  (2304 + 64 * (j))
#define XB_TOP      3328
#define XB_TOPGEN   3392
#define XCD_BAR_WORDS 3456
#define XB_SPIN_CAP (1u << 18)
__device__ __forceinline__ unsigned xb_ld(unsigned* p)              { return __hip_atomic_load(p, __ATOMIC_RELAXED, __HIP_MEMORY_SCOPE_AGENT); }
__device__ __forceinline__ unsigned xb_add(unsigned* p, unsigned v) { return __hip_atomic_fetch_add(p, v, __ATOMIC_RELAXED, __HIP_MEMORY_SCOPE_AGENT); }
__device__ __forceinline__ unsigned xb_xcc_id() { return (unsigned)__builtin_amdgcn_s_getreg((3 << 11) | 20) & 0xFu; }
#define XB_SPIN(cond, bar) do { unsigned _sp = 0; while (cond) { __builtin_amdgcn_s_sleep(1); \
    if ((++_sp & 255u) == 0u) { if (xb_ld(&(bar)[XB_TMO])) break; if (_sp > XB_SPIN_CAP) { atomicAdd(&(bar)[XB_TMO], 1u); break; } } } } while (0)
struct XcdBarrier { unsigned* bar; unsigned x; volatile LAS unsigned* st; };
__device__ __forceinline__ XcdBarrier xcd_barrier_post(unsigned* bar, volatile LAS unsigned* st, bool leader) {
    XcdBarrier b; b.bar = bar; b.x = xb_xcc_id(); b.st = st;
    if (leader) (void)xb_add(&bar[XB_XCNT(b.x)], 1u);
    return b;
}
__device__ __forceinline__ void xcd_barrier_complete(unsigned* bar, unsigned x, unsigned& nloc, unsigned& nx) {
    const unsigned G = gridDim.x * gridDim.y * gridDim.z;
    unsigned sum, cnt, mine, sp = 0u;
    for (;;) {
        sum = 0u; cnt = 0u; mine = 0u;
#pragma unroll
        for (unsigned j = 0; j < 16; ++j) { const unsigned c = xb_ld(&bar[XB_XCNT(j)]); sum += c; cnt += (c > 0u) ? 1u : 0u; mine = (j == x) ? c : mine; }
        if (sum == G) break;
        __builtin_amdgcn_s_sleep(1);
        if ((++sp & 255u) == 0u) { if (xb_ld(&bar[XB_TMO])) break; if (sp > XB_SPIN_CAP) { atomicAdd(&bar[XB_TMO], 1u); break; } }
    }
    nloc = mine > 0u ? mine : 1u; nx = cnt > 0u ? cnt : 1u;
}
__device__ __forceinline__ void xcd_barrier(const XcdBarrier& b, bool leader) {
    asm volatile("s_waitcnt vmcnt(0)" ::: "memory");
    __syncthreads();
    if (leader) {
        unsigned* bar = b.bar;
        __builtin_amdgcn_s_waitcnt(0);
        unsigned nloc = b.st[0], nx = b.st[1];
        if (nloc == 0u) { xcd_barrier_complete(bar, b.x, nloc, nx); b.st[0] = nloc; b.st[1] = nx; }
        const unsigned old = xb_add(&bar[XB_XSUB(b.x)], 1u);
        const unsigned gen = old / nloc;
        if (old + 1u == (gen + 1u) * nloc) {
            __builtin_amdgcn_fence(__ATOMIC_RELEASE, "agent");
            asm volatile("s_waitcnt vmcnt(0)" ::: "memory");
            const unsigned og = xb_add(&bar[XB_TOP], 1u);
            const unsigned tg = og / nx;
            if (og + 1u == (tg + 1u) * nx) xb_add(&bar[XB_TOPGEN], 1u);
            else XB_SPIN(xb_ld(&bar[XB_TOPGEN]) == tg, bar);
            __builtin_amdgcn_fence(__ATOMIC_ACQUIRE, "agent");
            asm volatile("s_waitcnt vmcnt(0)" ::: "memory");
        } else {
            XB_SPIN(xb_ld(&bar[XB_TOPGEN]) == gen, bar);
            __builtin_amdgcn_fence(__ATOMIC_ACQUIRE, "agent");
            asm volatile("s_waitcnt vmcnt(0)" ::: "memory");
        }
    }
    __syncthreads();
}

struct DepOrder : pg8::StaticOrder {
    unsigned* cnt; unsigned target; unsigned* tmo;
    __device__ __forceinline__ void a_ready(const pg8::Unit& u) const {
        const bool leader = (__builtin_amdgcn_readfirstlane((int)threadIdx.x >> 6) == 0) && (lane_id() == 0);
        if (leader) { unsigned* c_ = cnt + u.pm * 16; XB_SPIN(xb_ld(c_) < target, tmo); __builtin_amdgcn_fence(__ATOMIC_ACQUIRE, "agent"); asm volatile("s_waitcnt vmcnt(0)" ::: "memory"); }
        __syncthreads();
    }
};

__device__ __forceinline__ unsigned xcd_barrier_arrive(const XcdBarrier& b, bool leader) {
    unsigned gen = 0u;
    asm volatile("s_waitcnt vmcnt(0)" ::: "memory");
    __syncthreads();
    if (leader) {
        unsigned* bar = b.bar;
        __builtin_amdgcn_s_waitcnt(0);
        unsigned nloc = b.st[0], nx = b.st[1];
        if (nloc == 0u) { xcd_barrier_complete(bar, b.x, nloc, nx); b.st[0] = nloc; b.st[1] = nx; }
        const unsigned old = xb_add(&bar[XB_XSUB(b.x)], 1u);
        gen = old / nloc;
        if (old + 1u == (gen + 1u) * nloc) {
            __builtin_amdgcn_fence(__ATOMIC_RELEASE, "agent");
            asm volatile("s_waitcnt vmcnt(0)" ::: "memory");
            const unsigned og = xb_add(&bar[XB_TOP], 1u);
            const unsigned tg = og / nx;
            if (og + 1u == (tg + 1u) * nx) xb_add(&bar[XB_TOPGEN], 1u);
        }
    }
    return gen;
}
__device__ __forceinline__ void xcd_barrier_wait(const XcdBarrier& b, bool leader, unsigned gen) {
    if (leader) {
        XB_SPIN(xb_ld(&b.bar[XB_TOPGEN]) == gen, b.bar);
        __builtin_amdgcn_fence(__ATOMIC_ACQUIRE, "agent");
        asm volatile("s_waitcnt vmcnt(0)" ::: "memory");
    }
    __syncthreads();
}

struct Args { const float* in[23]; float* out; unsigned char* ws; int ph_lo, ph_hi; };
struct Ctx {
    LAS unsigned char* lds; int tid, lane, wave, G, bid;
    const Args* a; float* out; unsigned char* ws; float* ctlf;
    unsigned* pend;
    unsigned* qctr; unsigned tk;
};
#define QPUBLISH(F) do { if ((F).pend) { asm volatile("s_waitcnt vmcnt(0)" ::: "memory"); __syncthreads(); if ((F).tid == 0) (void)__hip_atomic_fetch_add((F).pend, 1u, __ATOMIC_RELAXED, __HIP_MEMORY_SCOPE_AGENT); (F).pend = nullptr; } } while (0)
#define QTICKET(F) do { QPUBLISH(F); if ((F).tid == 0) (F).tk = __hip_atomic_fetch_add((F).qctr, 1u, __ATOMIC_RELAXED, __HIP_MEMORY_SCOPE_AGENT); } while (0)
#define IN_XP 0
#define IN_XS 1
#define IN_MEM 2
#define IN_SCONV 3
#define IN_SGLA 4
#define IN_CSWK 5
#define IN_CSWV 6
#define IN_CMK 7
#define IN_CMV 8
#define IN_GNORM 9
#define IN_WIN 10
#define IN_CONVW 11
#define IN_WUP 12
#define IN_BA 13
#define IN_GGLAO 14
#define IN_GSWQ 15
#define IN_GSWK 16
#define IN_SINKS 17
#define IN_GMEM 18
#define IN_WMEM 19
#define IN_GMEMQ 20
#define IN_GMEMK 21
#define IN_WOUT 22

__device__ __forceinline__ int win_src_block(int nb) { if (nb >= 32) return nb; const int j = nb >> 2, t = nb & 3; return (t == 0 ? 8 : t == 1 ? 0 : t == 2 ? 16 : 24) + j; }
template <bool HASG>
__device__ __forceinline__ void p0_transpose_item(const float* W, const float* gk, int K, int N, int Npad, bf16_t* WT, LAS float* scr, int kb, int nb, int lane, int nbs = -1) {
    const int k0 = 64 * kb, n0 = 64 * nb, ns0 = 64 * (nbs < 0 ? nb : nbs), n4 = (lane & 15) * 4, kr = lane >> 4; const bool ok = (ns0 + n4) < N;
    f32x4 v[16];
#pragma unroll
    for (int i = 0; i < 16; ++i) { const int k = 4 * i + kr; v[i] = ok ? __builtin_nontemporal_load((const f32x4*)(W + (size_t)(k0 + k) * N + ns0 + n4)) : (f32x4){0.f, 0.f, 0.f, 0.f}; }
    float gv[16];
#pragma unroll
    for (int i = 0; i < 16; ++i) gv[i] = HASG ? gk[k0 + 4 * i + kr] : 1.f;
#pragma unroll
    for (int i = 0; i < 16; ++i) { const int k = 4 * i + kr; const float g = gv[i]; LAS float* d = scr + k * 65 + n4;
        d[0] = v[i].x * g; d[1] = v[i].y * g; d[2] = v[i].z * g; d[3] = v[i].w * g; }
    LDS_WAIT(); asm volatile("" ::: "memory");
    const int c = lane & 7;
#pragma unroll
    for (int j = 0; j < 8; ++j) { const int n = (lane >> 3) + 8 * j; const LAS float* s = scr + (8 * c) * 65 + n;
        u32x4 o; o.x = pk2(s[0 * 65], s[1 * 65]); o.y = pk2(s[2 * 65], s[3 * 65]); o.z = pk2(s[4 * 65], s[5 * 65]); o.w = pk2(s[6 * 65], s[7 * 65]);
        if (n0 + n < Npad) *(u32x4*)(WT + (size_t)(n0 + n) * K + k0 + 8 * c) = o; }
    LDS_WAIT(); asm volatile("" ::: "memory");
}
__device__ __forceinline__ void row_to_bf16(const float* xrow, bf16_t* orow, float* ss, int lane) {
    const f32x4* xr = (const f32x4*)xrow + lane; f32x4 v[8]; float s = 0.f;
#pragma unroll
    for (int j = 0; j < 8; ++j) { v[j] = __builtin_nontemporal_load(xr + 64 * j); s += (v[j].x * v[j].x + v[j].y * v[j].y) + (v[j].z * v[j].z + v[j].w * v[j].w); }
    s = wave_sum(s);
    u32x2* o8 = (u32x2*)orow + lane;
#pragma unroll
    for (int j = 0; j < 8; ++j) { u32x2 w; w.x = pk2(v[j].x, v[j].y); w.y = pk2(v[j].z, v[j].w); o8[64 * j] = w; }
    if (lane == 0) *ss = s;
}
__device__ __forceinline__ void p0_prologue(Ctx& F) {
    LAS float* scr = (LAS float*)(F.lds + F.wave * 16640);
    const int gw = F.bid * NWAVES + F.wave, NGW = F.G * NWAVES;
    constexpr int T_IN = 32 * 96, T_OUT = 32 * 32, T_MEM = 2 * 32 * 16, T_XP = NP, T_XS = NS, T_M = NMEMROWS;
    constexpr int NIT = T_IN + T_OUT + T_MEM + T_XP + T_XS + T_M;
    if (F.bid == 0) { for (int i = F.tid; i < 8192 + 64; i += NTHREADS) ((unsigned*)F.ctlf)[CW_Q + i] = 0u; }
    for (int i = gw * 64 + F.lane; i < NP + NS; i += NGW * 64) { if (i < NP) F.ctlf[CW_SSP + NP + i] = 0.f; else F.ctlf[CW_SSS + NS + (i - NP)] = 0.f; }
    for (int it = gw; it < NIT; it += NGW) {
        int r = it; { int ln_ = F.lane; asm volatile("" : "+v"(ln_)); F.lane = ln_; }
        if (r < T_IN) { p0_transpose_item<true>(F.a->in[IN_WIN], F.a->in[IN_GNORM], DM, DIN, PN, (bf16_t*)(F.ws + WS_WIN), scr, r / 96, r % 96, F.lane, win_src_block(r % 96)); continue; }
        r -= T_IN;
        if (r < T_OUT) { p0_transpose_item<false>(F.a->in[IN_WOUT], nullptr, DM, DM, DM, (bf16_t*)(F.ws + WS_WOUT), scr, r / 32, r % 32, F.lane); continue; }
        r -= T_OUT;
        if (r < T_MEM) { const int l = r / 512, q = r % 512;
            p0_transpose_item<true>(F.a->in[IN_WMEM] + (size_t)l * DM * 1024, F.a->in[IN_GMEM] + l * DM, DM, 1024, 1024, (bf16_t*)(F.ws + WS_WMEM) + (size_t)l * 1024 * DM, scr, q / 16, q % 16, F.lane); continue; }
        r -= T_MEM;
        if (r < T_XP) { row_to_bf16(F.a->in[IN_XP] + (size_t)r * DM, (bf16_t*)(F.ws + WS_XB) + (size_t)r * DM, F.ctlf + CW_SSP + r, F.lane); continue; }
        r -= T_XP;
        if (r < T_XS) { row_to_bf16(F.a->in[IN_XS] + (size_t)r * DM, (bf16_t*)(F.ws + WS_XS) + (size_t)r * DM, F.ctlf + CW_SSS + r, F.lane); continue; }
        r -= T_XS;
        row_to_bf16(F.a->in[IN_MEM] + (size_t)r * DM, (bf16_t*)(F.ws + WS_MEMA) + (size_t)r * DM, F.ctlf + CW_SSM + r, F.lane);
    }
}

__device__ __forceinline__ void cvt1_item(Ctx& F, int item) {
    QTICKET(F);
    LAS float* scr = (LAS float*)(F.lds + F.wave * 16640);
    const int w = item * 8 + F.wave;
    if (w < 32 * 96) p0_transpose_item<true>(F.a->in[IN_WIN] + (size_t)DM * DIN, F.a->in[IN_GNORM] + DM, DM, DIN, PN, (bf16_t*)(F.ws + WS_WIN + WIN_L), scr, w / 96, w % 96, F.lane, win_src_block(w % 96));
    else if (w < 32 * 96 + 32 * 32) { const int q = w - 32 * 96; p0_transpose_item<false>(F.a->in[IN_WOUT] + (size_t)DM * DM, nullptr, DM, DM, DM, (bf16_t*)(F.ws + WS_WOUT + WOUT_L), scr, q / 32, q % 32, F.lane); }
}

template <class Epi>
__device__ __forceinline__ void sg_unit(Ctx& F, const bf16_t* A, const bf16_t* Bt, const Epi& E) {
    constexpr int NSL = 6, D = 5, SLOT = 24576, BO = 16384;
    LAS unsigned char* lds = F.lds;
    const int tid = F.tid, fr = F.lane & 15, fq = F.lane >> 4, wm = F.wave & 3, wn = F.wave >> 2;
    unsigned voffA[2], voffB;
#pragma unroll
    for (int i = 0; i < 2; ++i) { int R, C; pg8::stage_rc(tid * 16 + i * 8192, R, C); voffA[i] = (unsigned)(R * DM + C) * 2u; if (i == 0) voffB = voffA[0]; }
    const unsigned ldsw = (unsigned)F.wave * 1024u;
    const int aoff = pg8::lds_byte(32 * wm + fr, 8 * fq), boff = BO + pg8::lds_byte(32 * wn + fr, 8 * fq);
#define SG_STAGE(t) do { const int so_ = ((t) % NSL) * SLOT; const char* ga_ = (const char*)A + (size_t)(t) * 128; const char* gb_ = (const char*)Bt + (size_t)(t) * 128; \
        _Pragma("unroll") for (int _i = 0; _i < 2; ++_i) { unsigned _vo = voffA[_i]; asm volatile("" : "+v"(_vo)); \
            __builtin_amdgcn_global_load_lds((const unsigned*)(ga_ + _vo), (LAS unsigned*)(lds + so_ + ldsw + _i * 8192), 16, 0, 0); } \
        { unsigned _vo = voffB; asm volatile("" : "+v"(_vo)); __builtin_amdgcn_global_load_lds((const unsigned*)(gb_ + _vo), (LAS unsigned*)(lds + so_ + BO + ldsw), 16, 0, 0); } } while (0)
    f32x4 acc[2][2];
#pragma unroll
    for (int a = 0; a < 2; ++a)
#pragma unroll
        for (int b = 0; b < 2; ++b) acc[a][b] = (f32x4){0.f, 0.f, 0.f, 0.f};
    QTICKET(F);
    __syncthreads();
#pragma unroll
    for (int t = 0; t < D; ++t) SG_STAGE(t);
    for (int t = 0; t < 32; ++t) {
        if (t + D <= 32) asm volatile("s_waitcnt vmcnt(12)" ::: "memory"); else asm volatile("s_waitcnt vmcnt(0)" ::: "memory");
        __builtin_amdgcn_s_barrier(); asm volatile("" ::: "memory");
        if (t + D < 32) SG_STAGE(t + D);
        const int so = (t % NSL) * SLOT;
        bf16x8 Af[2][2], Bf[2][2];
#pragma unroll
        for (int i = 0; i < 2; ++i)
#pragma unroll
            for (int ks = 0; ks < 2; ++ks) { Af[i][ks] = *(const LAS bf16x8*)(lds + so + aoff + i * 2048 + ks * 1024); Bf[i][ks] = *(const LAS bf16x8*)(lds + so + boff + i * 2048 + ks * 1024); }
        asm volatile("s_waitcnt lgkmcnt(0)" ::: "memory");
#pragma unroll
        for (int ks = 0; ks < 2; ++ks)
#pragma unroll
            for (int mi = 0; mi < 2; ++mi)
#pragma unroll
                for (int ni = 0; ni < 2; ++ni) acc[mi][ni] = MFMA16(Bf[ni][ks], Af[mi][ks], acc[mi][ni]);
    }
#undef SG_STAGE
    E(acc, wm, wn, fr, fq);
}
__device__ __forceinline__ void st16_sc1u(bf16_t* p, u32x4 v) { asm volatile("global_store_dwordx4 %0, %1, off sc1\n\ts_nop 1" :: "v"(p), "v"(v) : "memory"); }
__device__ __forceinline__ void pair16(const unsigned long long (&w)[4], bool odd, u32x4& o0, u32x4& o1) {
    const unsigned long long s0 = odd ? w[0] : w[1], s1 = odd ? w[2] : w[3];
    const unsigned long long r0 = __shfl_xor(s0, 16), r1 = __shfl_xor(s1, 16);
    const unsigned long long k0 = odd ? w[1] : w[0], k1 = odd ? w[3] : w[2];
    const unsigned long long lo0 = odd ? r0 : k0, hi0 = odd ? k0 : r0, lo1 = odd ? r1 : k1, hi1 = odd ? k1 : r1;
    o0.x = (unsigned)lo0; o0.y = (unsigned)(lo0 >> 32); o0.z = (unsigned)hi0; o0.w = (unsigned)(hi0 >> 32);
    o1.x = (unsigned)lo1; o1.y = (unsigned)(lo1 >> 32); o1.z = (unsigned)hi1; o1.w = (unsigned)(hi1 >> 32);
}
__device__ __forceinline__ void st16_sc1(float* p, f32x4 v) { asm volatile("global_store_dwordx4 %0, %1, off sc1\n\ts_nop 1" :: "v"(p), "v"(v) : "memory"); }
struct SgEpiBf16 { bf16_t* O; int ldc; const float* ss;
    __device__ __forceinline__ void operator()(const f32x4 (&acc)[2][2], int wm, int wn, int fr, int fq) const {
        const float sv[2] = {ss[32 * wm + fr], ss[32 * wm + 16 + fr]};
        unsigned long long w[4];
#pragma unroll
        for (int mi = 0; mi < 2; ++mi) { const float sc = rsqrtf(sv[mi] * (1.0f / DM) + EPS);
#pragma unroll
            for (int ni = 0; ni < 2; ++ni) { const f32x4 a = acc[mi][ni]; w[mi * 2 + ni] = (unsigned long long)pk2(a[0] * sc, a[1] * sc) | ((unsigned long long)pk2(a[2] * sc, a[3] * sc) << 32); } }
        const bool odd = (fq & 1) != 0; u32x4 o0, o1; pair16(w, odd, o0, o1);
        const int col = 32 * wn + (odd ? 16 : 0) + 4 * (fq & ~1);
        st16_sc1u(O + (size_t)(32 * wm + fr) * ldc + col, o0); st16_sc1u(O + (size_t)(32 * wm + 16 + fr) * ldc + col, o1); } };
struct SgEpiF32 { float* O; int ldc; const float* ss;
    __device__ __forceinline__ void operator()(const f32x4 (&acc)[2][2], int wm, int wn, int fr, int fq) const {
        const float sv[2] = {ss[32 * wm + fr], ss[32 * wm + 16 + fr]};
#pragma unroll
        for (int mi = 0; mi < 2; ++mi) { const int row = 32 * wm + 16 * mi + fr; const float sc = rsqrtf(sv[mi] * (1.0f / DM) + EPS);
#pragma unroll
            for (int ni = 0; ni < 2; ++ni) { const int col = 32 * wn + 16 * ni + 4 * fq; st16_sc1(O + (size_t)row * ldc + col, acc[mi][ni] * sc); } } } };
struct SgEpiOut { const float* base; float* out; bf16_t* xb; float* ssn;
    __device__ __forceinline__ void operator()(const f32x4 (&acc)[2][2], int wm, int wn, int fr, int fq) const {
        f32x4 bv[2][2];
#pragma unroll
        for (int mi = 0; mi < 2; ++mi)
#pragma unroll
            for (int ni = 0; ni < 2; ++ni) bv[mi][ni] = *(const f32x4*)(base + (size_t)(32 * wm + 16 * mi + fr) * DM + 32 * wn + 16 * ni + 4 * fq);
#pragma unroll
        for (int mi = 0; mi < 2; ++mi) { const int row = 32 * wm + 16 * mi + fr; float s = 0.f;
#pragma unroll
            for (int ni = 0; ni < 2; ++ni) { const int col = 32 * wn + 16 * ni + 4 * fq; const size_t o = (size_t)row * DM + col; const f32x4 y = bv[mi][ni] + acc[mi][ni]; *(f32x4*)(out + o) = y;
                if (xb) { u32x2 w; w.x = pk2(y[0], y[1]); w.y = pk2(y[2], y[3]); *(u32x2*)(xb + o) = w; s += (y[0] * y[0] + y[1] * y[1]) + (y[2] * y[2] + y[3] * y[3]); } }
            if (xb) { s += __shfl_xor(s, 16); s += __shfl_xor(s, 32); if (fq == 0) atomicAdd(ssn + row, s); } } } };

__device__ __forceinline__ void conv_unit(Ctx& F, int l, int cu) {
    const bf16_t* proj = (const bf16_t*)(F.ws + WS_PROJ); bf16_t* mix = (bf16_t*)(F.ws + WS_MIX);
    const int R0 = cu * 32, b = R0 >> 12, t0 = R0 & 4095, tg = F.tid >> 6, c8 = (F.tid & 63) * 8, ts = t0 + tg * 4;
    const float* cw = F.a->in[IN_CONVW] + l * 3 * 512;
    const bool halo = ts >= 2; const int th = halo ? ts - 2 : 0;
    const bf16_t* ph = proj + (size_t)(b * SEQ + th) * PN; const bf16_t* p0 = proj + (size_t)(b * SEQ + ts) * PN;
    u32x4 ru[6], rg[4];
#pragma unroll
    for (int i = 0; i < 2; ++i) ru[i] = *(const u32x4*)(ph + (size_t)i * PN + C_AC + c8);
#pragma unroll
    for (int i = 0; i < 4; ++i) { ru[2 + i] = *(const u32x4*)(p0 + (size_t)i * PN + C_AC + c8); rg[i] = __builtin_nontemporal_load((const u32x4*)(p0 + (size_t)i * PN + C_AB + c8)); }
    float w0[8], w1[8], w2[8], u[6][8];
#pragma unroll
    for (int j = 0; j < 8; ++j) { w0[j] = cw[c8 + j]; w1[j] = cw[512 + c8 + j]; w2[j] = cw[1024 + c8 + j]; }
    QTICKET(F);
#pragma unroll
    for (int i = 0; i < 6; ++i) { unpack8(ru[i], u[i]);
        if (i < 2 && !halo) {
#pragma unroll
            for (int j = 0; j < 8; ++j) u[i][j] = 0.f; } }
#pragma unroll
    for (int i = 0; i < 4; ++i) { const size_t row = (size_t)(b * SEQ + ts + i); float g[8], y[8]; unpack8(rg[i], g);
#pragma unroll
        for (int j = 0; j < 8; ++j) y[j] = g[j] * (w0[j] * u[i][j] + w1[j] * u[i + 1][j] + w2[j] * u[i + 2][j]);
        st16_sc1u(mix + row * DM + c8, pack8(y)); }
}

__device__ __forceinline__ void swa_unit(Ctx& F, int l, int un) {
    constexpr int PK = 144, VOFF = 256 * PK;
    const bf16_t* proj = (const bf16_t*)(F.ws + WS_PROJ); bf16_t* mix = (bf16_t*)(F.ws + WS_MIX);
    LAS unsigned char* Kl = F.lds; LAS unsigned char* Vl = F.lds + VOFF;
    const int blk = un & 31, kvh = (un >> 5) & 1, b = un >> 6, t0 = blk * 128;
    const int fr = F.lane & 15, fq = F.lane >> 4;
    const int qi = 16 * F.wave + fr; const size_t row = (size_t)(b * SEQ + t0 + qi); const bf16_t* pr = proj + row * PN;
    u32x4 kraw[4], vraw[4], qraw[4][2];
#pragma unroll
    for (int i = 0; i < 4; ++i) { const int p = F.tid + 512 * i, kj = p >> 3, ch = p & 7, tok = t0 - 128 + kj; const int tk = tok >= 0 ? tok : 0;
        const bf16_t* pp = proj + (size_t)(b * SEQ + tk) * PN; kraw[i] = *(const u32x4*)(pp + C_SK + kvh * 64 + ch * 8); vraw[i] = *(const u32x4*)(pp + C_SV + kvh * 64 + ch * 8);
        if (tok < 0) { kraw[i] = (u32x4){0u, 0u, 0u, 0u}; vraw[i] = kraw[i]; } }
#pragma unroll
    for (int g = 0; g < 4; ++g) {
#pragma unroll
        for (int ks = 0; ks < 2; ++ks) qraw[g][ks] = *(const u32x4*)(pr + C_SQ + (kvh * 4 + g) * 64 + ks * 32 + fq * 8);
    }
    f32x4 gkv[2], gqv[2][2]; float sinkv[4];
    {   const float* gkp = F.a->in[IN_GSWK] + l * 64 + (F.tid & 7) * 8; gkv[0] = ((const f32x4*)gkp)[0]; gkv[1] = ((const f32x4*)gkp)[1];
        const float* gqp = F.a->in[IN_GSWQ] + l * 64;
#pragma unroll
        for (int ks = 0; ks < 2; ++ks) { gqv[ks][0] = *(const f32x4*)(gqp + ks * 32 + fq * 8); gqv[ks][1] = *(const f32x4*)(gqp + ks * 32 + fq * 8 + 4); }
        const float* skp = F.a->in[IN_SINKS] + l * 8 + kvh * 4;
#pragma unroll
        for (int g = 0; g < 4; ++g) sinkv[g] = skp[g]; }
    QTICKET(F);
    __syncthreads();
    {   const float gk[8] = {gkv[0].x, gkv[0].y, gkv[0].z, gkv[0].w, gkv[1].x, gkv[1].y, gkv[1].z, gkv[1].w};
        const bool wout = (blk == 31);
#pragma unroll
        for (int i = 0; i < 4; ++i) { const int p = F.tid + 512 * i, kj = p >> 3, ch = p & 7;
            float k[8]; unpack8(kraw[i], k); float ss = 0.f;
#pragma unroll
            for (int j = 0; j < 8; ++j) ss += k[j] * k[j];
            ss += __shfl_xor(ss, 1); ss += __shfl_xor(ss, 2); ss += __shfl_xor(ss, 4);
            const float rs = rsqrtf(ss * (1.f / 64.f) + EPS);
#pragma unroll
            for (int j = 0; j < 8; ++j) k[j] = k[j] * rs * gk[j];
            *(LAS u32x4*)(Kl + kj * PK + ch * 16) = pack8(k); *(LAS u32x4*)(Vl + kj * PK + ch * 16) = vraw[i];
            if (wout && kj >= 128) { const size_t o = ((size_t)(l * 2 + b) * 128 + (kj - 128)) * 128 + kvh * 64 + ch * 8; float v[8]; unpack8(vraw[i], v);
#pragma unroll
                for (int j = 0; j < 8; ++j) { F.out[O_SWKP + o + j] = k[j]; F.out[O_SWVP + o + j] = v[j]; } }
        }
    }
    __syncthreads();
    const int e = F.wave & ~1;
#define SCHED_FENCE() __builtin_amdgcn_sched_barrier(0)
#pragma unroll 1
    for (int g = 0; g < 4; ++g) {
        const int h = kvh * 4 + g;
        u32x2 zq[4];
#pragma unroll
        for (int db = 0; db < 4; ++db) zq[db] = *(const u32x2*)(pr + C_SZ + h * 64 + 16 * db + 4 * fq);
        bf16x8 kf[20];
#pragma unroll
        for (int kb = 0; kb < 10; ++kb)
#pragma unroll
            for (int ks = 0; ks < 2; ++ks) kf[2 * kb + ks] = *(const LAS bf16x8*)(Kl + (16 * (e + kb) + fr) * PK + (ks * 32 + fq * 8) * 2);
        bf16x8 Qf[2];
        {   float q[2][8]; float ss = 0.f;
#pragma unroll
            for (int ks = 0; ks < 2; ++ks) { unpack8(g == 0 ? qraw[0][ks] : g == 1 ? qraw[1][ks] : g == 2 ? qraw[2][ks] : qraw[3][ks], q[ks]);
#pragma unroll
                for (int j = 0; j < 8; ++j) ss += q[ks][j] * q[ks][j]; }
            ss += __shfl_xor(ss, 16); ss += __shfl_xor(ss, 32);
            const float rs = rsqrtf(ss * (1.f / 64.f) + EPS) * (0.125f * 1.4426950408889634f);
#pragma unroll
            for (int ks = 0; ks < 2; ++ks) {
#pragma unroll
                for (int j = 0; j < 8; ++j) q[ks][j] = q[ks][j] * rs * gqv[ks][j >> 2][j & 3];
                Qf[ks] = __builtin_bit_cast(bf16x8, pack8(q[ks])); }
        }
        SCHED_FENCE();
        f32x4 S[10];
#pragma unroll
        for (int kb = 0; kb < 10; ++kb) { f32x4 a = (f32x4){0.f, 0.f, 0.f, 0.f}; a = MFMA16(kf[2 * kb], Qf[0], a); a = MFMA16(kf[2 * kb + 1], Qf[1], a); S[kb] = a; }
        SCHED_FENCE();
        s16x4 vf[40];
#pragma unroll
        for (int p = 0; p < 5; ++p)
#pragma unroll
            for (int db = 0; db < 4; ++db) { vf[(p * 4 + db) * 2] = tr4(Vl, PK, 16 * (e + 2 * p) + 4 * fq, 16 * db, fr); vf[(p * 4 + db) * 2 + 1] = tr4(Vl, PK, 16 * (e + 2 * p + 1) + 4 * fq, 16 * db, fr); }
        SCHED_FENCE();
        const float sink = (g == 0 ? sinkv[0] : g == 1 ? sinkv[1] : g == 2 ? sinkv[2] : sinkv[3]) * 1.4426950408889634f;
        float m = sink;
#pragma unroll
        for (int kb = 0; kb < 10; ++kb) { const int d = e + kb - F.wave;
            const bool hidden = (d < 0) || (d > 8) || (blk == 0 && (e + kb) < 8);
            if (hidden) { S[kb] = (f32x4){-INFINITY, -INFINITY, -INFINITY, -INFINITY}; }
            else if (d == 0) {
#pragma unroll
                for (int i = 0; i < 4; ++i) if (4 * fq + i <= fr) S[kb][i] = -INFINITY; }
            else if (d == 8) {
#pragma unroll
                for (int i = 0; i < 4; ++i) if (4 * fq + i > fr) S[kb][i] = -INFINITY; }
#pragma unroll
            for (int i = 0; i < 4; ++i) m = fmaxf(m, S[kb][i]); }
        m = fmaxf(m, __shfl_xor(m, 16)); m = fmaxf(m, __shfl_xor(m, 32));
        float sum = 0.f;
#pragma unroll
        for (int kb = 0; kb < 10; ++kb)
#pragma unroll
            for (int i = 0; i < 4; ++i) { const float ev = __builtin_amdgcn_exp2f(S[kb][i] - m); S[kb][i] = ev; sum += ev; }
        sum += __shfl_xor(sum, 16); sum += __shfl_xor(sum, 32);
        sum += __builtin_amdgcn_exp2f(sink - m);
        const float inv = __builtin_amdgcn_rcpf(sum);
        bf16x8 Pb[5];
#pragma unroll
        for (int p = 0; p < 5; ++p) Pb[p] = pk8f(S[2 * p], S[2 * p + 1]);
        SCHED_FENCE();
        f32x4 o[4];
#pragma unroll
        for (int db = 0; db < 4; ++db) o[db] = (f32x4){0.f, 0.f, 0.f, 0.f};
#pragma unroll
        for (int p = 0; p < 5; ++p)
#pragma unroll
            for (int db = 0; db < 4; ++db) o[db] = MFMA16(cat8(vf[(p * 4 + db) * 2], vf[(p * 4 + db) * 2 + 1]), Pb[p], o[db]);
        SCHED_FENCE();
#pragma unroll
        for (int db = 0; db < 4; ++db) { const int d = 16 * db + 4 * fq; const u32x2 z = zq[db];
            u32x2 w; w.x = pk2(o[db][0] * inv * siluf(bflo(z.x)), o[db][1] * inv * siluf(bfhi(z.x))); w.y = pk2(o[db][2] * inv * siluf(bflo(z.y)), o[db][3] * inv * siluf(bfhi(z.y)));
            *(u32x2*)(mix + row * DM + 1024 + h * 64 + d) = w; }
    }
}

__device__ __forceinline__ void memfin_item(Ctx& F, int it) {
    const int rr = it * 8 + F.wave, lw = rr >> 9, rem = rr & 511, b = rem >> 8, m = rem & 255, head = F.lane >> 4, d0 = (F.lane & 15) * 8;
    const float* src = (const float*)(F.ws + WS_MEMKV) + (size_t)rem * 2048 + lw * 1024 + F.lane * 8;
    const f32x4 k0 = ((const f32x4*)src)[0], k1 = ((const f32x4*)src)[1], v0 = ((const f32x4*)(src + 512))[0], v1 = ((const f32x4*)(src + 512))[1];
    const float* g = F.a->in[IN_GMEMK] + lw * 128 + d0; const f32x4 g0 = ((const f32x4*)g)[0], g1 = ((const f32x4*)g)[1];
    QTICKET(F);
    float ss = (k0.x * k0.x + k0.y * k0.y) + (k0.z * k0.z + k0.w * k0.w) + (k1.x * k1.x + k1.y * k1.y) + (k1.z * k1.z + k1.w * k1.w);
    ss += __shfl_xor(ss, 1); ss += __shfl_xor(ss, 2); ss += __shfl_xor(ss, 4); ss += __shfl_xor(ss, 8);
    const float rs = rsqrtf(ss * (1.f / 128.f) + EPS);
    const f32x4 n0 = k0 * rs * g0, n1 = k1 * rs * g1;
    {   float nn = (n0.x * n0.x + n0.y * n0.y) + (n0.z * n0.z + n0.w * n0.w) + (n1.x * n1.x + n1.y * n1.y) + (n1.z * n1.z + n1.w * n1.w);
        nn += __shfl_xor(nn, 1); nn += __shfl_xor(nn, 2); nn += __shfl_xor(nn, 4); nn += __shfl_xor(nn, 8);
        if ((F.lane & 15) == 0) atomicMax((unsigned*)(F.ctlf + CW_KN2) + (lw * 2 + b) * 4 + head, __float_as_uint(nn)); }
    float* ko = F.out + O_MKP + ((size_t)(lw * 2 + b) * 256 + m) * 512 + F.lane * 8; float* vo = F.out + O_MVP + ((size_t)(lw * 2 + b) * 256 + m) * 512 + F.lane * 8;
    __builtin_nontemporal_store(n0, (f32x4*)ko); __builtin_nontemporal_store(n1, (f32x4*)ko + 1); __builtin_nontemporal_store(v0, (f32x4*)vo); __builtin_nontemporal_store(v1, (f32x4*)vo + 1);
    const size_t bo = ((size_t)((lw * 2 + b) * 4 + head) * 256 + m) * 128 + d0;
    u32x4 kw, vw; kw.x = pk2(n0.x, n0.y); kw.y = pk2(n0.z, n0.w); kw.z = pk2(n1.x, n1.y); kw.w = pk2(n1.z, n1.w);
    vw.x = pk2(v0.x, v0.y); vw.y = pk2(v0.z, v0.w); vw.z = pk2(v1.x, v1.y); vw.w = pk2(v1.z, v1.w);
    *(u32x4*)((bf16_t*)(F.ws + WS_MEMKB) + bo) = kw; *(u32x4*)((bf16_t*)(F.ws + WS_MEMVB) + bo) = vw;
}

template <bool SAMPLE>
__device__ __forceinline__ void mem_unit(Ctx& F, int l, int un) {
    constexpr int PK = 272, VOFF = 256 * PK;
    LAS unsigned char* Kl = F.lds; LAS unsigned char* Vl = F.lds + VOFF;
    const int fr = F.lane & 15, fq = F.lane >> 4;
    int b, h, qb;
    if (SAMPLE) { b = un >> 2; h = un & 3; qb = 0; } else { qb = un & 31; h = (un >> 5) & 3; b = un >> 7; }
    const bf16_t* proj; bf16_t* mix; size_t row;
    if (SAMPLE) { proj = (const bf16_t*)(F.ws + WS_PROJS); mix = (bf16_t*)(F.ws + WS_MIXS); row = (size_t)(b * DS + (fr & 3)); }
    else { proj = (const bf16_t*)(F.ws + WS_PROJ); mix = (bf16_t*)(F.ws + WS_MIX); row = (size_t)(b * SEQ + qb * 128 + 16 * F.wave + fr); }
    const bf16_t* pr = proj + row * PN;
    u32x4 qraw[4]; u32x2 zr[8];
#pragma unroll
    for (int ks = 0; ks < 4; ++ks) qraw[ks] = *(const u32x4*)(pr + C_MQ + h * 128 + ks * 32 + fq * 8);
#pragma unroll
    for (int db = 0; db < 8; ++db) zr[db] = *(const u32x2*)(pr + C_MZ + h * 128 + 16 * db + 4 * fq);
    QTICKET(F);
    if (!SAMPLE) {
        const bf16_t* kb = (const bf16_t*)(F.ws + WS_MEMKB) + (size_t)((l * 2 + b) * 4 + h) * 256 * 128; const bf16_t* vb = (const bf16_t*)(F.ws + WS_MEMVB) + (size_t)((l * 2 + b) * 4 + h) * 256 * 128;
        u32x4 kr[8], vr[8];
#pragma unroll
        for (int i = 0; i < 8; ++i) { const int p = F.tid + 512 * i; kr[i] = *(const u32x4*)(kb + (size_t)p * 8); vr[i] = *(const u32x4*)(vb + (size_t)p * 8); }
        __syncthreads();
#pragma unroll
        for (int i = 0; i < 8; ++i) { const int p = F.tid + 512 * i, m = p >> 4, ch = p & 15; *(LAS u32x4*)(Kl + m * PK + ch * 16) = kr[i]; *(LAS u32x4*)(Vl + m * PK + ch * 16) = vr[i]; }
    } else {
        const float* ck = F.a->in[IN_CMK] + (size_t)(l * DB + b) * 256 * 512 + h * 128; const float* cv = F.a->in[IN_CMV] + (size_t)(l * DB + b) * 256 * 512 + h * 128;
        {   f32x4 kr[16], vr[16];
#pragma unroll
            for (int i = 0; i < 16; ++i) { const int p = F.tid + 512 * i, m = p >> 5, c4 = p & 31; kr[i] = __builtin_nontemporal_load((const f32x4*)(ck + (size_t)m * 512 + c4 * 4)); vr[i] = __builtin_nontemporal_load((const f32x4*)(cv + (size_t)m * 512 + c4 * 4)); }
            __syncthreads();
#pragma unroll
            for (int i = 0; i < 16; ++i) { const int p = F.tid + 512 * i, m = p >> 5, c4 = p & 31;
                u32x2 kw, vw; kw.x = pk2(kr[i].x, kr[i].y); kw.y = pk2(kr[i].z, kr[i].w); vw.x = pk2(vr[i].x, vr[i].y); vw.y = pk2(vr[i].z, vr[i].w);
                *(LAS u32x2*)(Kl + m * PK + c4 * 8) = kw; *(LAS u32x2*)(Vl + m * PK + c4 * 8) = vw; } }
    }
    bf16x8 Qf[4];
    {   const float* gq = F.a->in[IN_GMEMQ] + l * 128; float q[4][8]; float ss = 0.f;
#pragma unroll
        for (int ks = 0; ks < 4; ++ks) { unpack8(qraw[ks], q[ks]);
#pragma unroll
            for (int j = 0; j < 8; ++j) ss += q[ks][j] * q[ks][j]; }
        ss += __shfl_xor(ss, 16); ss += __shfl_xor(ss, 32);
        const float rs = rsqrtf(ss * (1.f / 128.f) + EPS) * 0.08838834764831845f;
#pragma unroll
        for (int ks = 0; ks < 4; ++ks) {
#pragma unroll
            for (int j = 0; j < 8; ++j) q[ks][j] = q[ks][j] * rs * gq[ks * 32 + fq * 8 + j];
            Qf[ks] = __builtin_bit_cast(bf16x8, pack8(q[ks])); }
    }
    __syncthreads();
    if (SAMPLE && F.wave != 0) return;
    f32x4 S[16];
#pragma unroll
    for (int kb = 0; kb < 16; ++kb) { f32x4 a = (f32x4){0.f, 0.f, 0.f, 0.f};
#pragma unroll
        for (int ks = 0; ks < 4; ++ks) { const bf16x8 kf = *(const LAS bf16x8*)(Kl + (16 * kb + fr) * PK + (ks * 32 + fq * 8) * 2); a = MFMA16(kf, Qf[ks], a); }
        S[kb] = a; }
    float m = -INFINITY;
#pragma unroll
    for (int kb = 0; kb < 16; ++kb)
#pragma unroll
        for (int i = 0; i < 4; ++i) m = fmaxf(m, S[kb][i]);
    m = fmaxf(m, __shfl_xor(m, 16)); m = fmaxf(m, __shfl_xor(m, 32));
    float sum = 0.f;
#pragma unroll
    for (int kb = 0; kb < 16; ++kb)
#pragma unroll
        for (int i = 0; i < 4; ++i) { const float ev = __expf(S[kb][i] - m); S[kb][i] = ev; sum += ev; }
    sum += __shfl_xor(sum, 16); sum += __shfl_xor(sum, 32);
    const float inv = __builtin_amdgcn_rcpf(sum);
    f32x4 o[8];
#pragma unroll
    for (int db = 0; db < 8; ++db) o[db] = (f32x4){0.f, 0.f, 0.f, 0.f};
#pragma unroll
    for (int p = 0; p < 8; ++p) { const bf16x8 Pb = pk8f(S[2 * p] * inv, S[2 * p + 1] * inv);
#pragma unroll
        for (int db = 0; db < 8; ++db) { const bf16x8 Va = cat8(tr4(Vl, PK, 32 * p + 4 * fq, 16 * db, fr), tr4(Vl, PK, 32 * p + 16 + 4 * fq, 16 * db, fr));
            o[db] = MFMA16(Va, Pb, o[db]); } }
    if (SAMPLE && fr >= 4) return;
#pragma unroll
    for (int db = 0; db < 8; ++db) { const int d = 16 * db + 4 * fq;
        u32x2 w; w.x = pk2(o[db][0] * siluf(bflo(zr[db].x)), o[db][1] * siluf(bfhi(zr[db].x))); w.y = pk2(o[db][2] * siluf(bflo(zr[db].y)), o[db][3] * siluf(bfhi(zr[db].y)));
        *(u32x2*)(mix + row * DM + 1536 + h * 128 + d) = w; }
}

template <bool SC1>
__device__ __forceinline__ void memp_unit(Ctx& F, int l, int un) {
    constexpr int PK = 272, VOFF = 256 * PK;
    LAS unsigned char* Kl = F.lds; LAS unsigned char* Vl = F.lds + VOFF;
    const int fr = F.lane & 15, fq = F.lane >> 4;
    const int qb = un & 15, h = (un >> 4) & 3, b = un >> 6;
    const bf16_t* proj = (const bf16_t*)(F.ws + WS_PROJ); bf16_t* mix = (bf16_t*)(F.ws + WS_MIX);
    const size_t row0 = (size_t)(b * SEQ + qb * 256 + 32 * F.wave + fr);
    u32x4 qraw[2][4];
#pragma unroll
    for (int qq = 0; qq < 2; ++qq)
#pragma unroll
        for (int ks = 0; ks < 4; ++ks) qraw[qq][ks] = __builtin_nontemporal_load((const u32x4*)(proj + (row0 + 16 * qq) * PN + C_MQ + h * 128 + ks * 32 + fq * 8));
    f32x4 gqv[4][2];
#pragma unroll
    for (int ks = 0; ks < 4; ++ks) { const float* gqp = F.a->in[IN_GMEMQ] + l * 128 + ks * 32 + fq * 8; gqv[ks][0] = ((const f32x4*)gqp)[0]; gqv[ks][1] = ((const f32x4*)gqp)[1]; }
    const float kn2 = F.ctlf[CW_KN2 + (l * 2 + b) * 4 + h];
    {   const bf16_t* kb = (const bf16_t*)(F.ws + WS_MEMKB) + (size_t)((l * 2 + b) * 4 + h) * 256 * 128; const bf16_t* vb = (const bf16_t*)(F.ws + WS_MEMVB) + (size_t)((l * 2 + b) * 4 + h) * 256 * 128;
        u32x4 kr[8], vr[8];
#pragma unroll
        for (int i = 0; i < 8; ++i) { const int p = F.tid + 512 * i; kr[i] = *(const u32x4*)(kb + (size_t)p * 8); vr[i] = *(const u32x4*)(vb + (size_t)p * 8); }
        QTICKET(F);
        __syncthreads();
#pragma unroll
        for (int i = 0; i < 8; ++i) { const int p = F.tid + 512 * i, m = p >> 4, ch = p & 15; *(LAS u32x4*)(Kl + m * PK + ch * 16) = kr[i]; *(LAS u32x4*)(Vl + m * PK + ch * 16) = vr[i]; }
    }
    bf16x8 Qf[2][4]; float shift[2];
    {
#pragma unroll
        for (int qq = 0; qq < 2; ++qq) { float q[4][8]; float ss = 0.f, nn = 0.f;
#pragma unroll
            for (int ks = 0; ks < 4; ++ks) { unpack8(qraw[qq][ks], q[ks]);
#pragma unroll
                for (int j = 0; j < 8; ++j) ss += q[ks][j] * q[ks][j]; }
            ss += __shfl_xor(ss, 16); ss += __shfl_xor(ss, 32);
            const float rs = rsqrtf(ss * (1.f / 128.f) + EPS) * (0.08838834764831845f * 1.4426950408889634f);
#pragma unroll
            for (int ks = 0; ks < 4; ++ks) {
#pragma unroll
                for (int j = 0; j < 8; ++j) { q[ks][j] = q[ks][j] * rs * gqv[ks][j >> 2][j & 3]; nn += q[ks][j] * q[ks][j]; }
                Qf[qq][ks] = __builtin_bit_cast(bf16x8, pack8(q[ks])); }
            nn += __shfl_xor(nn, 16); nn += __shfl_xor(nn, 32);
            shift[qq] = sqrtf(nn * kn2) * 1.01f; }
    }
    __syncthreads();
    u32x2 zr2[2][8];
#pragma unroll
    for (int qq = 0; qq < 2; ++qq)
#pragma unroll
        for (int db = 0; db < 8; ++db) zr2[qq][db] = __builtin_nontemporal_load((const u32x2*)(proj + (row0 + 16 * qq) * PN + C_MZ + h * 128 + 16 * db + 4 * fq));
    f32x4 o[2][8]; float sum[2] = {0.f, 0.f};
#pragma unroll
    for (int qq = 0; qq < 2; ++qq)
#pragma unroll
        for (int db = 0; db < 8; ++db) o[qq][db] = (f32x4){0.f, 0.f, 0.f, 0.f};
#pragma unroll 2
    for (int p = 0; p < 8; ++p) {
        f32x4 S[2][2];
#pragma unroll
        for (int kk = 0; kk < 2; ++kk) { f32x4 a0 = (f32x4){0.f, 0.f, 0.f, 0.f}, a1 = a0;
#pragma unroll
            for (int ks = 0; ks < 4; ++ks) { const bf16x8 kf = *(const LAS bf16x8*)(Kl + (16 * (2 * p + kk) + fr) * PK + (ks * 32 + fq * 8) * 2); a0 = MFMA16(kf, Qf[0][ks], a0); a1 = MFMA16(kf, Qf[1][ks], a1); }
            S[0][kk] = a0; S[1][kk] = a1; }
        bf16x8 Pb[2];
#pragma unroll
        for (int qq = 0; qq < 2; ++qq) {
#pragma unroll
            for (int kk = 0; kk < 2; ++kk)
#pragma unroll
                for (int i = 0; i < 4; ++i) { const float ev = __builtin_amdgcn_exp2f(S[qq][kk][i] - shift[qq]); S[qq][kk][i] = ev; sum[qq] += ev; }
            Pb[qq] = pk8f(S[qq][0], S[qq][1]); }
#pragma unroll
        for (int db = 0; db < 8; ++db) { const bf16x8 Va = cat8(tr4(Vl, PK, 32 * p + 4 * fq, 16 * db, fr), tr4(Vl, PK, 32 * p + 16 + 4 * fq, 16 * db, fr));
            o[0][db] = MFMA16(Va, Pb[0], o[0][db]); o[1][db] = MFMA16(Va, Pb[1], o[1][db]); }
    }
#pragma unroll
    for (int qq = 0; qq < 2; ++qq) { float sm = sum[qq]; sm += __shfl_xor(sm, 16); sm += __shfl_xor(sm, 32); const float inv = __builtin_amdgcn_rcpf(sm);
        const size_t row = row0 + 16 * qq; unsigned long long wq[4];
#pragma unroll
        for (int db = 0; db < 8; ++db) { const int d = 16 * db + 4 * fq; const u32x2 z = zr2[qq][db];
            u32x2 w; w.x = pk2(o[qq][db][0] * inv * siluf(bflo(z.x)), o[qq][db][1] * inv * siluf(bfhi(z.x))); w.y = pk2(o[qq][db][2] * inv * siluf(bflo(z.y)), o[qq][db][3] * inv * siluf(bfhi(z.y)));
            if (!SC1) *(u32x2*)(mix + row * DM + 1536 + h * 128 + d) = w;
            else { wq[db & 3] = (unsigned long long)w.x | ((unsigned long long)w.y << 32);
                if ((db & 3) == 3) { const bool odd = (fq & 1) != 0; u32x4 o0, o1; pair16(wq, odd, o0, o1);
                    bf16_t* mp = mix + row * DM + 1536 + h * 128 + 16 * ((db & 4) + (odd ? 1 : 0)) + 4 * (fq & ~1); st16_sc1u(mp, o0); st16_sc1u(mp + 32, o1); } } } }
}

constexpr int GL_CUM = 0, GL_TOT = 16384, GL_GA = 16640, GL_SEG = 20736, GL_A = 24576;
struct GlaPar { float wu[16]; float bias; u32x4 garaw; };
__device__ __forceinline__ void gla_par_load(Ctx& F, int l, int h, const bf16_t* prow0, GlaPar& P) {
    const int dk = F.tid & 63;
    const float* wup = F.a->in[IN_WUP] + (size_t)l * 16 * 256 + h * 64 + dk; const float* bap = F.a->in[IN_BA] + l * 256 + h * 64 + dk;
#pragma unroll
    for (int r = 0; r < 16; ++r) P.wu[r] = wup[r * 256];
    P.bias = bap[0];
    const int t = F.tid & 127; P.garaw = *(const u32x4*)(prow0 + (size_t)(t >> 1) * PN + C_GA + (t & 1) * 8);
}
__device__ __forceinline__ void gla_cum(Ctx& F, const GlaPar& P) {
    LAS float* cumL = (LAS float*)(F.lds + GL_CUM); LAS float* totL = (LAS float*)(F.lds + GL_TOT); LAS float* gaL = (LAS float*)(F.lds + GL_GA); LAS float* segL = (LAS float*)(F.lds + GL_SEG);
    if (F.tid < 128) { const int s = F.tid >> 1, hf = F.tid & 1; float g[8]; unpack8(P.garaw, g);
#pragma unroll
        for (int j = 0; j < 8; ++j) gaL[s * 16 + hf * 8 + j] = g[j]; }
    const int dk = F.tid & 63, sg = F.tid >> 6;
    const float* wu = P.wu; const float bias = P.bias;
    __syncthreads();
    float c[8]; float run = 0.f;
#pragma unroll
    for (int i = 0; i < 8; ++i) { const int s = sg * 8 + i; float x = bias;
#pragma unroll
        for (int r = 0; r < 16; ++r) x += gaL[s * 16 + r] * wu[r];
        run += logsigf(x) * (1.f / 16.f); c[i] = run; }
    segL[sg * 64 + dk] = run;
    __syncthreads();
    float off = 0.f, tot = 0.f;
#pragma unroll
    for (int s2 = 0; s2 < 8; ++s2) { const float v = segL[s2 * 64 + dk]; tot += v; if (s2 < sg) off += v; }
#pragma unroll
    for (int i = 0; i < 8; ++i) cumL[(sg * 8 + i) * 64 + dk] = off + c[i];
    if (sg == 0) totL[dk] = tot;
    __syncthreads();
}
__device__ __forceinline__ void glaA_unit(Ctx& F, int l, int un) {
    constexpr int PKT = 144, PV = 272, KT = GL_A, VL = GL_A + 64 * PKT;
    const bf16_t* proj = (const bf16_t*)(F.ws + WS_PROJ);
    const int c = un & 63, h = (un >> 6) & 3, b = un >> 8, fr = F.lane & 15, fq = F.lane >> 4;
    const bf16_t* prow0 = proj + (size_t)(b * SEQ + c * 64) * PN;
    LAS float* cumL = (LAS float*)(F.lds + GL_CUM); LAS float* totL = (LAS float*)(F.lds + GL_TOT);
    const int s = F.tid >> 3, ch = F.tid & 7;
    const u32x4 kraw = *(const u32x4*)(prow0 + (size_t)s * PN + C_GK + h * 64 + ch * 8);
    u32x4 vraw[2];
#pragma unroll
    for (int i = 0; i < 2; ++i) { const int p = F.tid + 512 * i, s2 = p >> 4, c2 = p & 15; vraw[i] = *(const u32x4*)(prow0 + (size_t)s2 * PN + C_GV + h * 128 + c2 * 8); }
    GlaPar GP; gla_par_load(F, l, h, prow0, GP);
    QTICKET(F);
    __syncthreads();
    gla_cum(F, GP);
    {   float k[8]; unpack8(kraw, k);
        const f32x4 c0 = *(const LAS f32x4*)(cumL + s * 64 + ch * 8), c1 = *(const LAS f32x4*)(cumL + s * 64 + ch * 8 + 4);
        float* cg = (float*)(F.ws + WS_GLACUM) + (size_t)un * 4096 + s * 64 + ch * 8; *(f32x4*)cg = c0; *(f32x4*)(cg + 4) = c1;
        const float cm[8] = {c0.x, c0.y, c0.z, c0.w, c1.x, c1.y, c1.z, c1.w};
#pragma unroll
        for (int j = 0; j < 8; ++j) k[j] *= __expf(totL[ch * 8 + j] - cm[j]);
        *(LAS u32x4*)(F.lds + KT + s * PKT + ch * 16) = pack8(k);
#pragma unroll
        for (int i = 0; i < 2; ++i) { const int p = F.tid + 512 * i, s2 = p >> 4, c2 = p & 15; *(LAS u32x4*)(F.lds + VL + s2 * PV + c2 * 16) = vraw[i]; }
    }
    __syncthreads();
    f32x4 acc[4];
#pragma unroll
    for (int db = 0; db < 4; ++db) acc[db] = (f32x4){0.f, 0.f, 0.f, 0.f};
#pragma unroll
    for (int ks = 0; ks < 2; ++ks) { const bf16x8 Bv = cat8(tr4(F.lds + VL, PV, 32 * ks + 8 * fq, 16 * F.wave, fr), tr4(F.lds + VL, PV, 32 * ks + 8 * fq + 4, 16 * F.wave, fr));
#pragma unroll
        for (int db = 0; db < 4; ++db) { const bf16x8 Ak = cat8(tr4(F.lds + KT, PKT, 32 * ks + 8 * fq, 16 * db, fr), tr4(F.lds + KT, PKT, 32 * ks + 8 * fq + 4, 16 * db, fr));
            acc[db] = MFMA16(Bv, Ak, acc[db]); } }
    bf16_t* kv = (bf16_t*)(F.ws + WS_GLAKV) + (size_t)un * 8192;
    {   unsigned long long w[4];
#pragma unroll
        for (int db = 0; db < 4; ++db) w[db] = (unsigned long long)pk2(acc[db][0], acc[db][1]) | ((unsigned long long)pk2(acc[db][2], acc[db][3]) << 32);
        const bool odd = (fq & 1) != 0; u32x4 o0, o1; pair16(w, odd, o0, o1);
        bf16_t* kp = kv + (16 * (odd ? 1 : 0) + fr) * 128 + 16 * F.wave + 4 * (fq & ~1);
        st16_sc1u(kp, o0); st16_sc1u(kp + 32 * 128, o1); }
    if (F.tid < 64) __hip_atomic_store((float*)(F.ws + WS_GLADEC) + un * 64 + F.tid, __expf(totL[F.tid]), RLX_AGENT);
}
constexpr int GL2 = 51200;
__device__ __forceinline__ void glaA2_unit(Ctx& F, int l, int un2) {
    constexpr int PKT = 144, PV = 272, KT = GL_A, VL = GL_A + 64 * PKT;
    const bf16_t* proj = (const bf16_t*)(F.ws + WS_PROJ);
    const int cc = un2 & 31, h = (un2 >> 5) & 3, b = un2 >> 7, fr = F.lane & 15, fq = F.lane >> 4;
    const int s = F.tid >> 3, ch = F.tid & 7, dk = F.tid & 63, sg = F.tid >> 6;
    u32x4 kraw[2], vraw[2][2], garaw[2]; float wu[16], bias;
#pragma unroll
    for (int j = 0; j < 2; ++j) { const bf16_t* prow0 = proj + (size_t)(b * SEQ + (2 * cc + j) * 64) * PN;
        kraw[j] = *(const u32x4*)(prow0 + (size_t)s * PN + C_GK + h * 64 + ch * 8);
#pragma unroll
        for (int i = 0; i < 2; ++i) { const int p = F.tid + 512 * i, s2 = p >> 4, c2 = p & 15; vraw[j][i] = *(const u32x4*)(prow0 + (size_t)s2 * PN + C_GV + h * 128 + c2 * 8); }
        const int t = F.tid & 127; garaw[j] = *(const u32x4*)(prow0 + (size_t)(t >> 1) * PN + C_GA + (t & 1) * 8); }
    {   const float* wup = F.a->in[IN_WUP] + (size_t)l * 16 * 256 + h * 64 + dk; const float* bap = F.a->in[IN_BA] + l * 256 + h * 64 + dk;
#pragma unroll
        for (int r = 0; r < 16; ++r) wu[r] = wup[r * 256];
        bias = bap[0]; }
    QTICKET(F);
    if (F.tid < 256) { const int j = F.tid >> 7, t = F.tid & 127, s_ = t >> 1, hf = t & 1; float g[8]; unpack8(j == 0 ? garaw[0] : garaw[1], g); LAS float* gaL = (LAS float*)(F.lds + j * GL2 + GL_GA);
#pragma unroll
        for (int q = 0; q < 8; ++q) gaL[s_ * 16 + hf * 8 + q] = g[q]; }
    __syncthreads();
    float cp[2][8];
#pragma unroll
    for (int j = 0; j < 2; ++j) { const LAS float* gaL = (const LAS float*)(F.lds + j * GL2 + GL_GA); LAS float* segL = (LAS float*)(F.lds + j * GL2 + GL_SEG); float run = 0.f;
#pragma unroll
        for (int i = 0; i < 8; ++i) { const int s_ = sg * 8 + i; float x = bias;
#pragma unroll
            for (int r = 0; r < 16; ++r) x += gaL[s_ * 16 + r] * wu[r];
            run += logsigf(x) * (1.f / 16.f); cp[j][i] = run; }
        segL[sg * 64 + dk] = run; }
    __syncthreads();
#pragma unroll
    for (int j = 0; j < 2; ++j) { const LAS float* segL = (const LAS float*)(F.lds + j * GL2 + GL_SEG); LAS float* cumL = (LAS float*)(F.lds + j * GL2 + GL_CUM); LAS float* totL = (LAS float*)(F.lds + j * GL2 + GL_TOT);
        float off = 0.f, tot = 0.f;
#pragma unroll
        for (int s2 = 0; s2 < 8; ++s2) { const float v = segL[s2 * 64 + dk]; tot += v; if (s2 < sg) off += v; }
#pragma unroll
        for (int i = 0; i < 8; ++i) cumL[(sg * 8 + i) * 64 + dk] = off + cp[j][i];
        if (sg == 0) totL[dk] = tot; }
    __syncthreads();
#pragma unroll
    for (int j = 0; j < 2; ++j) { const int un = (b * 4 + h) * 64 + 2 * cc + j; LAS unsigned char* L = F.lds + j * GL2; const LAS float* cumL = (const LAS float*)(L + GL_CUM); const LAS float* totL = (const LAS float*)(L + GL_TOT);
        float k[8]; unpack8(kraw[j], k);
        const f32x4 c0 = *(const LAS f32x4*)(cumL + s * 64 + ch * 8), c1 = *(const LAS f32x4*)(cumL + s * 64 + ch * 8 + 4);
        float* cg = (float*)(F.ws + WS_GLACUM) + (size_t)un * 4096 + s * 64 + ch * 8; *(f32x4*)cg = c0; *(f32x4*)(cg + 4) = c1;
        const float cm[8] = {c0.x, c0.y, c0.z, c0.w, c1.x, c1.y, c1.z, c1.w};
#pragma unroll
        for (int q = 0; q < 8; ++q) k[q] *= __expf(totL[ch * 8 + q] - cm[q]);
        *(LAS u32x4*)(L + KT + s * PKT + ch * 16) = pack8(k);
#pragma unroll
        for (int i = 0; i < 2; ++i) { const int p = F.tid + 512 * i, s2 = p >> 4, c2 = p & 15; *(LAS u32x4*)(L + VL + s2 * PV + c2 * 16) = vraw[j][i]; } }
    __syncthreads();
#pragma unroll
    for (int j = 0; j < 2; ++j) { const int un = (b * 4 + h) * 64 + 2 * cc + j; LAS unsigned char* L = F.lds + j * GL2;
        f32x4 acc[4];
#pragma unroll
        for (int db = 0; db < 4; ++db) acc[db] = (f32x4){0.f, 0.f, 0.f, 0.f};
#pragma unroll
        for (int ks = 0; ks < 2; ++ks) { const bf16x8 Bv = cat8(tr4(L + VL, PV, 32 * ks + 8 * fq, 16 * F.wave, fr), tr4(L + VL, PV, 32 * ks + 8 * fq + 4, 16 * F.wave, fr));
#pragma unroll
            for (int db = 0; db < 4; ++db) { const bf16x8 Ak = cat8(tr4(L + KT, PKT, 32 * ks + 8 * fq, 16 * db, fr), tr4(L + KT, PKT, 32 * ks + 8 * fq + 4, 16 * db, fr));
                acc[db] = MFMA16(Bv, Ak, acc[db]); } }
        bf16_t* kv = (bf16_t*)(F.ws + WS_GLAKV) + (size_t)un * 8192;
        unsigned long long w[4];
#pragma unroll
        for (int db = 0; db < 4; ++db) w[db] = (unsigned long long)pk2(acc[db][0], acc[db][1]) | ((unsigned long long)pk2(acc[db][2], acc[db][3]) << 32);
        const bool odd = (fq & 1) != 0; u32x4 o0, o1; pair16(w, odd, o0, o1);
        bf16_t* kp = kv + (16 * (odd ? 1 : 0) + fr) * 128 + 16 * F.wave + 4 * (fq & ~1);
        st16_sc1u(kp, o0); st16_sc1u(kp + 32 * 128, o1); }
    if (F.tid < 128) { const int j = F.tid >> 6, d_ = F.tid & 63; const LAS float* totL = (const LAS float*)(F.lds + j * GL2 + GL_TOT);
        __hip_atomic_store((float*)(F.ws + WS_GLADEC) + ((b * 4 + h) * 64 + 2 * cc + j) * 64 + d_, __expf(totL[d_]), RLX_AGENT); }
}
__device__ __forceinline__ void gla_scan_item(Ctx& F, int l, int si) {
    const int gid = si * 512 + F.tid, bh = gid >> 13, d = (gid >> 7) & 63, v = gid & 127;
    const bf16_t* kv = (const bf16_t*)(F.ws + WS_GLAKV) + (size_t)bh * 64 * 8192 + d * 128 + v;
    const float* dec = (const float*)(F.ws + WS_GLADEC) + (size_t)bh * 64 * 64 + d;
    bf16_t* st = (bf16_t*)(F.ws + WS_GLAST) + (size_t)bh * 64 * 8192 + d * 128 + v;
    float S = 0.f;
    unsigned short kr[64]; float dd[64];
#pragma unroll
    for (int i = 0; i < 64; ++i) { kr[i] = __builtin_nontemporal_load(kv + (size_t)i * 8192); dd[i] = dec[i * 64]; }
    QTICKET(F);
#pragma unroll
    for (int i = 0; i < 64; ++i) { st[(size_t)i * 8192] = (bf16_t)f2bf(S); S = dd[i] * S + bf1(kr[i]); }
    __builtin_nontemporal_store(S, F.out + O_GLAP + ((size_t)(l * 8 + bh) * 64 + d) * 128 + v);
}
__device__ __forceinline__ void glaC_unit(Ctx& F, int l, int un) {
    constexpr int PQ = 144, PV = 272, QD = GL_A, KD = QD + 64 * PQ, VL = KD + 64 * PQ, SL = VL + 64 * PV, SSX = SL + 64 * PV;
    const bf16_t* proj = (const bf16_t*)(F.ws + WS_PROJ); bf16_t* mix = (bf16_t*)(F.ws + WS_MIX);
    const int c = un & 63, h = (un >> 6) & 3, b = un >> 8, fr = F.lane & 15, fq = F.lane >> 4;
    const bf16_t* prow0 = proj + (size_t)(b * SEQ + c * 64) * PN;
    LAS float* cumL = (LAS float*)(F.lds + GL_CUM);
    const int tb = F.wave & 3, vh = F.wave >> 2;
    const size_t row = (size_t)(b * SEQ + c * 64 + 16 * tb + fr);
    const int s = F.tid >> 3, ch = F.tid & 7;
    const u32x4 qraw = __builtin_nontemporal_load((const u32x4*)(prow0 + (size_t)s * PN + C_GQ + h * 64 + ch * 8)), kraw = __builtin_nontemporal_load((const u32x4*)(prow0 + (size_t)s * PN + C_GK + h * 64 + ch * 8));
    u32x4 vraw[2], sraw[2]; u32x2 zr[4]; f32x4 cmr[2];
    {   const float* cg = (const float*)(F.ws + WS_GLACUM) + (size_t)un * 4096 + s * 64 + ch * 8; cmr[0] = __builtin_nontemporal_load((const f32x4*)cg); cmr[1] = __builtin_nontemporal_load((const f32x4*)(cg + 4)); }
    {   const bf16_t* st = (const bf16_t*)(F.ws + WS_GLAST) + (size_t)un * 8192;
#pragma unroll
        for (int i = 0; i < 2; ++i) { const int p = F.tid + 512 * i, s2 = p >> 4, c2 = p & 15;
            vraw[i] = __builtin_nontemporal_load((const u32x4*)(prow0 + (size_t)s2 * PN + C_GV + h * 128 + c2 * 8)); sraw[i] = __builtin_nontemporal_load((const u32x4*)(st + s2 * 128 + c2 * 8)); }
#pragma unroll
        for (int vb = 0; vb < 4; ++vb) zr[vb] = __builtin_nontemporal_load((const u32x2*)(proj + row * PN + C_GZ + h * 128 + 16 * (4 * vh + vb) + 4 * fq));
    }
    f32x4 gov[4];
    const float* gop = F.a->in[IN_GGLAO] + l * 128 + 64 * vh + 4 * fq;
#pragma unroll
    for (int vb = 0; vb < 4; ++vb) gov[vb] = *(const f32x4*)(gop + 16 * vb);
    QTICKET(F);
    __syncthreads();
    {   float q[8], k[8]; unpack8(qraw, q); unpack8(kraw, k);
        const float cmv[8] = {cmr[0].x, cmr[0].y, cmr[0].z, cmr[0].w, cmr[1].x, cmr[1].y, cmr[1].z, cmr[1].w};
#pragma unroll
        for (int j = 0; j < 8; ++j) { const float cm = cmv[j]; q[j] *= 0.125f * __expf(cm); k[j] *= __expf(-cm); }
        *(LAS u32x4*)(F.lds + QD + s * PQ + ch * 16) = pack8(q); *(LAS u32x4*)(F.lds + KD + s * PQ + ch * 16) = pack8(k);
#pragma unroll
        for (int i = 0; i < 2; ++i) { const int p = F.tid + 512 * i, s2 = p >> 4, c2 = p & 15;
            *(LAS u32x4*)(F.lds + VL + s2 * PV + c2 * 16) = vraw[i]; *(LAS u32x4*)(F.lds + SL + s2 * PV + c2 * 16) = sraw[i]; }
    }
    __syncthreads();
    bf16x8 Qf[2];
#pragma unroll
    for (int ks = 0; ks < 2; ++ks) Qf[ks] = *(const LAS bf16x8*)(F.lds + QD + (16 * tb + fr) * PQ + (ks * 32 + fq * 8) * 2);
    f32x4 P[4];
#pragma unroll
    for (int sb = 0; sb < 4; ++sb) { f32x4 a = (f32x4){0.f, 0.f, 0.f, 0.f};
        if (sb <= tb) {
#pragma unroll
            for (int ks = 0; ks < 2; ++ks) { const bf16x8 kf = *(const LAS bf16x8*)(F.lds + KD + (16 * sb + fr) * PQ + (ks * 32 + fq * 8) * 2); a = MFMA16(kf, Qf[ks], a); }
            if (sb == tb) {
#pragma unroll
                for (int i = 0; i < 4; ++i) if (4 * fq + i > fr) a[i] = 0.f; } }
        P[sb] = a; }
    f32x4 o[4];
#pragma unroll
    for (int vb = 0; vb < 4; ++vb) o[vb] = (f32x4){0.f, 0.f, 0.f, 0.f};
#pragma unroll
    for (int p = 0; p < 2; ++p) {
        if (2 * p <= tb) { const bf16x8 Pb = pk8f(P[2 * p], P[2 * p + 1]);
#pragma unroll
            for (int vb = 0; vb < 4; ++vb) { const int v0 = 16 * (4 * vh + vb);
                const bf16x8 Va = cat8(tr4(F.lds + VL, PV, 32 * p + 4 * fq, v0, fr), tr4(F.lds + VL, PV, 32 * p + 16 + 4 * fq, v0, fr)); o[vb] = MFMA16(Va, Pb, o[vb]); } } }
#pragma unroll
    for (int ks = 0; ks < 2; ++ks)
#pragma unroll
        for (int vb = 0; vb < 4; ++vb) { const int v0 = 16 * (4 * vh + vb);
            const bf16x8 Sa = cat8(tr4(F.lds + SL, PV, 32 * ks + 8 * fq, v0, fr), tr4(F.lds + SL, PV, 32 * ks + 8 * fq + 4, v0, fr)); o[vb] = MFMA16(Sa, Qf[ks], o[vb]); }
    float ss = 0.f;
#pragma unroll
    for (int vb = 0; vb < 4; ++vb)
#pragma unroll
        for (int i = 0; i < 4; ++i) ss += o[vb][i] * o[vb][i];
    ss += __shfl_xor(ss, 16); ss += __shfl_xor(ss, 32);
    LAS float* ssx = (LAS float*)(F.lds + SSX);
    if (fq == 0) ssx[vh * 64 + 16 * tb + fr] = ss;
    __syncthreads();
    const float tot = ssx[16 * tb + fr] + ssx[64 + 16 * tb + fr];
    const float rs = rsqrtf(tot * (1.f / 128.f) + EPS);
    unsigned long long wq[4];
#pragma unroll
    for (int vb = 0; vb < 4; ++vb) { const f32x4 g = gov[vb];
        wq[vb] = (unsigned long long)pk2(o[vb][0] * rs * g[0] * siluf(bflo(zr[vb].x)), o[vb][1] * rs * g[1] * siluf(bfhi(zr[vb].x)))
               | ((unsigned long long)pk2(o[vb][2] * rs * g[2] * siluf(bflo(zr[vb].y)), o[vb][3] * rs * g[3] * siluf(bfhi(zr[vb].y))) << 32); }
    {   const bool odd = (fq & 1) != 0; u32x4 o0, o1; pair16(wq, odd, o0, o1);
        bf16_t* mp = mix + row * DM + 512 + h * 128 + 16 * (4 * vh + (odd ? 1 : 0)) + 4 * (fq & ~1); st16_sc1u(mp, o0); st16_sc1u(mp + 32, o1); }
}
__device__ __forceinline__ void sgla_unit(Ctx& F, int l, int un) {
    const int b = un >> 2, h = un & 3;
    const bf16_t* projs = (const bf16_t*)(F.ws + WS_PROJS); bf16_t* mixs = (bf16_t*)(F.ws + WS_MIXS);
    float S[16];
    {   const int v_ = F.tid & 127, dg_ = F.tid >> 7; const float* s0_ = F.a->in[IN_SGLA] + ((size_t)((l * DB + b) * 4 + h) * 64 + 16 * dg_) * 128 + v_;
#pragma unroll
        for (int i = 0; i < 16; ++i) S[i] = __builtin_nontemporal_load(s0_ + i * 128); }
    const bf16_t vraw = projs[(size_t)(b * DS + (F.tid >> 7)) * PN + C_GV + h * 128 + (F.tid & 127)];
    const int t4 = (F.tid >> 6) & 3, dk4 = F.tid & 63;
    const bf16_t* pr4 = projs + (size_t)(b * DS + t4) * PN;
    const float* wup = F.a->in[IN_WUP] + (size_t)l * 16 * 256 + h * 64 + dk4; const float bias = F.a->in[IN_BA][l * 256 + h * 64 + dk4];
    const u32x4 g0 = *(const u32x4*)(pr4 + C_GA), g1 = *(const u32x4*)(pr4 + C_GA + 8);
    float wv[16];
#pragma unroll
    for (int r = 0; r < 16; ++r) wv[r] = wup[r * 256];
    const bf16_t qraw = pr4[C_GQ + h * 64 + dk4], kraw = pr4[C_GK + h * 64 + dk4];
    const float* go = F.a->in[IN_GGLAO] + l * 128; const float go0 = go[F.lane], go1 = go[64 + F.lane];
    const bf16_t z0 = pr4[C_GZ + h * 128 + F.lane], z1 = pr4[C_GZ + h * 128 + 64 + F.lane];
    QTICKET(F);
    LAS float* aL = (LAS float*)F.lds; LAS float* qL = aL + 256; LAS float* kL = qL + 256; LAS float* vL = kL + 256; LAS float* part = vL + 512; LAS float* oL = part + 512;
    {   const int t = F.tid >> 7, v = F.tid & 127; vL[t * 128 + v] = bf1(vraw); }
    if (F.tid < 256) { float gaf[16]; unpack8(g0, gaf); unpack8(g1, gaf + 8); float x = bias;
#pragma unroll
        for (int r = 0; r < 16; ++r) x += gaf[r] * wv[r];
        aL[t4 * 64 + dk4] = __expf(logsigf(x) * (1.f / 16.f)); qL[t4 * 64 + dk4] = bf1(qraw) * 0.125f; kL[t4 * 64 + dk4] = bf1(kraw); }
    __syncthreads();
    const int v = F.tid & 127, dg = F.tid >> 7;
    for (int t = 0; t < 4; ++t) { float po = 0.f; const float vv = vL[t * 128 + v];
#pragma unroll
        for (int i = 0; i < 16; ++i) { const int dk = 16 * dg + i; S[i] = aL[t * 64 + dk] * S[i] + kL[t * 64 + dk] * vv; po += qL[t * 64 + dk] * S[i]; }
        part[dg * 128 + v] = po;
        __syncthreads();
        if (dg == 0) oL[t * 128 + v] = (part[v] + part[128 + v]) + (part[256 + v] + part[384 + v]);
        __syncthreads(); }
    float* so = F.out + O_GLAS + ((size_t)((l * DB + b) * 4 + h) * 64 + 16 * dg) * 128 + v;
#pragma unroll
    for (int i = 0; i < 16; ++i) __builtin_nontemporal_store(S[i], so + i * 128);
    if (F.wave < 4) { const int t = F.wave; const float o0 = oL[t * 128 + F.lane], o1 = oL[t * 128 + 64 + F.lane];
        const float ss = wave_sum(o0 * o0 + o1 * o1); const float rs = rsqrtf(ss * (1.f / 128.f) + EPS);
        const size_t row = (size_t)(b * DS + t);
        mixs[row * DM + 512 + h * 128 + F.lane] = (bf16_t)f2bf(o0 * rs * go0 * siluf(bf1(z0)));
        mixs[row * DM + 512 + h * 128 + 64 + F.lane] = (bf16_t)f2bf(o1 * rs * go1 * siluf(bf1(z1))); }
}
__device__ __forceinline__ void sswa_unit(Ctx& F, int l, int un) {
    constexpr int PK = 144, VOFF = 160 * PK;
    const int b = un >> 1, kvh = un & 1, fr = F.lane & 15, fq = F.lane >> 4;
    const bf16_t* projs = (const bf16_t*)(F.ws + WS_PROJS); bf16_t* mixs = (bf16_t*)(F.ws + WS_MIXS);
    LAS unsigned char* Kl = F.lds; LAS unsigned char* Vl = F.lds + VOFF;
    QTICKET(F);
    __syncthreads();
    {   const float* gk = F.a->in[IN_GSWK] + l * 64;
        for (int p = F.tid; p < 1536; p += 512) { const int j = p >> 3, ch = p & 7;
            float k[8], v[8];
#pragma unroll
            for (int q = 0; q < 8; ++q) { k[q] = 0.f; v[q] = 0.f; }
            if (j < 128) { const float* ck = F.a->in[IN_CSWK] + ((size_t)((l * DB + b) * 128 + j) * 2 + kvh) * 64 + ch * 8; const float* cv = F.a->in[IN_CSWV] + ((size_t)((l * DB + b) * 128 + j) * 2 + kvh) * 64 + ch * 8;
                const f32x4 a0 = __builtin_nontemporal_load((const f32x4*)ck), a1 = __builtin_nontemporal_load((const f32x4*)ck + 1), b0 = __builtin_nontemporal_load((const f32x4*)cv), b1 = __builtin_nontemporal_load((const f32x4*)cv + 1);
                k[0] = a0.x; k[1] = a0.y; k[2] = a0.z; k[3] = a0.w; k[4] = a1.x; k[5] = a1.y; k[6] = a1.z; k[7] = a1.w;
                v[0] = b0.x; v[1] = b0.y; v[2] = b0.z; v[3] = b0.w; v[4] = b1.x; v[5] = b1.y; v[6] = b1.z; v[7] = b1.w; }
            else if (j < 132) { const bf16_t* pr = projs + (size_t)(b * DS + (j - 128)) * PN; unpack8(*(const u32x4*)(pr + C_SK + kvh * 64 + ch * 8), k); unpack8(*(const u32x4*)(pr + C_SV + kvh * 64 + ch * 8), v); }
            float ss = 0.f;
#pragma unroll
            for (int q = 0; q < 8; ++q) ss += k[q] * k[q];
            ss += __shfl_xor(ss, 1); ss += __shfl_xor(ss, 2); ss += __shfl_xor(ss, 4);
            if (j >= 128) { const float rs = rsqrtf(ss * (1.f / 64.f) + EPS);
#pragma unroll
                for (int q = 0; q < 8; ++q) k[q] = k[q] * rs * gk[ch * 8 + q]; }
            if (j < 160) { *(LAS u32x4*)(Kl + j * PK + ch * 16) = pack8(k); *(LAS u32x4*)(Vl + j * PK + ch * 16) = pack8(v); }
            if (j >= 4 && j < 132) { const size_t o = ((size_t)((l * DB + b) * 128 + (j - 4)) * 2 + kvh) * 64 + ch * 8;
                { f32x4 t0 = {k[0], k[1], k[2], k[3]}, t1 = {k[4], k[5], k[6], k[7]}, t2 = {v[0], v[1], v[2], v[3]}, t3 = {v[4], v[5], v[6], v[7]};
                  __builtin_nontemporal_store(t0, (f32x4*)(F.out + O_SWKS + o)); __builtin_nontemporal_store(t1, (f32x4*)(F.out + O_SWKS + o + 4)); __builtin_nontemporal_store(t2, (f32x4*)(F.out + O_SWVS + o)); __builtin_nontemporal_store(t3, (f32x4*)(F.out + O_SWVS + o + 4)); } }
        }
    }
    __syncthreads();
    if (F.wave != 0) return;
    const int t = fr & 3, h = kvh * 4 + (fr >> 2); const size_t row = (size_t)(b * DS + t); const bf16_t* pr = projs + row * PN;
    bf16x8 Qf[2];
    {   const float* gq = F.a->in[IN_GSWQ] + l * 64; float q[2][8]; float ss = 0.f;
#pragma unroll
        for (int ks = 0; ks < 2; ++ks) { unpack8(*(const u32x4*)(pr + C_SQ + h * 64 + ks * 32 + fq * 8), q[ks]);
#pragma unroll
            for (int j = 0; j < 8; ++j) ss += q[ks][j] * q[ks][j]; }
        ss += __shfl_xor(ss, 16); ss += __shfl_xor(ss, 32);
        const float rs = rsqrtf(ss * (1.f / 64.f) + EPS) * 0.125f;
#pragma unroll
        for (int ks = 0; ks < 2; ++ks) {
#pragma unroll
            for (int j = 0; j < 8; ++j) q[ks][j] = q[ks][j] * rs * gq[ks * 32 + fq * 8 + j];
            Qf[ks] = __builtin_bit_cast(bf16x8, pack8(q[ks])); }
    }
    f32x4 S[10];
#pragma unroll
    for (int kb = 0; kb < 10; ++kb) { f32x4 a = (f32x4){0.f, 0.f, 0.f, 0.f};
#pragma unroll
        for (int ks = 0; ks < 2; ++ks) { const bf16x8 kf = *(const LAS bf16x8*)(Kl + (16 * kb + fr) * PK + (ks * 32 + fq * 8) * 2); a = MFMA16(kf, Qf[ks], a); }
        S[kb] = a; }
    const float sink = F.a->in[IN_SINKS][l * 8 + h];
    float m = sink;
#pragma unroll
    for (int kb = 0; kb < 10; ++kb)
#pragma unroll
        for (int i = 0; i < 4; ++i) { const int kj = 16 * kb + 4 * fq + i; const bool valid = (kj >= t + 1) && (kj <= t + 128);
            if (!valid) S[kb][i] = -INFINITY; m = fmaxf(m, S[kb][i]); }
    m = fmaxf(m, __shfl_xor(m, 16)); m = fmaxf(m, __shfl_xor(m, 32));
    float sum = 0.f;
#pragma unroll
    for (int kb = 0; kb < 10; ++kb)
#pragma unroll
        for (int i = 0; i < 4; ++i) { const float ev = __expf(S[kb][i] - m); S[kb][i] = ev; sum += ev; }
    sum += __shfl_xor(sum, 16); sum += __shfl_xor(sum, 32);
    sum += __expf(sink - m);
    const float inv = __builtin_amdgcn_rcpf(sum);
    f32x4 o[4];
#pragma unroll
    for (int db = 0; db < 4; ++db) o[db] = (f32x4){0.f, 0.f, 0.f, 0.f};
#pragma unroll
    for (int p = 0; p < 5; ++p) { const bf16x8 Pb = pk8f(S[2 * p] * inv, S[2 * p + 1] * inv);
#pragma unroll
        for (int db = 0; db < 4; ++db) { const bf16x8 Va = cat8(tr4(Vl, PK, 32 * p + 4 * fq, 16 * db, fr), tr4(Vl, PK, 32 * p + 16 + 4 * fq, 16 * db, fr)); o[db] = MFMA16(Va, Pb, o[db]); } }
#pragma unroll
    for (int db = 0; db < 4; ++db) { const int d = 16 * db + 4 * fq; const u32x2 zr = *(const u32x2*)(pr + C_SZ + h * 64 + d);
        u32x2 w; w.x = pk2(o[db][0] * siluf(bflo(zr.x)), o[db][1] * siluf(bfhi(zr.x))); w.y = pk2(o[db][2] * siluf(bflo(zr.y)), o[db][3] * siluf(bfhi(zr.y)));
        *(u32x2*)(mixs + row * DM + 1024 + h * 64 + d) = w; }
}
__device__ __forceinline__ void sconv_unit(Ctx& F, int l, int b) {
    const bf16_t* projs = (const bf16_t*)(F.ws + WS_PROJS); bf16_t* mixs = (bf16_t*)(F.ws + WS_MIXS);
    QTICKET(F);
    const int ch = F.tid; const float* cw = F.a->in[IN_CONVW] + l * 3 * 512; const float w0 = cw[ch], w1 = cw[512 + ch], w2 = cw[1024 + ch];
    float um2 = F.a->in[IN_SCONV][((size_t)(l * DB + b) * 2 + 0) * 512 + ch], um1 = F.a->in[IN_SCONV][((size_t)(l * DB + b) * 2 + 1) * 512 + ch];
    float ac[4], ah[4], ab[4], az[4];
#pragma unroll
    for (int t = 0; t < 4; ++t) { const bf16_t* pr = projs + (size_t)(b * DS + t) * PN + 256 * (ch >> 6) + (ch & 63); ac[t] = bf1(pr[0]); ab[t] = bf1(pr[64]); ah[t] = bf1(pr[128]); az[t] = bf1(pr[192]); }
#pragma unroll
    for (int t = 0; t < 4; ++t) { const size_t row = (size_t)(b * DS + t);
        const float u = ac[t] * ah[t]; const float o = w0 * um2 + w1 * um1 + w2 * u;
        mixs[row * DM + ch] = (bf16_t)f2bf(ab[t] * o * siluf(az[t]));
        um2 = um1; um1 = u; }
    F.out[O_CONVS + ((size_t)(l * DB + b) * 2 + 0) * 512 + ch] = um2; F.out[O_CONVS + ((size_t)(l * DB + b) * 2 + 1) * 512 + ch] = um1;
}

#ifndef TPA
#define TPA -1
#endif
#ifndef TPB
#define TPB -1
#endif
constexpr int CW_TS = 120000;
constexpr int N_PHASES = 11;
__global__ void __launch_bounds__(NTHREADS, 2) hymba_fwd(const Args args) {
    extern __shared__ __attribute__((aligned(16))) unsigned char lds_raw[];
    Ctx F;
    const int wave_s = __builtin_amdgcn_readfirstlane((int)threadIdx.x >> 6);
#define LEADER (wave_s == 0 && lane_id() == 0)
    F.lds = (LAS unsigned char*)lds_raw; F.tid = wave_s * 64 + lane_id(); F.lane = F.tid & 63; F.wave = wave_s; F.G = gridDim.x; F.bid = blockIdx.x;
    F.a = &args;
    F.pend = nullptr;
    F.out = args.out; F.ws = args.ws; F.ctlf = (float*)(args.ws + WS_CTL);
    volatile LAS unsigned* MISC = (volatile LAS unsigned*)(F.lds + MISC_OFF);
    if (F.tid < 64) MISC[F.tid] = 0u;
    __syncthreads();
    XcdBarrier bar; bar.bar = (unsigned*)(args.ws + WS_CTL) + CW_BAR; bar.x = 0; bar.st = nullptr;
    if (MK_N_LAUNCHES == 1) bar = xcd_barrier_post((unsigned*)(args.ws + WS_CTL) + CW_BAR, MISC + 8, LEADER);
    const int lo = args.ph_lo, hi = args.ph_hi;
#define IN(k) (lo <= (k) && (k) < hi)
#define STAMP(k) do { if (TPA >= 0 && F.bid == 0 && LEADER) ((unsigned long long*)(F.ctlf + CW_TS))[k] = __builtin_amdgcn_s_memrealtime(); } while (0)
#define SEAM(k) do { if (IN(k) && IN((k) + 1)) { xcd_barrier(bar, LEADER); STAMP((k) + 1); } } while (0)
#define PHASE_ENTER() do { int t_ = wave_s * 64 + lane_id(); asm volatile("" : "+v"(t_)); F.tid = t_; F.lane = t_ & 63; F.wave = __builtin_amdgcn_readfirstlane(t_ >> 6); } while (0)
#define QUEUE_BEGIN(ph, NIT) { const int qg_ = F.bid & 7; F.qctr = (unsigned*)(args.ws + WS_CTL) + CW_Q + ((ph) * 8 + qg_) * 64; int it = qg_ + 8 * (F.bid >> 3); \
        while (it < (NIT)) { F.tk = 0u; PHASE_ENTER();
#define QUEUE_END() __syncthreads(); if (F.tid == 0) MISC[16] = (unsigned)(F.bid & 7) + 8u * ((unsigned)(F.G >> 3) + F.tk); __syncthreads(); it = __builtin_amdgcn_readfirstlane((int)MISC[16]); } }

    STAMP(0);
    if (IN(0)) { PHASE_ENTER(); p0_prologue(F); }
    SEAM(0);
    for (int l = 0; l < 2; ++l) {
        const int pb = 1 + 5 * l;
        float* ssP = F.ctlf + CW_SSP + l * NP; float* ssS = F.ctlf + CW_SSS + l * NS;
        bf16_t* WinT = (bf16_t*)(F.ws + WS_WIN + l * WIN_L); bf16_t* WoutT = (bf16_t*)(F.ws + WS_WOUT + l * WOUT_L);
        if (IN(pb)) {
            pg8::Gemm g{(const bf16_t*)(F.ws + WS_XB), WinT, NP, PN, DM}; pg8::StaticOrder S; S.init(NP, PN, F.G, F.bid);
            pg8::EpiProj E{(bf16_t*)(F.ws + WS_PROJ), PN, ssP, F.out + O_CONVP + (size_t)l * 2 * 2 * 512};
            pg8::gemm_phase<pg8::EpiProj, pg8::StaticOrder, true, true>(F.lds, g, S, E, wave_s);
        }
        unsigned bgen = 0u; bool bwait = false;
        if (IN(pb) && IN(pb + 1)) { bgen = xcd_barrier_arrive(bar, LEADER); bwait = true; }
        if (IN(pb + 1)) {
            unsigned* dep = (unsigned*)(args.ws + WS_CTL) + CW_DEP + l * 256;
            const int a1 = 96, a2 = a1 + 128, a3 = a2 + 128, a4 = a3 + 256, a5 = a4, a6 = a5 + (l == 0 ? 171 : 0);
            const int c1 = a6 + (l == 0 ? 128 : 0), c2 = c1 + 128, c3 = c2 + 128, c4 = c3 + 64, c5 = c4 + 32, c6 = c5 + 128, c7 = c6, NIT = c7 + (l == 0 ? 171 : 0);
            bool depS = false, depG = false;
            QUEUE_BEGIN(pb + 1, NIT)
                unsigned* done_ = nullptr;
                if (bwait && !(it < (l == 0 ? a2 : a1))) { xcd_barrier_wait(bar, LEADER, bgen); STAMP(pb + 1); bwait = false; }
                if (it >= a6 && it < c5 && !depS) {
                    QPUBLISH(F);
                    if (F.tid == 0) {
                        XB_SPIN(xb_ld(dep) < 96u || (l == 0 && xb_ld(dep + 128) < 128u), bar.bar);
                        __builtin_amdgcn_fence(__ATOMIC_ACQUIRE, "agent");
                        asm volatile("s_waitcnt vmcnt(0)" ::: "memory");
                    }
                    __syncthreads();
                    depS = true;
                }
                if (it >= c5 && it < c6 && !depG) {
                    QPUBLISH(F);
                    if (F.tid == 0) {
                        XB_SPIN(xb_ld(dep + 64) < 256u, bar.bar);
                        __builtin_amdgcn_fence(__ATOMIC_ACQUIRE, "agent");
                        asm volatile("s_waitcnt vmcnt(0)" ::: "memory");
                    }
                    __syncthreads();
                    depG = true;
                }
                if (it < a1) { SgEpiBf16 E{(bf16_t*)(F.ws + WS_PROJS) + it * 64, PN, ssS}; sg_unit(F, (const bf16_t*)(F.ws + WS_XS), WinT + (size_t)it * 64 * DM, E); done_ = dep; }
                else if (it < a2) {
                    if (l == 0) { const int q = it - a1, rb = q >> 5, cb = q & 31;
                        SgEpiF32 E{(float*)(F.ws + WS_MEMKV) + (size_t)rb * 128 * 2048 + cb * 64, 2048, F.ctlf + CW_SSM + rb * 128};
                        sg_unit(F, (const bf16_t*)(F.ws + WS_MEMA) + (size_t)rb * 128 * DM, (const bf16_t*)(F.ws + WS_WMEM) + (size_t)cb * 64 * DM, E); done_ = dep + 128; }
                    else memp_unit<false>(F, l, it - a1); }
                else if (it < a3) swa_unit(F, l, it - a2);
                else if (it < a4) { glaA2_unit(F, l, it - a3); done_ = dep + 64; }
                else if (it < a6) cvt1_item(F, it - a5);
                else if (it < c1) memfin_item(F, it - a6);
                else if (it < c2) mem_unit<true>(F, l, it - c1);
                else if (it < c3) sgla_unit(F, l, it - c2);
                else if (it < c4) sswa_unit(F, l, it - c3);
                else if (it < c5) sconv_unit(F, l, it - c4);
                else if (it < c6) gla_scan_item(F, l, it - c5);
                else cvt1_item(F, 171 + it - c7);
                F.pend = done_;
            QUEUE_END()
            QPUBLISH(F);
        }
        if (bwait) { xcd_barrier_wait(bar, LEADER, bgen); bwait = false; }
        if (IN(pb + 1) && IN(pb + 3)) {
            const unsigned g2 = xcd_barrier_arrive(bar, LEADER);
            unsigned* rdyc = (unsigned*)(args.ws + WS_CTL) + CW_RDY + l * 512;
            for (int cu = F.bid; cu < 256; cu += F.G) { PHASE_ENTER(); conv_unit(F, l, cu); F.pend = rdyc + (cu >> 3) * 16; __syncthreads(); }
            QPUBLISH(F);
            xcd_barrier_wait(bar, LEADER, g2); STAMP(pb + 3);
        }
        unsigned* rdy = (unsigned*)(args.ws + WS_CTL) + CW_RDY + l * 512;
        if (IN(pb + 3)) {
            const int n1 = 32, n2 = n1 + (l == 0 ? 128 : 0), n3 = n2 + 512, NIT = n3 + (l == 0 ? 170 : 0);
            QUEUE_BEGIN(pb + 3, NIT)
                unsigned* done_ = nullptr;
                if (it < n1) { SgEpiOut E{(l == 0 ? F.a->in[IN_XS] : F.out + O_YS) + it * 64, F.out + O_YS + it * 64, l == 0 ? (bf16_t*)(F.ws + WS_XS) + it * 64 : nullptr, F.ctlf + CW_SSS + NS};
                    sg_unit(F, (const bf16_t*)(F.ws + WS_MIXS), WoutT + (size_t)it * 64 * DM, E); }
                else if (it < n2) { const int q = it - n1, h = q & 3, qb = (q >> 2) & 15, b = q >> 6; memp_unit<true>(F, l, b * 64 + h * 16 + qb); done_ = rdy + (b * 16 + qb) * 16; }
                else if (it < n3) { const int q = it - n2, h = q & 3, c = (q >> 2) & 63, b = q >> 8; glaC_unit(F, l, (b * 4 + h) * 64 + c); done_ = rdy + (b * 16 + (c >> 2)) * 16; }
                else cvt1_item(F, 342 + it - n3);
                F.pend = done_;
            QUEUE_END()
            QPUBLISH(F);
        }
        if (IN(pb + 4)) {
            pg8::Gemm g{(const bf16_t*)(F.ws + WS_MIX), WoutT, NP, DM, DM}; DepOrder S; S.init(NP, DM, F.G, F.bid); S.cnt = rdy; S.target = (l == 0 ? 28u : 24u);
            if (l == 0) { pg8::EpiOut<false> E{nullptr, nullptr, (bf16_t*)(F.ws + WS_XB), F.ctlf + CW_SSP + NP}; pg8::gemm_phase<pg8::EpiOut<false>, DepOrder, false, true>(F.lds, g, S, E, wave_s); }
            else { pg8::EpiOut<true> E{nullptr, F.out + O_YP, (bf16_t*)(F.ws + WS_XB), nullptr}; pg8::gemm_phase<pg8::EpiOut<true>, DepOrder, false, true>(F.lds, g, S, E, wave_s); }
        }
        if (l == 0) SEAM(pb + 4);
    }
    if (TPA >= 0) {
        xcd_barrier(bar, LEADER); STAMP(11);
        if (F.bid == 0) { __syncthreads();
            const unsigned long long* ts = (const unsigned long long*)(F.ctlf + CW_TS);
            const float T1 = (float)(ts[TPA + 1] - ts[TPA]) * 0.01f, T2 = (float)(ts[TPB + 1] - ts[TPB]) * 0.01f;
            float* cp = F.out + O_CONVP; const float sc = 1.f + T1 * 0.001f;
            for (int i = wave_s * 64 + lane_id(); i < 4096; i += NTHREADS) cp[i] *= sc;
            if (LEADER) F.out[O_YP] += T2 * 0.25f; }
    }
#undef IN
#undef SEAM
}

extern "C" void kernel_launch(void* const* d_in, const int* in_sizes, int n_in, void* d_out, int out_size, void* d_ws, size_t ws_size, hipStream_t stream) {
    static int grid = 0;
    if (grid == 0) {
        if (n_in != 23 || out_size != (int)O_END || ws_size < WS_END) { fprintf(stderr, "kernel_launch: unexpected shapes (n_in %d out %d ws %zu)\n", n_in, out_size, ws_size); grid = -1; return; }
        int dev = 0, cus = 0, per_cu = 0;
        if (hipGetDevice(&dev) != hipSuccess || hipDeviceGetAttribute(&cus, hipDeviceAttributeMultiprocessorCount, dev) != hipSuccess) { grid = -1; return; }
        if (hipFuncSetAttribute((const void*)hymba_fwd, hipFuncAttributeMaxDynamicSharedMemorySize, LDS_BYTES) != hipSuccess) { fprintf(stderr, "kernel_launch: hipFuncSetAttribute failed\n"); grid = -1; return; }
        if (hipOccupancyMaxActiveBlocksPerMultiprocessor(&per_cu, (const void*)hymba_fwd, NTHREADS, LDS_BYTES) != hipSuccess || per_cu < 1) { fprintf(stderr, "kernel_launch: occupancy query reports %d\n", per_cu); }
        (void)hipGetLastError();
        grid = cus - (cus % 8);
    }
    if (grid < 0) return;
    (void)hipMemsetAsync((char*)d_ws + WS_CTL, 0, CTL_ZERO_BYTES, stream);
    Args a{};
    for (int i = 0; i < 23; ++i) a.in[i] = (const float*)d_in[i];
    a.out = (float*)d_out; a.ws = (unsigned char*)d_ws;
    if (MK_N_LAUNCHES == 1) { a.ph_lo = 0; a.ph_hi = N_PHASES; hipLaunchKernelGGL(hymba_fwd, dim3(grid), dim3(NTHREADS), LDS_BYTES, stream, a); }
    else { for (int p = 0; p < N_PHASES; ++p) { a.ph_lo = p; a.ph_hi = p + 1; hipLaunchKernelGGL(hymba_fwd, dim3(grid), dim3(NTHREADS), LDS_BYTES, stream, a); } }
}
```

```cpp
#include <hip/hip_runtime.h>
#include <cstdio>
#include <cstdint>

#ifndef MK_N_LAUNCHES
#define MK_N_LAUNCHES 1
#endif

#define GAS __attribute__((address_space(1)))
#define LAS __attribute__((address_space(3)))
typedef unsigned short bf16_t;
typedef short bf16x8 __attribute__((ext_vector_type(8)));
typedef short s16x4 __attribute__((ext_vector_type(4)));
typedef short v4i16_t __attribute__((ext_vector_type(4)));
typedef float f32x4 __attribute__((ext_vector_type(4)));
typedef unsigned u32x4 __attribute__((ext_vector_type(4)));
typedef unsigned u32x2 __attribute__((ext_vector_type(2)));

constexpr int DM = 2048, SEQ = 4096, NP = 8192, NS = 128, DB = 32, DS = 4, DIN = 5904, PN = 6144, NMEMROWS = 512;
constexpr int C_AB = 0, C_AC = 512, C_AH = 1024, C_AZ = 1536, C_GQ = 2048, C_GK = 2304, C_GV = 2560, C_GA = 3072, C_GZ = 3088,
              C_SQ = 3600, C_SK = 4112, C_SV = 4240, C_SZ = 4368, C_MQ = 4880, C_MZ = 5392;
constexpr float EPS = 1e-6f;
constexpr size_t O_YP = 0, O_YS = 16777216, O_CONVP = 17039360, O_GLAP = 17043456, O_SWKP = 17174528, O_SWVP = 17240064, O_MKP = 17305600,
                 O_MVP = 17829888, O_CONVS = 18354176, O_GLAS = 18419712, O_SWKS = 20516864, O_SWVS = 21565440, O_END = 22614016;
constexpr size_t MiB = 1u << 20;
constexpr size_t WS_CTL = 0, CTL_ZERO_BYTES = 32768;
constexpr size_t WS_WIN = 2 * MiB, WIN_L = (size_t)PN * DM * 2;
constexpr size_t WS_WOUT = 50 * MiB, WOUT_L = (size_t)DM * DM * 2;
constexpr size_t WS_WMEM = 66 * MiB;
constexpr size_t WS_XB = 74 * MiB;
constexpr size_t WS_PROJ = 106 * MiB;
constexpr size_t WS_MIX = 202 * MiB;
constexpr size_t WS_GLAKV = 234 * MiB;
constexpr size_t WS_GLAST = 250 * MiB;
constexpr size_t WS_GLADEC = 258 * MiB;
constexpr size_t WS_MEMKV = 259 * MiB;
constexpr size_t WS_MEMA = 263 * MiB;
constexpr size_t WS_XS = 265 * MiB;
constexpr size_t WS_PROJS = 266 * MiB;
constexpr size_t WS_MIXS = 268 * MiB;
constexpr size_t WS_MEMKB = 270 * MiB;
constexpr size_t WS_MEMVB = 271 * MiB;
constexpr size_t WS_GLACUM = 272 * MiB;
constexpr size_t WS_END = 280 * MiB;
constexpr int CW_KN2 = 16384;
constexpr int CW_Q = 8192;
constexpr int CW_DEP = CW_Q + 6144;
constexpr int CW_RDY = CW_DEP + 512;
constexpr int CW_BAR = 4096;
constexpr int CW_SSP = 65536;
constexpr int CW_SSS = CW_SSP + 2 * 8192;
constexpr int CW_SSM = CW_SSS + 2 * 128;
static_assert(CW_BAR + 3456 <= 8192, "ctl");

constexpr int NWAVES = 8, NTHREADS = 512;
constexpr int LDS_BYTES = 151552, MISC_OFF = 147456;

__device__ __forceinline__ float bflo(unsigned u) { return __uint_as_float(u << 16); }
__device__ __forceinline__ float bfhi(unsigned u) { return __uint_as_float(u & 0xffff0000u); }
__device__ __forceinline__ float bf1(bf16_t h) { return __uint_as_float((unsigned)h << 16); }
__device__ __forceinline__ unsigned f2bf(float f) { unsigned u = __float_as_uint(f); return (u + 0x7fffu + ((u >> 16) & 1u)) >> 16; }
typedef float f32x2_t __attribute__((ext_vector_type(2))); typedef __bf16 bf16x2_t __attribute__((ext_vector_type(2)));
__device__ __forceinline__ unsigned pk2(float lo, float hi) { f32x2_t v = {lo, hi}; bf16x2_t b = __builtin_convertvector(v, bf16x2_t); return __builtin_bit_cast(unsigned, b); }
__device__ __forceinline__ void unpack8(const u32x4 r, float* f) { f[0] = bflo(r.x); f[1] = bfhi(r.x); f[2] = bflo(r.y); f[3] = bfhi(r.y); f[4] = bflo(r.z); f[5] = bfhi(r.z); f[6] = bflo(r.w); f[7] = bfhi(r.w); }
__device__ __forceinline__ u32x4 pack8(const float* f) { u32x4 r; r.x = pk2(f[0], f[1]); r.y = pk2(f[2], f[3]); r.z = pk2(f[4], f[5]); r.w = pk2(f[6], f[7]); return r; }
__device__ __forceinline__ float siluf(float x) { return x * __builtin_amdgcn_rcpf(1.f + __expf(-x)); }
__device__ __forceinline__ float logsigf(float x) { return fminf(x, 0.f) - __logf(1.f + __expf(-fabsf(x))); }
__device__ __forceinline__ float wave_sum(float v) {
#pragma unroll
    for (int o = 1; o < 64; o <<= 1) v += __shfl_xor(v, o);
    return v;
}
#define LDS_WAIT() asm volatile("s_waitcnt lgkmcnt(0)" ::: "memory")
__device__ __forceinline__ int lane_id() { int l; asm volatile("v_mbcnt_lo_u32_b32 %0, -1, 0\n\tv_mbcnt_hi_u32_b32 %0, -1, %0" : "=v"(l)); return l; }
__device__ __forceinline__ s16x4 tr4(const LAS unsigned char* base, int pitchB, int r0, int c0, int li) {
    const LAS unsigned char* p = base + (r0 + (li >> 2)) * pitchB + (c0 + 4 * (li & 3)) * 2;
    return __builtin_bit_cast(s16x4, __builtin_amdgcn_ds_read_tr16_b64_v4i16((LAS v4i16_t*)p));
}
__device__ __forceinline__ bf16x8 cat8(s16x4 a, s16x4 b) { return (bf16x8){a[0], a[1], a[2], a[3], b[0], b[1], b[2], b[3]}; }
__device__ __forceinline__ bf16x8 pk8f(f32x4 a, f32x4 b) { u32x4 r; r.x = pk2(a[0], a[1]); r.y = pk2(a[2], a[3]); r.z = pk2(b[0], b[1]); r.w = pk2(b[2], b[3]); return __builtin_bit_cast(bf16x8, r); }
#define MFMA16(a, b, c) __builtin_amdgcn_mfma_f32_16x16x32_bf16((a), (b), (c), 0, 0, 0)

namespace pg8 {
#define PG8_LAS __attribute__((address_space(3)))
constexpr int BM = 256, BK = 64, HALF = 128, HTB = HALF * BK * 2, STAGE_BYTES = 8 * HTB, NXCD = 8, WGM = 4;
__host__ __device__ __forceinline__ int lds_byte(int r, int c) { const int st = (r >> 4) * 2 + (c >> 5), rr = r & 15, cc = c & 31, ob = rr * 64 + cc * 2; return st * 1024 + (ob ^ (((ob >> 9) & 1) << 5)); }
__host__ __device__ __forceinline__ void stage_rc(int b, int& R, int& C) { const int st = b / 1024, sb = b % 1024, swz = sb ^ (((sb >> 9) & 1) << 5); R = (st >> 1) * 16 + swz / 64; C = (st & 1) * 32 + (swz % 64) / 2; }
__host__ __device__ __forceinline__ int perm32(int rho) { const int n = rho >> 4, i = rho & 15; return 8 * (i >> 2) + 4 * n + (i & 3); }
struct Unit { int pm, pn; };
struct Gemm { const bf16_t* A; const bf16_t* Bt; int M, N, K; };
struct StaticOrder {
    int nM, nN, nwg, G, c;
    __host__ __device__ void init(int M, int N, int G_, int c_) { nM = M / BM; nN = N / BM; nwg = nM * nN; G = G_; c = c_; }
    __host__ __device__ bool next(int i, Unit& u) const {
        const long L = (long)i * G + c; if (L >= nwg) return false;
        int wgid = (int)L; { const int q = nwg / NXCD, r = nwg % NXCD, xcd = wgid % NXCD, off = wgid / NXCD; wgid = (xcd < r ? xcd * (q + 1) : r * (q + 1) + (xcd - r) * q) + off; }
        const int nig = WGM * nN, gid = wgid / nig, fm = gid * WGM, gsz = (nM - fm) < WGM ? (nM - fm) : WGM;
        u.pm = fm + ((wgid % nig) % gsz); u.pn = (wgid % nig) / gsz; return true;
    }
    __device__ __forceinline__ void a_ready(const Unit&) const {}
    __device__ __forceinline__ void done(const Unit&) const {}
};
__device__ __forceinline__ unsigned cvt_pk_bf16(float lo, float hi) { unsigned r; asm volatile("v_cvt_pk_bf16_f32 %0, %1, %2" : "=v"(r) : "v"(lo), "v"(hi)); return r; }

struct EpiProj {
    static constexpr bool PERM = true, AFTER_DRAIN = false;
    bf16_t* O; int ldc; const float* ss; float* convp;
    __device__ __forceinline__ void operator()(const f32x4 (&acc)[2][2][4][2], const Unit& u, int wr, int wc, int fr, int fq) const {
        const int row0 = u.pm * BM + wr * 64 + fr, col0 = u.pn * BM + wc * 32 + 8 * fq;
        float sv[2][4];
#pragma unroll
        for (int ai = 0; ai < 2; ++ai)
#pragma unroll
            for (int m = 0; m < 4; ++m) sv[ai][m] = ss[row0 + ai * HALF + m * 16];
        if (u.pn < 8) {
            const int ch0 = 64 * u.pn + 32 * (wc & 1) + 8 * fq;
#pragma unroll
            for (int ai = 0; ai < 2; ++ai)
#pragma unroll
                for (int m = 0; m < 4; ++m) { const int row = row0 + ai * HALF + m * 16; const float sc = rsqrtf(sv[ai][m] * (1.0f / DM) + EPS);
                    const f32x4 a0 = acc[ai][0][m][0] * sc, a1 = acc[ai][0][m][1] * sc, b0 = acc[ai][1][m][0] * sc, b1 = acc[ai][1][m][1] * sc;
                    f32x4 r0, r1;
                    if (wc < 2) { r0 = a0 * b0; r1 = a1 * b1; }
                    else {
#pragma unroll
                        for (int j = 0; j < 4; ++j) { r0[j] = a0[j] * (b0[j] * __builtin_amdgcn_rcpf(1.f + __expf(-b0[j]))); r1[j] = a1[j] * (b1[j] * __builtin_amdgcn_rcpf(1.f + __expf(-b1[j]))); } }
                    u32x4 w; w.x = cvt_pk_bf16(r0[0], r0[1]); w.y = cvt_pk_bf16(r0[2], r0[3]); w.z = cvt_pk_bf16(r1[0], r1[1]); w.w = cvt_pk_bf16(r1[2], r1[3]);
                    *(u32x4*)(O + (size_t)row * ldc + (wc < 2 ? C_AC : C_AB) + ch0) = w;
                    const int t = row & (SEQ - 1);
                    if (wc < 2 && t >= SEQ - 2) { float* cp = convp + ((size_t)(row >> 12) * 2 + (t - (SEQ - 2))) * 512 + ch0; *(f32x4*)cp = r0; *(f32x4*)(cp + 4) = r1; } }
            return; }
#pragma unroll
        for (int ai = 0; ai < 2; ++ai)
#pragma unroll
            for (int m = 0; m < 4; ++m) { const int row = row0 + ai * HALF + m * 16; const float sc = rsqrtf(sv[ai][m] * (1.0f / DM) + EPS);
                bf16_t* rowp = O + (size_t)row * ldc + col0;
#pragma unroll
                for (int bj = 0; bj < 2; ++bj) { const f32x4 v0 = acc[ai][bj][m][0] * sc, v1 = acc[ai][bj][m][1] * sc;
                    u32x4 w; w.x = cvt_pk_bf16(v0[0], v0[1]); w.y = cvt_pk_bf16(v0[2], v0[3]); w.z = cvt_pk_bf16(v1[0], v1[1]); w.w = cvt_pk_bf16(v1[2], v1[3]);
                    *(u32x4*)(rowp + bj * HALF) = w; } }
    }
};
template <bool LAST> struct EpiOut {
    static constexpr bool PERM = true, AFTER_DRAIN = false;
    const float* base; float* out; bf16_t* xb; float* ssn;
    __device__ __forceinline__ void operator()(const f32x4 (&acc)[2][2][4][2], const Unit& u, int wr, int wc, int fr, int fq) const {
        const int row0 = u.pm * BM + wr * 64 + fr, col0 = u.pn * BM + wc * 32 + 8 * fq;
        u32x4 bw[2][4][2];
#pragma unroll
        for (int ai = 0; ai < 2; ++ai)
#pragma unroll
            for (int m = 0; m < 4; ++m)
#pragma unroll
                for (int bj = 0; bj < 2; ++bj) bw[ai][m][bj] = *(const u32x4*)(xb + (size_t)(row0 + ai * HALF + m * 16) * DM + col0 + bj * HALF);
#pragma unroll
        for (int ai = 0; ai < 2; ++ai)
#pragma unroll
            for (int m = 0; m < 4; ++m) { const int row = row0 + ai * HALF + m * 16; const size_t off = (size_t)row * DM + col0; float s = 0.f;
#pragma unroll
                for (int bj = 0; bj < 2; ++bj) { const size_t o2 = off + bj * HALF; const u32x4 b4 = bw[ai][m][bj];
                    f32x4 y0 = acc[ai][bj][m][0], y1 = acc[ai][bj][m][1];
                    y0[0] += bflo(b4.x); y0[1] += bfhi(b4.x); y0[2] += bflo(b4.y); y0[3] += bfhi(b4.y); y1[0] += bflo(b4.z); y1[1] += bfhi(b4.z); y1[2] += bflo(b4.w); y1[3] += bfhi(b4.w);
                    if (!LAST) { u32x4 w; w.x = cvt_pk_bf16(y0[0], y0[1]); w.y = cvt_pk_bf16(y0[2], y0[3]); w.z = cvt_pk_bf16(y1[0], y1[1]); w.w = cvt_pk_bf16(y1[2], y1[3]); *(u32x4*)(xb + o2) = w;
                        s += (y0[0] * y0[0] + y0[1] * y0[1]) + (y0[2] * y0[2] + y0[3] * y0[3]) + (y1[0] * y1[0] + y1[1] * y1[1]) + (y1[2] * y1[2] + y1[3] * y1[3]); }
                    else { *(f32x4*)(out + o2) = y0; *(f32x4*)(out + o2 + 4) = y1; } }
                if (!LAST) { s += __shfl_xor(s, 16); s += __shfl_xor(s, 32); if (fq == 0) atomicAdd(ssn + row, s); } }
    }
};

template <class Epi, class Sched, bool ALIGN_EPI = false, bool SP2 = false>
__device__ __forceinline__ void gemm_phase(PG8_LAS unsigned char* lds, const Gemm g, const Sched& S, const Epi& E, int wave_s) {
    int tid_ = wave_s * 64 + lane_id(); asm volatile("" : "+v"(tid_));
    const int tid = tid_, wid = __builtin_amdgcn_readfirstlane(tid >> 6), lane = tid & 63, wr = wid >> 2, wc = wid & 3, fr = lane & 15, fq = lane >> 4;
    const int K = g.K, nt = K / BK;
    unsigned voffA[2], voffB[2];
#pragma unroll
    for (int i = 0; i < 2; ++i) { int R, C; stage_rc(tid * 16 + i * 8192, R, C); const int Rb = Epi::PERM ? ((R & ~31) + perm32(R & 31)) : R;
        voffA[i] = (unsigned)(R * K + C) * 2u; voffB[i] = (unsigned)(Rb * K + C) * 2u; }
    const size_t kstep = (size_t)(BK * 2);
    const size_t hstep = (size_t)HALF * K * 2;
    const size_t tstep = 2 * hstep;
    const unsigned ldsw = (unsigned)wid * 1024u;
    const int aoff = lds_byte(wr * 64 + fr, fq * 8), boff = lds_byte(wc * 32 + fr, fq * 8);
#define PG8_SA(b, h) (((b) * 2 + (h)) * HTB)
#define PG8_SB(b, h) ((4 + (b) * 2 + (h)) * HTB)
#define PG8_STAGE(bufoff, gbase, voff) do { _Pragma("unroll") for (int _i = 0; _i < 2; ++_i) { unsigned _vo = (voff)[_i]; asm volatile("" : "+v"(_vo)); \
        __builtin_amdgcn_global_load_lds((const unsigned*)((const char*)(gbase) + _vo), (PG8_LAS unsigned*)(lds + (bufoff) + ldsw + _i * 8192), 16, 0, 0); } } while (0)
#define PG8_LDA(dst, b, h) do { _Pragma("unroll") for (int m = 0; m < 4; ++m) _Pragma("unroll") for (int k = 0; k < 2; ++k) dst[m][k] = *(const PG8_LAS bf16x8*)(lds + PG8_SA(b, h) + aoff + m * 2048 + k * 1024); } while (0)
#define PG8_LDB(dst, b, h) do { _Pragma("unroll") for (int n = 0; n < 2; ++n) _Pragma("unroll") for (int k = 0; k < 2; ++k) dst[n][k] = *(const PG8_LAS bf16x8*)(lds + PG8_SB(b, h) + boff + n * 2048 + k * 1024); } while (0)
#define PG8_MMA(ai, bj, At, Bt) do { __builtin_amdgcn_s_setprio(1); _Pragma("unroll") for (int m = 0; m < 4; ++m) _Pragma("unroll") for (int n = 0; n < 2; ++n) _Pragma("unroll") for (int k = 0; k < 2; ++k) \
        acc[ai][bj][m][n] = __builtin_amdgcn_mfma_f32_16x16x32_bf16(Bt[n][k], At[m][k], acc[ai][bj][m][n], 0, 0, 0); __builtin_amdgcn_s_setprio(0); } while (0)
#define PG8_WAIT_V(n) asm volatile("s_waitcnt vmcnt(" #n ")" ::: "memory")
#define PG8_WAIT_L(n) asm volatile("s_waitcnt lgkmcnt(" #n ")" ::: "memory")
#define PG8_BAR __builtin_amdgcn_s_barrier()
#define PG8_SCHED __builtin_amdgcn_sched_barrier(0)
    Unit cur, nxt; int ui = 0;
    if (!S.next(0, cur)) return;
    f32x4 acc[2][2][4][2];
#pragma unroll
    for (int a = 0; a < 2; ++a)
#pragma unroll
        for (int b = 0; b < 2; ++b)
#pragma unroll
            for (int m = 0; m < 4; ++m)
#pragma unroll
                for (int n = 0; n < 2; ++n) acc[a][b][m][n] = (f32x4){0.f, 0.f, 0.f, 0.f};
    bf16x8 At[4][2], B0[2][2], B1[2][2];
    const char* cA = (const char*)g.A + (size_t)cur.pm * tstep; const char* cB = (const char*)g.Bt + (size_t)cur.pn * tstep;
    S.a_ready(cur);
    if constexpr (SP2) {
        PG8_STAGE(PG8_SB(0, 0), cB, voffB); PG8_STAGE(PG8_SB(0, 1), cB + hstep, voffB); PG8_STAGE(PG8_SA(0, 0), cA, voffA); PG8_STAGE(PG8_SA(0, 1), cA + hstep, voffA);
        if (wr == 1) PG8_BAR;
        PG8_WAIT_V(2); PG8_BAR;
        PG8_STAGE(PG8_SB(1, 0), cB + kstep, voffB); PG8_STAGE(PG8_SA(1, 0), cA + kstep, voffA); PG8_STAGE(PG8_SB(1, 1), cB + hstep + kstep, voffB);
        PG8_WAIT_V(6); PG8_BAR;
    } else {
        PG8_STAGE(PG8_SB(0, 0), cB, voffB); PG8_STAGE(PG8_SA(0, 0), cA, voffA); PG8_STAGE(PG8_SB(0, 1), cB + hstep, voffB); PG8_STAGE(PG8_SA(0, 1), cA + hstep, voffA);
        if (wr == 1) PG8_BAR;
        PG8_WAIT_V(4); PG8_BAR;
        PG8_STAGE(PG8_SB(1, 0), cB + kstep, voffB); PG8_STAGE(PG8_SA(1, 0), cA + kstep, voffA); PG8_STAGE(PG8_SB(1, 1), cB + hstep + kstep, voffB);
        PG8_WAIT_V(6); PG8_BAR;
    }
    for (;;) {
        const bool has_next = S.next(ui + 1, nxt);
        const char* nA = has_next ? (const char*)g.A + (size_t)nxt.pm * tstep : cA; const char* nB = has_next ? (const char*)g.Bt + (size_t)nxt.pn * tstep : cB;
        for (int t = 0; t < nt; t += 2) {
            const bool last = (t == nt - 2);
            const char* a1 = cA + (size_t)(t + 1) * kstep;
            const char* a2 = last ? nA : cA + (size_t)(t + 2) * kstep; const char* b2 = last ? nB : cB + (size_t)(t + 2) * kstep;
            const char* a3 = a2 + kstep; const char* b3 = b2 + kstep;
            if (last && has_next) S.a_ready(nxt);
            if constexpr (SP2) {
            PG8_LDB(B0, 0, 0); PG8_LDB(B1, 0, 1); PG8_SCHED; PG8_LDA(At, 0, 0); PG8_STAGE(PG8_SA(1, 1), a1 + hstep, voffA);
            PG8_WAIT_V(8); PG8_WAIT_L(0); PG8_BAR; PG8_MMA(0, 0, At, B0); PG8_MMA(0, 1, At, B1); PG8_BAR; PG8_SCHED;
            PG8_LDA(At, 0, 1); PG8_STAGE(PG8_SB(0, 0), b2, voffB); PG8_STAGE(PG8_SB(0, 1), b2 + hstep, voffB); PG8_STAGE(PG8_SA(0, 0), a2, voffA);
            PG8_WAIT_V(8); PG8_WAIT_L(0); PG8_BAR; PG8_MMA(1, 0, At, B0); PG8_MMA(1, 1, At, B1); PG8_BAR; PG8_SCHED;
            PG8_LDB(B0, 1, 0); PG8_LDB(B1, 1, 1); PG8_SCHED; PG8_LDA(At, 1, 0); PG8_STAGE(PG8_SA(0, 1), a2 + hstep, voffA);
            PG8_WAIT_V(8); PG8_WAIT_L(0); PG8_BAR; PG8_MMA(0, 0, At, B0); PG8_MMA(0, 1, At, B1); PG8_BAR; PG8_SCHED;
            PG8_LDA(At, 1, 1); PG8_STAGE(PG8_SB(1, 0), b3, voffB); PG8_STAGE(PG8_SB(1, 1), b3 + hstep, voffB); PG8_STAGE(PG8_SA(1, 0), a3, voffA);
            PG8_WAIT_V(8); PG8_WAIT_L(0); PG8_BAR; PG8_MMA(1, 0, At, B0); PG8_MMA(1, 1, At, B1); PG8_BAR; PG8_SCHED;
            } else {
            PG8_LDB(B0, 0, 0); PG8_SCHED; PG8_LDA(At, 0, 0); PG8_STAGE(PG8_SA(1, 1), a1 + hstep, voffA);
            PG8_WAIT_L(8); PG8_BAR; PG8_WAIT_L(0); PG8_MMA(0, 0, At, B0); PG8_BAR; PG8_SCHED;
            PG8_LDB(B1, 0, 1); PG8_STAGE(PG8_SB(0, 0), b2, voffB);
            PG8_BAR; PG8_WAIT_L(0); PG8_MMA(0, 1, At, B1); PG8_BAR;
            PG8_LDA(At, 0, 1); PG8_STAGE(PG8_SA(0, 0), a2, voffA);
            PG8_BAR; PG8_WAIT_L(0); PG8_MMA(1, 0, At, B0); PG8_BAR; PG8_SCHED;
            PG8_STAGE(PG8_SB(0, 1), b2 + hstep, voffB);
            PG8_WAIT_V(6); PG8_BAR; PG8_MMA(1, 1, At, B1); PG8_BAR;
            PG8_LDB(B0, 1, 0); PG8_SCHED; PG8_LDA(At, 1, 0); PG8_STAGE(PG8_SA(0, 1), a2 + hstep, voffA);
            PG8_WAIT_L(8); PG8_BAR; PG8_WAIT_L(0); PG8_MMA(0, 0, At, B0); PG8_BAR; PG8_SCHED;
            PG8_LDB(B1, 1, 1); PG8_STAGE(PG8_SB(1, 0), b3, voffB);
            PG8_BAR; PG8_WAIT_L(0); PG8_MMA(0, 1, At, B1); PG8_BAR;
            PG8_LDA(At, 1, 1); PG8_STAGE(PG8_SA(1, 0), a3, voffA);
            PG8_BAR; PG8_WAIT_L(0); PG8_MMA(1, 0, At, B0); PG8_BAR; PG8_SCHED;
            PG8_STAGE(PG8_SB(1, 1), b3 + hstep, voffB);
            PG8_WAIT_V(6); PG8_BAR; PG8_MMA(1, 1, At, B1); PG8_BAR;
            }
        }
        if constexpr (ALIGN_EPI) { if (wr == 0) PG8_BAR; }
        if constexpr (!Epi::AFTER_DRAIN) { E(acc, cur, wr, wc, fr, fq); S.done(cur); }
        if (!has_next) break;
#pragma unroll
        for (int a = 0; a < 2; ++a)
#pragma unroll
            for (int b = 0; b < 2; ++b)
#pragma unroll
                for (int m = 0; m < 4; ++m)
#pragma unroll
                    for (int n = 0; n < 2; ++n) acc[a][b][m][n] = (f32x4){0.f, 0.f, 0.f, 0.f};
        cur = nxt; cA = nA; cB = nB; ++ui;
        if constexpr (ALIGN_EPI) { if (wr == 1) PG8_BAR; }
    }
    PG8_WAIT_V(0);
    if constexpr (!ALIGN_EPI) { if (wr == 0) PG8_BAR; }
    PG8_BAR;
#undef PG8_SA
#undef PG8_SB
#undef PG8_STAGE
#undef PG8_LDA
#undef PG8_LDB
#undef PG8_MMA
#undef PG8_WAIT_V
#undef PG8_WAIT_L
#undef PG8_BAR
#undef PG8_SCHED
}
}

typedef GAS unsigned gu32;
#define RLX_AGENT __ATOMIC_RELAXED, __HIP_MEMORY_SCOPE_AGENT
#define XB_TMO      128
#define XB_XCNT(j)  (256  + 64 * (j))
#define XB_XSUB(j)  (1280 + 64 * (j))
#define XB_XGEN(j)  (2304 + 64 * (j))
#define XB_TOP      3328
#define XB_TOPGEN   3392
#define XCD_BAR_WORDS 3456
#define XB_SPIN_CAP (1u << 18)
__device__ __forceinline__ unsigned xb_ld(unsigned* p)              { return __hip_atomic_load(p, __ATOMIC_RELAXED, __HIP_MEMORY_SCOPE_AGENT); }
__device__ __forceinline__ unsigned xb_add(unsigned* p, unsigned v) { return __hip_atomic_fetch_add(p, v, __ATOMIC_RELAXED, __HIP_MEMORY_SCOPE_AGENT); }
__device__ __forceinline__ unsigned xb_xcc_id() { return (unsigned)__builtin_amdgcn_s_getreg((3 << 11) | 20) & 0xFu; }
#define XB_SPIN(cond, bar) do { unsigned _sp = 0; while (cond) { __builtin_amdgcn_s_sleep(1); \
    if ((++_sp & 255u) == 0u) { if (xb_ld(&(bar)[XB_TMO])) break; if (_sp > XB_SPIN_CAP) { atomicAdd(&(bar)[XB_TMO], 1u); break; } } } } while (0)
struct XcdBarrier { unsigned* bar; unsigned x; volatile LAS unsigned* st; };
__device__ __forceinline__ XcdBarrier xcd_barrier_post(unsigned* bar, volatile LAS unsigned* st, bool leader) {
    XcdBarrier b; b.bar = bar; b.x = xb_xcc_id(); b.st = st;
    if (leader) (void)xb_add(&bar[XB_XCNT(b.x)], 1u);
    return b;
}
__device__ __forceinline__ void xcd_barrier_complete(unsigned* bar, unsigned x, unsigned& nloc, unsigned& nx) {
    const unsigned G = gridDim.x * gridDim.y * gridDim.z;
    unsigned sum, cnt, mine, sp = 0u;
    for (;;) {
        sum = 0u; cnt = 0u; mine = 0u;
#pragma unroll
        for (unsigned j = 0; j < 16; ++j) { const unsigned c = xb_ld(&bar[XB_XCNT(j)]); sum += c; cnt += (c > 0u) ? 1u : 0u; mine = (j == x) ? c : mine; }
        if (sum == G) break;
        __builtin_amdgcn_s_sleep(1);
        if ((++sp & 255u) == 0u) { if (xb_ld(&bar[XB_TMO])) break; if (sp > XB_SPIN_CAP) { atomicAdd(&bar[XB_TMO], 1u); break; } }
    }
    nloc = mine > 0u ? mine : 1u; nx = cnt > 0u ? cnt : 1u;
}
__device__ __forceinline__ void xcd_barrier(const XcdBarrier& b, bool leader) {
    asm volatile("s_waitcnt vmcnt(0)" ::: "memory");
    __syncthreads();
    if (leader) {
        unsigned* bar = b.bar;
        __builtin_amdgcn_s_waitcnt(0);
        unsigned nloc = b.st[0], nx = b.st[1];
        if (nloc == 0u) { xcd_barrier_complete(bar, b.x, nloc, nx); b.st[0] = nloc; b.st[1] = nx; }
        const unsigned old = xb_add(&bar[XB_XSUB(b.x)], 1u);
        const unsigned gen = old / nloc;
        if (old + 1u == (gen + 1u) * nloc) {
            __builtin_amdgcn_fence(__ATOMIC_RELEASE, "agent");
            asm volatile("s_waitcnt vmcnt(0)" ::: "memory");
            const unsigned og = xb_add(&bar[XB_TOP], 1u);
            const unsigned tg = og / nx;
            if (og + 1u == (tg + 1u) * nx) xb_add(&bar[XB_TOPGEN], 1u);
            else XB_SPIN(xb_ld(&bar[XB_TOPGEN]) == tg, bar);
            __builtin_amdgcn_fence(__ATOMIC_ACQUIRE, "agent");
            asm volatile("s_waitcnt vmcnt(0)" ::: "memory");
        } else {
            XB_SPIN(xb_ld(&bar[XB_TOPGEN]) == gen, bar);
            __builtin_amdgcn_fence(__ATOMIC_ACQUIRE, "agent");
            asm volatile("s_waitcnt vmcnt(0)" ::: "memory");
        }
    }
    __syncthreads();
}

struct DepOrder : pg8::StaticOrder {
    unsigned* cnt; unsigned target; unsigned* tmo;
    __device__ __forceinline__ void a_ready(const pg8::Unit& u) const {
        const bool leader = (__builtin_amdgcn_readfirstlane((int)threadIdx.x >> 6) == 0) && (lane_id() == 0);
        if (leader) { unsigned* c_ = cnt + u.pm * 16; XB_SPIN(xb_ld(c_) < target, tmo); __builtin_amdgcn_fence(__ATOMIC_ACQUIRE, "agent"); asm volatile("s_waitcnt vmcnt(0)" ::: "memory"); }
        __syncthreads();
    }
};

__device__ __forceinline__ unsigned xcd_barrier_arrive(const XcdBarrier& b, bool leader) {
    unsigned gen = 0u;
    asm volatile("s_waitcnt vmcnt(0)" ::: "memory");
    __syncthreads();
    if (leader) {
        unsigned* bar = b.bar;
        __builtin_amdgcn_s_waitcnt(0);
        unsigned nloc = b.st[0], nx = b.st[1];
        if (nloc == 0u) { xcd_barrier_complete(bar, b.x, nloc, nx); b.st[0] = nloc; b.st[1] = nx; }
        const unsigned old = xb_add(&bar[XB_XSUB(b.x)], 1u);
        gen = old / nloc;
        if (old + 1u == (gen + 1u) * nloc) {
            __builtin_amdgcn_fence(__ATOMIC_RELEASE, "agent");
            asm volatile("s_waitcnt vmcnt(0)" ::: "memory");
            const unsigned og = xb_add(&bar[XB_TOP], 1u);
            const unsigned tg = og / nx;
            if (og + 1u == (tg + 1u) * nx) xb_add(&bar[XB_TOPGEN], 1u);
        }
    }
    return gen;
}
__device__ __forceinline__ void xcd_barrier_wait(const XcdBarrier& b, bool leader, unsigned gen) {
    if (leader) {
        XB_SPIN(xb_ld(&b.bar[XB_TOPGEN]) == gen, b.bar);
        __builtin_amdgcn_fence(__ATOMIC_ACQUIRE, "agent");
        asm volatile("s_waitcnt vmcnt(0)" ::: "memory");
    }
    __syncthreads();
}

struct Args { const float* in[23]; float* out; unsigned char* ws; int ph_lo, ph_hi; };
struct Ctx {
    LAS unsigned char* lds; int tid, lane, wave, G, bid;
    const Args* a; float* out; unsigned char* ws; float* ctlf;
    unsigned* pend;
    unsigned* qctr; unsigned tk;
};
#define QPUBLISH(F) do { if ((F).pend) { asm volatile("s_waitcnt vmcnt(0)" ::: "memory"); __syncthreads(); if ((F).tid == 0) (void)__hip_atomic_fetch_add((F).pend, 1u, __ATOMIC_RELAXED, __HIP_MEMORY_SCOPE_AGENT); (F).pend = nullptr; } } while (0)
#define QTICKET(F) do { QPUBLISH(F); if ((F).tid == 0) (F).tk = __hip_atomic_fetch_add((F).qctr, 1u, __ATOMIC_RELAXED, __HIP_MEMORY_SCOPE_AGENT); } while (0)
#define IN_XP 0
#define IN_XS 1
#define IN_MEM 2
#define IN_SCONV 3
#define IN_SGLA 4
#define IN_CSWK 5
#define IN_CSWV 6
#define IN_CMK 7
#define IN_CMV 8
#define IN_GNORM 9
#define IN_WIN 10
#define IN_CONVW 11
#define IN_WUP 12
#define IN_BA 13
#define IN_GGLAO 14
#define IN_GSWQ 15
#define IN_GSWK 16
#define IN_SINKS 17
#define IN_GMEM 18
#define IN_WMEM 19
#define IN_GMEMQ 20
#define IN_GMEMK 21
#define IN_WOUT 22

__device__ __forceinline__ int win_src_block(int nb) { if (nb >= 32) return nb; const int j = nb >> 2, t = nb & 3; return (t == 0 ? 8 : t == 1 ? 0 : t == 2 ? 16 : 24) + j; }
template <bool HASG>
__device__ __forceinline__ void p0_transpose_item(const float* W, const float* gk, int K, int N, int Npad, bf16_t* WT, LAS float* scr, int kb, int nb, int lane, int nbs = -1) {
    const int k0 = 64 * kb, n0 = 64 * nb, ns0 = 64 * (nbs < 0 ? nb : nbs), n4 = (lane & 15) * 4, kr = lane >> 4; const bool ok = (ns0 + n4) < N;
    f32x4 v[16];
#pragma unroll
    for (int i = 0; i < 16; ++i) { const int k = 4 * i + kr; v[i] = ok ? __builtin_nontemporal_load((const f32x4*)(W + (size_t)(k0 + k) * N + ns0 + n4)) : (f32x4){0.f, 0.f, 0.f, 0.f}; }
    float gv[16];
#pragma unroll
    for (int i = 0; i < 16; ++i) gv[i] = HASG ? gk[k0 + 4 * i + kr] : 1.f;
#pragma unroll
    for (int i = 0; i < 16; ++i) { const int k = 4 * i + kr; const float g = gv[i]; LAS float* d = scr + k * 65 + n4;
        d[0] = v[i].x * g; d[1] = v[i].y * g; d[2] = v[i].z * g; d[3] = v[i].w * g; }
    LDS_WAIT(); asm volatile("" ::: "memory");
    const int c = lane & 7;
#pragma unroll
    for (int j = 0; j < 8; ++j) { const int n = (lane >> 3) + 8 * j; const LAS float* s = scr + (8 * c) * 65 + n;
        u32x4 o; o.x = pk2(s[0 * 65], s[1 * 65]); o.y = pk2(s[2 * 65], s[3 * 65]); o.z = pk2(s[4 * 65], s[5 * 65]); o.w = pk2(s[6 * 65], s[7 * 65]);
        if (n0 + n < Npad) *(u32x4*)(WT + (size_t)(n0 + n) * K + k0 + 8 * c) = o; }
    LDS_WAIT(); asm volatile("" ::: "memory");
}
__device__ __forceinline__ void row_to_bf16(const float* xrow, bf16_t* orow, float* ss, int lane) {
    const f32x4* xr = (const f32x4*)xrow + lane; f32x4 v[8]; float s = 0.f;
#pragma unroll
    for (int j = 0; j < 8; ++j) { v[j] = __builtin_nontemporal_load(xr + 64 * j); s += (v[j].x * v[j].x + v[j].y * v[j].y) + (v[j].z * v[j].z + v[j].w * v[j].w); }
    s = wave_sum(s);
    u32x2* o8 = (u32x2*)orow + lane;
#pragma unroll
    for (int j = 0; j < 8; ++j) { u32x2 w; w.x = pk2(v[j].x, v[j].y); w.y = pk2(v[j].z, v[j].w); o8[64 * j] = w; }
    if (lane == 0) *ss = s;
}
__device__ __forceinline__ void p0_prologue(Ctx& F) {
    LAS float* scr = (LAS float*)(F.lds + F.wave * 16640);
    const int gw = F.bid * NWAVES + F.wave, NGW = F.G * NWAVES;
    constexpr int T_IN = 32 * 96, T_OUT = 32 * 32, T_MEM = 2 * 32 * 16, T_XP = NP, T_XS = NS, T_M = NMEMROWS;
    constexpr int NIT = T_IN + T_OUT + T_MEM + T_XP + T_XS + T_M;
    if (F.bid == 0) { for (int i = F.tid; i < 8192 + 64; i += NTHREADS) ((unsigned*)F.ctlf)[CW_Q + i] = 0u; }
    for (int i = gw * 64 + F.lane; i < NP + NS; i += NGW * 64) { if (i < NP) F.ctlf[CW_SSP + NP + i] = 0.f; else F.ctlf[CW_SSS + NS + (i - NP)] = 0.f; }
    for (int it = gw; it < NIT; it += NGW) {
        int r = it; { int ln_ = F.lane; asm volatile("" : "+v"(ln_)); F.lane = ln_; }
        if (r < T_IN) { p0_transpose_item<true>(F.a->in[IN_WIN], F.a->in[IN_GNORM], DM, DIN, PN, (bf16_t*)(F.ws + WS_WIN), scr, r / 96, r % 96, F.lane, win_src_block(r % 96)); continue; }
        r -= T_IN;
        if (r < T_OUT) { p0_transpose_item<false>(F.a->in[IN_WOUT], nullptr, DM, DM, DM, (bf16_t*)(F.ws + WS_WOUT), scr, r / 32, r % 32, F.lane); continue; }
        r -= T_OUT;
        if (r < T_MEM) { const int l = r / 512, q = r % 512;
            p0_transpose_item<true>(F.a->in[IN_WMEM] + (size_t)l * DM * 1024, F.a->in[IN_GMEM] + l * DM, DM, 1024, 1024, (bf16_t*)(F.ws + WS_WMEM) + (size_t)l * 1024 * DM, scr, q / 16, q % 16, F.lane); continue; }
        r -= T_MEM;
        if (r < T_XP) { row_to_bf16(F.a->in[IN_XP] + (size_t)r * DM, (bf16_t*)(F.ws + WS_XB) + (size_t)r * DM, F.ctlf + CW_SSP + r, F.lane); continue; }
        r -= T_XP;
        if (r < T_XS) { row_to_bf16(F.a->in[IN_XS] + (size_t)r * DM, (bf16_t*)(F.ws + WS_XS) + (size_t)r * DM, F.ctlf + CW_SSS + r, F.lane); continue; }
        r -= T_XS;
        row_to_bf16(F.a->in[IN_MEM] + (size_t)r * DM, (bf16_t*)(F.ws + WS_MEMA) + (size_t)r * DM, F.ctlf + CW_SSM + r, F.lane);
    }
}

__device__ __forceinline__ void cvt1_item(Ctx& F, int item) {
    QTICKET(F);
    LAS float* scr = (LAS float*)(F.lds + F.wave * 16640);
    const int w = item * 8 + F.wave;
    if (w < 32 * 96) p0_transpose_item<true>(F.a->in[IN_WIN] + (size_t)DM * DIN, F.a->in[IN_GNORM] + DM, DM, DIN, PN, (bf16_t*)(F.ws + WS_WIN + WIN_L), scr, w / 96, w % 96, F.lane, win_src_block(w % 96));
    else if (w < 32 * 96 + 32 * 32) { const int q = w - 32 * 96; p0_transpose_item<false>(F.a->in[IN_WOUT] + (size_t)DM * DM, nullptr, DM, DM, DM, (bf16_t*)(F.ws + WS_WOUT + WOUT_L), scr, q / 32, q % 32, F.lane); }
}

template <class Epi>
__device__ __forceinline__ void sg_unit(Ctx& F, const bf16_t* A, const bf16_t* Bt, const Epi& E) {
    constexpr int NSL = 6, D = 5, SLOT = 24576, BO = 16384;
    LAS unsigned char* lds = F.lds;
    const int tid = F.tid, fr = F.lane & 15, fq = F.lane >> 4, wm = F.wave & 3, wn = F.wave >> 2;
    unsigned voffA[2], voffB;
#pragma unroll
    for (int i = 0; i < 2; ++i) { int R, C; pg8::stage_rc(tid * 16 + i * 8192, R, C); voffA[i] = (unsigned)(R * DM + C) * 2u; if (i == 0) voffB = voffA[0]; }
    const unsigned ldsw = (unsigned)F.wave * 1024u;
    const int aoff = pg8::lds_byte(32 * wm + fr, 8 * fq), boff = BO + pg8::lds_byte(32 * wn + fr, 8 * fq);
#define SG_STAGE(t) do { const int so_ = ((t) % NSL) * SLOT; const char* ga_ = (const char*)A + (size_t)(t) * 128; const char* gb_ = (const char*)Bt + (size_t)(t) * 128; \
        _Pragma("unroll") for (int _i = 0; _i < 2; ++_i) { unsigned _vo = voffA[_i]; asm volatile("" : "+v"(_vo)); \
            __builtin_amdgcn_global_load_lds((const unsigned*)(ga_ + _vo), (LAS unsigned*)(lds + so_ + ldsw + _i * 8192), 16, 0, 0); } \
        { unsigned _vo = voffB; asm volatile("" : "+v"(_vo)); __builtin_amdgcn_global_load_lds((const unsigned*)(gb_ + _vo), (LAS unsigned*)(lds + so_ + BO + ldsw), 16, 0, 0); } } while (0)
    f32x4 acc[2][2];
#pragma unroll
    for (int a = 0; a < 2; ++a)
#pragma unroll
        for (int b = 0; b < 2; ++b) acc[a][b] = (f32x4){0.f, 0.f, 0.f, 0.f};
    QTICKET(F);
    __syncthreads();
#pragma unroll
    for (int t = 0; t < D; ++t) SG_STAGE(t);
    for (int t = 0; t < 32; ++t) {
        if (t + D <= 32) asm volatile("s_waitcnt vmcnt(12)" ::: "memory"); else asm volatile("s_waitcnt vmcnt(0)" ::: "memory");
        __builtin_amdgcn_s_barrier(); asm volatile("" ::: "memory");
        if (t + D < 32) SG_STAGE(t + D);
        const int so = (t % NSL) * SLOT;
        bf16x8 Af[2][2], Bf[2][2];
#pragma unroll
        for (int i = 0; i < 2; ++i)
#pragma unroll
            for (int ks = 0; ks < 2; ++ks) { Af[i][ks] = *(const LAS bf16x8*)(lds + so + aoff + i * 2048 + ks * 1024); Bf[i][ks] = *(const LAS bf16x8*)(lds + so + boff + i * 2048 + ks * 1024); }
        asm volatile("s_waitcnt lgkmcnt(0)" ::: "memory");
#pragma unroll
        for (int ks = 0; ks < 2; ++ks)
#pragma unroll
            for (int mi = 0; mi < 2; ++mi)
#pragma unroll
                for (int ni = 0; ni < 2; ++ni) acc[mi][ni] = MFMA16(Bf[ni][ks], Af[mi][ks], acc[mi][ni]);
    }
#undef SG_STAGE
    E(acc, wm, wn, fr, fq);
}
__device__ __forceinline__ void st16_sc1u(bf16_t* p, u32x4 v) { asm volatile("global_store_dwordx4 %0, %1, off sc1\n\ts_nop 1" :: "v"(p), "v"(v) : "memory"); }
__device__ __forceinline__ void pair16(const unsigned long long (&w)[4], bool odd, u32x4& o0, u32x4& o1) {
    const unsigned long long s0 = odd ? w[0] : w[1], s1 = odd ? w[2] : w[3];
    const unsigned long long r0 = __shfl_xor(s0, 16), r1 = __shfl_xor(s1, 16);
    const unsigned long long k0 = odd ? w[1] : w[0], k1 = odd ? w[3] : w[2];
    const unsigned long long lo0 = odd ? r0 : k0, hi0 = odd ? k0 : r0, lo1 = odd ? r1 : k1, hi1 = odd ? k1 : r1;
    o0.x = (unsigned)lo0; o0.y = (unsigned)(lo0 >> 32); o0.z = (unsigned)hi0; o0.w = (unsigned)(hi0 >> 32);
    o1.x = (unsigned)lo1; o1.y = (unsigned)(lo1 >> 32); o1.z = (unsigned)hi1; o1.w = (unsigned)(hi1 >> 32);
}
__device__ __forceinline__ void st16_sc1(float* p, f32x4 v) { asm volatile("global_store_dwordx4 %0, %1, off sc1\n\ts_nop 1" :: "v"(p), "v"(v) : "memory"); }
struct SgEpiBf16 { bf16_t* O; int ldc; const float* ss;
    __device__ __forceinline__ void operator()(const f32x4 (&acc)[2][2], int wm, int wn, int fr, int fq) const {
        const float sv[2] = {ss[32 * wm + fr], ss[32 * wm + 16 + fr]};
        unsigned long long w[4];
#pragma unroll
        for (int mi = 0; mi < 2; ++mi) { const float sc = rsqrtf(sv[mi] * (1.0f / DM) + EPS);
#pragma unroll
            for (int ni = 0; ni < 2; ++ni) { const f32x4 a = acc[mi][ni]; w[mi * 2 + ni] = (unsigned long long)pk2(a[0] * sc, a[1] * sc) | ((unsigned long long)pk2(a[2] * sc, a[3] * sc) << 32); } }
        const bool odd = (fq & 1) != 0; u32x4 o0, o1; pair16(w, odd, o0, o1);
        const int col = 32 * wn + (odd ? 16 : 0) + 4 * (fq & ~1);
        st16_sc1u(O + (size_t)(32 * wm + fr) * ldc + col, o0); st16_sc1u(O + (size_t)(32 * wm + 16 + fr) * ldc + col, o1); } };
struct SgEpiF32 { float* O; int ldc; const float* ss;
    __device__ __forceinline__ void operator()(const f32x4 (&acc)[2][2], int wm, int wn, int fr, int fq) const {
        const float sv[2] = {ss[32 * wm + fr], ss[32 * wm + 16 + fr]};
#pragma unroll
        for (int mi = 0; mi < 2; ++mi) { const int row = 32 * wm + 16 * mi + fr; const float sc = rsqrtf(sv[mi] * (1.0f / DM) + EPS);
#pragma unroll
            for (int ni = 0; ni < 2; ++ni) { const int col = 32 * wn + 16 * ni + 4 * fq; st16_sc1(O + (size_t)row * ldc + col, acc[mi][ni] * sc); } } } };
struct SgEpiOut { const float* base; float* out; bf16_t* xb; float* ssn;
    __device__ __forceinline__ void operator()(const f32x4 (&acc)[2][2], int wm, int wn, int fr, int fq) const {
        f32x4 bv[2][2];
#pragma unroll
        for (int mi = 0; mi < 2; ++mi)
#pragma unroll
            for (int ni = 0; ni < 2; ++ni) bv[mi][ni] = *(const f32x4*)(base + (size_t)(32 * wm + 16 * mi + fr) * DM + 32 * wn + 16 * ni + 4 * fq);
#pragma unroll
        for (int mi = 0; mi < 2; ++mi) { const int row = 32 * wm + 16 * mi + fr; float s = 0.f;
#pragma unroll
            for (int ni = 0; ni < 2; ++ni) { const int col = 32 * wn + 16 * ni + 4 * fq; const size_t o = (size_t)row * DM + col; const f32x4 y = bv[mi][ni] + acc[mi][ni]; *(f32x4*)(out + o) = y;
                if (xb) { u32x2 w; w.x = pk2(y[0], y[1]); w.y = pk2(y[2], y[3]); *(u32x2*)(xb + o) = w; s += (y[0] * y[0] + y[1] * y[1]) + (y[2] * y[2] + y[3] * y[3]); } }
            if (xb) { s += __shfl_xor(s, 16); s += __shfl_xor(s, 32); if (fq == 0) atomicAdd(ssn + row, s); } } } };

__device__ __forceinline__ void conv_unit(Ctx& F, int l, int cu) {
    const bf16_t* proj = (const bf16_t*)(F.ws + WS_PROJ); bf16_t* mix = (bf16_t*)(F.ws + WS_MIX);
    const int R0 = cu * 32, b = R0 >> 12, t0 = R0 & 4095, tg = F.tid >> 6, c8 = (F.tid & 63) * 8, ts = t0 + tg * 4;
    const float* cw = F.a->in[IN_CONVW] + l * 3 * 512;
    const bool halo = ts >= 2; const int th = halo ? ts - 2 : 0;
    const bf16_t* ph = proj + (size_t)(b * SEQ + th) * PN; const bf16_t* p0 = proj + (size_t)(b * SEQ + ts) * PN;
    u32x4 ru[6], rg[4];
#pragma unroll
    for (int i = 0; i < 2; ++i) ru[i] = *(const u32x4*)(ph + (size_t)i * PN + C_AC + c8);
#pragma unroll
    for (int i = 0; i < 4; ++i) { ru[2 + i] = *(const u32x4*)(p0 + (size_t)i * PN + C_AC + c8); rg[i] = __builtin_nontemporal_load((const u32x4*)(p0 + (size_t)i * PN + C_AB + c8)); }
    float w0[8], w1[8], w2[8], u[6][8];
#pragma unroll
    for (int j = 0; j < 8; ++j) { w0[j] = cw[c8 + j]; w1[j] = cw[512 + c8 + j]; w2[j] = cw[1024 + c8 + j]; }
    QTICKET(F);
#pragma unroll
    for (int i = 0; i < 6; ++i) { unpack8(ru[i], u[i]);
        if (i < 2 && !halo) {
#pragma unroll
            for (int j = 0; j < 8; ++j) u[i][j] = 0.f; } }
#pragma unroll
    for (int i = 0; i < 4; ++i) { const size_t row = (size_t)(b * SEQ + ts + i); float g[8], y[8]; unpack8(rg[i], g);
#pragma unroll
        for (int j = 0; j < 8; ++j) y[j] = g[j] * (w0[j] * u[i][j] + w1[j] * u[i + 1][j] + w2[j] * u[i + 2][j]);
        st16_sc1u(mix + row * DM + c8, pack8(y)); }
}

__device__ __forceinline__ void swa_unit(Ctx& F, int l, int un) {
    constexpr int PK = 144, VOFF = 256 * PK;
    const bf16_t* proj = (const bf16_t*)(F.ws + WS_PROJ); bf16_t* mix = (bf16_t*)(F.ws + WS_MIX);
    LAS unsigned char* Kl = F.lds; LAS unsigned char* Vl = F.lds + VOFF;
    const int blk = un & 31, kvh = (un >> 5) & 1, b = un >> 6, t0 = blk * 128;
    const int fr = F.lane & 15, fq = F.lane >> 4;
    const int qi = 16 * F.wave + fr; const size_t row = (size_t)(b * SEQ + t0 + qi); const bf16_t* pr = proj + row * PN;
    u32x4 kraw[4], vraw[4], qraw[4][2];
#pragma unroll
    for (int i = 0; i < 4; ++i) { const int p = F.tid + 512 * i, kj = p >> 3, ch = p & 7, tok = t0 - 128 + kj; const int tk = tok >= 0 ? tok : 0;
        const bf16_t* pp = proj + (size_t)(b * SEQ + tk) * PN; kraw[i] = *(const u32x4*)(pp + C_SK + kvh * 64 + ch * 8); vraw[i] = *(const u32x4*)(pp + C_SV + kvh * 64 + ch * 8);
        if (tok < 0) { kraw[i] = (u32x4){0u, 0u, 0u, 0u}; vraw[i] = kraw[i]; } }
#pragma unroll
    for (int g = 0; g < 4; ++g) {
#pragma unroll
        for (int ks = 0; ks < 2; ++ks) qraw[g][ks] = *(const u32x4*)(pr + C_SQ + (kvh * 4 + g) * 64 + ks * 32 + fq * 8);
    }
    f32x4 gkv[2], gqv[2][2]; float sinkv[4];
    {   const float* gkp = F.a->in[IN_GSWK] + l * 64 + (F.tid & 7) * 8; gkv[0] = ((const f32x4*)gkp)[0]; gkv[1] = ((const f32x4*)gkp)[1];
        const float* gqp = F.a->in[IN_GSWQ] + l * 64;
#pragma unroll
        for (int ks = 0; ks < 2; ++ks) { gqv[ks][0] = *(const f32x4*)(gqp + ks * 32 + fq * 8); gqv[ks][1] = *(const f32x4*)(gqp + ks * 32 + fq * 8 + 4); }
        const float* skp = F.a->in[IN_SINKS] + l * 8 + kvh * 4;
#pragma unroll
        for (int g = 0; g < 4; ++g) sinkv[g] = skp[g]; }
    QTICKET(F);
    __syncthreads();
    {   const float gk[8] = {gkv[0].x, gkv[0].y, gkv[0].z, gkv[0].w, gkv[1].x, gkv[1].y, gkv[1].z, gkv[1].w};
        const bool wout = (blk == 31);
#pragma unroll
        for (int i = 0; i < 4; ++i) { const int p = F.tid + 512 * i, kj = p >> 3, ch = p & 7;
            float k[8]; unpack8(kraw[i], k); float ss = 0.f;
#pragma unroll
            for (int j = 0; j < 8; ++j) ss += k[j] * k[j];
            ss += __shfl_xor(ss, 1); ss += __shfl_xor(ss, 2); ss += __shfl_xor(ss, 4);
            const float rs = rsqrtf(ss * (1.f / 64.f) + EPS);
#pragma unroll
            for (int j = 0; j < 8; ++j) k[j] = k[j] * rs * gk[j];
            *(LAS u32x4*)(Kl + kj * PK + ch * 16) = pack8(k); *(LAS u32x4*)(Vl + kj * PK + ch * 16) = vraw[i];
            if (wout && kj >= 128) { const size_t o = ((size_t)(l * 2 + b) * 128 + (kj - 128)) * 128 + kvh * 64 + ch * 8; float v[8]; unpack8(vraw[i], v);
#pragma unroll
                for (int j = 0; j < 8; ++j) { F.out[O_SWKP + o + j] = k[j]; F.out[O_SWVP + o + j] = v[j]; } }
        }
    }
    __syncthreads();
    const int e = F.wave & ~1;
#define SCHED_FENCE() __builtin_amdgcn_sched_barrier(0)
#pragma unroll 1
    for (int g = 0; g < 4; ++g) {
        const int h = kvh * 4 + g;
        u32x2 zq[4];
#pragma unroll
        for (int db = 0; db < 4; ++db) zq[db] = *(const u32x2*)(pr + C_SZ + h * 64 + 16 * db + 4 * fq);
        bf16x8 kf[20];
#pragma unroll
        for (int kb = 0; kb < 10; ++kb)
#pragma unroll
            for (int ks = 0; ks < 2; ++ks) kf[2 * kb + ks] = *(const LAS bf16x8*)(Kl + (16 * (e + kb) + fr) * PK + (ks * 32 + fq * 8) * 2);
        bf16x8 Qf[2];
        {   float q[2][8]; float ss = 0.f;
#pragma unroll
            for (int ks = 0; ks < 2; ++ks) { unpack8(g == 0 ? qraw[0][ks] : g == 1 ? qraw[1][ks] : g == 2 ? qraw[2][ks] : qraw[3][ks], q[ks]);
#pragma unroll
                for (int j = 0; j < 8; ++j) ss += q[ks][j] * q[ks][j]; }
            ss += __shfl_xor(ss, 16); ss += __shfl_xor(ss, 32);
            const float rs = rsqrtf(ss * (1.f / 64.f) + EPS) * (0.125f * 1.4426950408889634f);
#pragma unroll
            for (int ks = 0; ks < 2; ++ks) {
#pragma unroll
                for (int j = 0; j < 8; ++j) q[ks][j] = q[ks][j] * rs * gqv[ks][j >> 2][j & 3];
                Qf[ks] = __builtin_bit_cast(bf16x8, pack8(q[ks])); }
        }
        SCHED_FENCE();
        f32x4 S[10];
#pragma unroll
        for (int kb = 0; kb < 10; ++kb) { f32x4 a = (f32x4){0.f, 0.f, 0.f, 0.f}; a = MFMA16(kf[2 * kb], Qf[0], a); a = MFMA16(kf[2 * kb + 1], Qf[1], a); S[kb] = a; }
        SCHED_FENCE();
        s16x4 vf[40];
#pragma unroll
        for (int p = 0; p < 5; ++p)
#pragma unroll
            for (int db = 0; db < 4; ++db) { vf[(p * 4 + db) * 2] = tr4(Vl, PK, 16 * (e + 2 * p) + 4 * fq, 16 * db, fr); vf[(p * 4 + db) * 2 + 1] = tr4(Vl, PK, 16 * (e + 2 * p + 1) + 4 * fq, 16 * db, fr); }
        SCHED_FENCE();
        const float sink = (g == 0 ? sinkv[0] : g == 1 ? sinkv[1] : g == 2 ? sinkv[2] : sinkv[3]) * 1.4426950408889634f;
        float m = sink;
#pragma unroll
        for (int kb = 0; kb < 10; ++kb) { const int d = e + kb - F.wave;
            const bool hidden = (d < 0) || (d > 8) || (blk == 0 && (e + kb) < 8);
            if (hidden) { S[kb] = (f32x4){-INFINITY, -INFINITY, -INFINITY, -INFINITY}; }
            else if (d == 0) {
#pragma unroll
                for (int i = 0; i < 4; ++i) if (4 * fq + i <= fr) S[kb][i] = -INFINITY; }
            else if (d == 8) {
#pragma unroll
                for (int i = 0; i < 4; ++i) if (4 * fq + i > fr) S[kb][i] = -INFINITY; }
#pragma unroll
            for (int i = 0; i < 4; ++i) m = fmaxf(m, S[kb][i]); }
        m = fmaxf(m, __shfl_xor(m, 16)); m = fmaxf(m, __shfl_xor(m, 32));
        float sum = 0.f;
#pragma unroll
        for (int kb = 0; kb < 10; ++kb)
#pragma unroll
            for (int i = 0; i < 4; ++i) { const float ev = __builtin_amdgcn_exp2f(S[kb][i] - m); S[kb][i] = ev; sum += ev; }
        sum += __shfl_xor(sum, 16); sum += __shfl_xor(sum, 32);
        sum += __builtin_amdgcn_exp2f(sink - m);
        const float inv = __builtin_amdgcn_rcpf(sum);
        bf16x8 Pb[5];
#pragma unroll
        for (int p = 0; p < 5; ++p) Pb[p] = pk8f(S[2 * p], S[2 * p + 1]);
        SCHED_FENCE();
        f32x4 o[4];
#pragma unroll
        for (int db = 0; db < 4; ++db) o[db] = (f32x4){0.f, 0.f, 0.f, 0.f};
#pragma unroll
        for (int p = 0; p < 5; ++p)
#pragma unroll
            for (int db = 0; db < 4; ++db) o[db] = MFMA16(cat8(vf[(p * 4 + db) * 2], vf[(p * 4 + db) * 2 + 1]), Pb[p], o[db]);
        SCHED_FENCE();
#pragma unroll
        for (int db = 0; db < 4; ++db) { const int d = 16 * db + 4 * fq; const u32x2 z = zq[db];
            u32x2 w; w.x = pk2(o[db][0] * inv * siluf(bflo(z.x)), o[db][1] * inv * siluf(bfhi(z.x))); w.y = pk2(o[db][2] * inv * siluf(bflo(z.y)), o[db][3] * inv * siluf(bfhi(z.y)));
            *(u32x2*)(mix + row * DM + 1024 + h * 64 + d) = w; }
    }
}

__device__ __forceinline__ void memfin_item(Ctx& F, int it) {
    const int rr = it * 8 + F.wave, lw = rr >> 9, rem = rr & 511, b = rem >> 8, m = rem & 255, head = F.lane >> 4, d0 = (F.lane & 15) * 8;
    const float* src = (const float*)(F.ws + WS_MEMKV) + (size_t)rem * 2048 + lw * 1024 + F.lane * 8;
    const f32x4 k0 = ((const f32x4*)src)[0], k1 = ((const f32x4*)src)[1], v0 = ((const f32x4*)(src + 512))[0], v1 = ((const f32x4*)(src + 512))[1];
    const float* g = F.a->in[IN_GMEMK] + lw * 128 + d0; const f32x4 g0 = ((const f32x4*)g)[0], g1 = ((const f32x4*)g)[1];
    QTICKET(F);
    float ss = (k0.x * k0.x + k0.y * k0.y) + (k0.z * k0.z + k0.w * k0.w) + (k1.x * k1.x + k1.y * k1.y) + (k1.z * k1.z + k1.w * k1.w);
    ss += __shfl_xor(ss, 1); ss += __shfl_xor(ss, 2); ss += __shfl_xor(ss, 4); ss += __shfl_xor(ss, 8);
    const float rs = rsqrtf(ss * (1.f / 128.f) + EPS);
    const f32x4 n0 = k0 * rs * g0, n1 = k1 * rs * g1;
    {   float nn = (n0.x * n0.x + n0.y * n0.y) + (n0.z * n0.z + n0.w * n0.w) + (n1.x * n1.x + n1.y * n1.y) + (n1.z * n1.z + n1.w * n1.w);
        nn += __shfl_xor(nn, 1); nn += __shfl_xor(nn, 2); nn += __shfl_xor(nn, 4); nn += __shfl_xor(nn, 8);
        if ((F.lane & 15) == 0) atomicMax((unsigned*)(F.ctlf + CW_KN2) + (lw * 2 + b) * 4 + head, __float_as_uint(nn)); }
    float* ko = F.out + O_MKP + ((size_t)(lw * 2 + b) * 256 + m) * 512 + F.lane * 8; float* vo = F.out + O_MVP + ((size_t)(lw * 2 + b) * 256 + m) * 512 + F.lane * 8;
    __builtin_nontemporal_store(n0, (f32x4*)ko); __builtin_nontemporal_store(n1, (f32x4*)ko + 1); __builtin_nontemporal_store(v0, (f32x4*)vo); __builtin_nontemporal_store(v1, (f32x4*)vo + 1);
    const size_t bo = ((size_t)((lw * 2 + b) * 4 + head) * 256 + m) * 128 + d0;
    u32x4 kw, vw; kw.x = pk2(n0.x, n0.y); kw.y = pk2(n0.z, n0.w); kw.z = pk2(n1.x, n1.y); kw.w = pk2(n1.z, n1.w);
    vw.x = pk2(v0.x, v0.y); vw.y = pk2(v0.z, v0.w); vw.z = pk2(v1.x, v1.y); vw.w = pk2(v1.z, v1.w);
    *(u32x4*)((bf16_t*)(F.ws + WS_MEMKB) + bo) = kw; *(u32x4*)((bf16_t*)(F.ws + WS_MEMVB) + bo) = vw;
}

template <bool SAMPLE>
__device__ __forceinline__ void mem_unit(Ctx& F, int l, int un) {
    constexpr int PK = 272, VOFF = 256 * PK;
    LAS unsigned char* Kl = F.lds; LAS unsigned char* Vl = F.lds + VOFF;
    const int fr = F.lane & 15, fq = F.lane >> 4;
    int b, h, qb;
    if (SAMPLE) { b = un >> 2; h = un & 3; qb = 0; } else { qb = un & 31; h = (un >> 5) & 3; b = un >> 7; }
    const bf16_t* proj; bf16_t* mix; size_t row;
    if (SAMPLE) { proj = (const bf16_t*)(F.ws + WS_PROJS); mix = (bf16_t*)(F.ws + WS_MIXS); row = (size_t)(b * DS + (fr & 3)); }
    else { proj = (const bf16_t*)(F.ws + WS_PROJ); mix = (bf16_t*)(F.ws + WS_MIX); row = (size_t)(b * SEQ + qb * 128 + 16 * F.wave + fr); }
    const bf16_t* pr = proj + row * PN;
    u32x4 qraw[4]; u32x2 zr[8];
#pragma unroll
    for (int ks = 0; ks < 4; ++ks) qraw[ks] = *(const u32x4*)(pr + C_MQ + h * 128 + ks * 32 + fq * 8);
#pragma unroll
    for (int db = 0; db < 8; ++db) zr[db] = *(const u32x2*)(pr + C_MZ + h * 128 + 16 * db + 4 * fq);
    QTICKET(F);
    if (!SAMPLE) {
        const bf16_t* kb = (const bf16_t*)(F.ws + WS_MEMKB) + (size_t)((l * 2 + b) * 4 + h) * 256 * 128; const bf16_t* vb = (const bf16_t*)(F.ws + WS_MEMVB) + (size_t)((l * 2 + b) * 4 + h) * 256 * 128;
        u32x4 kr[8], vr[8];
#pragma unroll
        for (int i = 0; i < 8; ++i) { const int p = F.tid + 512 * i; kr[i] = *(const u32x4*)(kb + (size_t)p * 8); vr[i] = *(const u32x4*)(vb + (size_t)p * 8); }
        __syncthreads();
#pragma unroll
        for (int i = 0; i < 8; ++i) { const int p = F.tid + 512 * i, m = p >> 4, ch = p & 15; *(LAS u32x4*)(Kl + m * PK + ch * 16) = kr[i]; *(LAS u32x4*)(Vl + m * PK + ch * 16) = vr[i]; }
    } else {
        const float* ck = F.a->in[IN_CMK] + (size_t)(l * DB + b) * 256 * 512 + h * 128; const float* cv = F.a->in[IN_CMV] + (size_t)(l * DB + b) * 256 * 512 + h * 128;
        {   f32x4 kr[16], vr[16];
#pragma unroll
            for (int i = 0; i < 16; ++i) { const int p = F.tid + 512 * i, m = p >> 5, c4 = p & 31; kr[i] = __builtin_nontemporal_load((const f32x4*)(ck + (size_t)m * 512 + c4 * 4)); vr[i] = __builtin_nontemporal_load((const f32x4*)(cv + (size_t)m * 512 + c4 * 4)); }
            __syncthreads();
#pragma unroll
            for (int i = 0; i < 16; ++i) { const int p = F.tid + 512 * i, m = p >> 5, c4 = p & 31;
                u32x2 kw, vw; kw.x = pk2(kr[i].x, kr[i].y); kw.y = pk2(kr[i].z, kr[i].w); vw.x = pk2(vr[i].x, vr[i].y); vw.y = pk2(vr[i].z, vr[i].w);
                *(LAS u32x2*)(Kl + m * PK + c4 * 8) = kw; *(LAS u32x2*)(Vl + m * PK + c4 * 8) = vw; } }
    }
    bf16x8 Qf[4];
    {   const float* gq = F.a->in[IN_GMEMQ] + l * 128; float q[4][8]; float ss = 0.f;
#pragma unroll
        for (int ks = 0; ks < 4; ++ks) { unpack8(qraw[ks], q[ks]);
#pragma unroll
            for (int j = 0; j < 8; ++j) ss += q[ks][j] * q[ks][j]; }
        ss += __shfl_xor(ss, 16); ss += __shfl_xor(ss, 32);
        const float rs = rsqrtf(ss * (1.f / 128.f) + EPS) * 0.08838834764831845f;
#pragma unroll
        for (int ks = 0; ks < 4; ++ks) {
#pragma unroll
            for (int j = 0; j < 8; ++j) q[ks][j] = q[ks][j] * rs * gq[ks * 32 + fq * 8 + j];
            Qf[ks] = __builtin_bit_cast(bf16x8, pack8(q[ks])); }
    }
    __syncthreads();
    if (SAMPLE && F.wave != 0) return;
    f32x4 S[16];
#pragma unroll
    for (int kb = 0; kb < 16; ++kb) { f32x4 a = (f32x4){0.f, 0.f, 0.f, 0.f};
#pragma unroll
        for (int ks = 0; ks < 4; ++ks) { const bf16x8 kf = *(const LAS bf16x8*)(Kl + (16 * kb + fr) * PK + (ks * 32 + fq * 8) * 2); a = MFMA16(kf, Qf[ks], a); }
        S[kb] = a; }
    float m = -INFINITY;
#pragma unroll
    for (int kb = 0; kb < 16; ++kb)
#pragma unroll
        for (int i = 0; i < 4; ++i) m = fmaxf(m, S[kb][i]);
    m = fmaxf(m, __shfl_xor(m, 16)); m = fmaxf(m, __shfl_xor(m, 32));
    float sum = 0.f;
#pragma unroll
    for (int kb = 0; kb < 16; ++kb)
#pragma unroll
        for (int i = 0; i < 4; ++i) { const float ev = __expf(S[kb][i] - m); S[kb][i] = ev; sum += ev; }
    sum += __shfl_xor(sum, 16); sum += __shfl_xor(sum, 32);
    const float inv = __builtin_amdgcn_rcpf(sum);
    f32x4 o[8];
#pragma unroll
    for (int db = 0; db < 8; ++db) o[db] = (f32x4){0.f, 0.f, 0.f, 0.f};
#pragma unroll
    for (int p = 0; p < 8; ++p) { const bf16x8 Pb = pk8f(S[2 * p] * inv, S[2 * p + 1] * inv);
#pragma unroll
        for (int db = 0; db < 8; ++db) { const bf16x8 Va = cat8(tr4(Vl, PK, 32 * p + 4 * fq, 16 * db, fr), tr4(Vl, PK, 32 * p + 16 + 4 * fq, 16 * db, fr));
            o[db] = MFMA16(Va, Pb, o[db]); } }
    if (SAMPLE && fr >= 4) return;
#pragma unroll
    for (int db = 0; db < 8; ++db) { const int d = 16 * db + 4 * fq;
        u32x2 w; w.x = pk2(o[db][0] * siluf(bflo(zr[db].x)), o[db][1] * siluf(bfhi(zr[db].x))); w.y = pk2(o[db][2] * siluf(bflo(zr[db].y)), o[db][3] * siluf(bfhi(zr[db].y)));
        *(u32x2*)(mix + row * DM + 1536 + h * 128 + d) = w; }
}

template <bool SC1>
__device__ __forceinline__ void memp_unit(Ctx& F, int l, int un) {
    constexpr int PK = 272, VOFF = 256 * PK;
    LAS unsigned char* Kl = F.lds; LAS unsigned char* Vl = F.lds + VOFF;
    const int fr = F.lane & 15, fq = F.lane >> 4;
    const int qb = un & 15, h = (un >> 4) & 3, b = un >> 6;
    const bf16_t* proj = (const bf16_t*)(F.ws + WS_PROJ); bf16_t* mix = (bf16_t*)(F.ws + WS_MIX);
    const size_t row0 = (size_t)(b * SEQ + qb * 256 + 32 * F.wave + fr);
    u32x4 qraw[2][4];
#pragma unroll
    for (int qq = 0; qq < 2; ++qq)
#pragma unroll
        for (int ks = 0; ks < 4; ++ks) qraw[qq][ks] = __builtin_nontemporal_load((const u32x4*)(proj + (row0 + 16 * qq) * PN + C_MQ + h * 128 + ks * 32 + fq * 8));
    f32x4 gqv[4][2];
#pragma unroll
    for (int ks = 0; ks < 4; ++ks) { const float* gqp = F.a->in[IN_GMEMQ] + l * 128 + ks * 32 + fq * 8; gqv[ks][0] = ((const f32x4*)gqp)[0]; gqv[ks][1] = ((const f32x4*)gqp)[1]; }
    const float kn2 = F.ctlf[CW_KN2 + (l * 2 + b) * 4 + h];
    {   const bf16_t* kb = (const bf16_t*)(F.ws + WS_MEMKB) + (size_t)((l * 2 + b) * 4 + h) * 256 * 128; const bf16_t* vb = (const bf16_t*)(F.ws + WS_MEMVB) + (size_t)((l * 2 + b) * 4 + h) * 256 * 128;
        u32x4 kr[8], vr[8];
#pragma unroll
        for (int i = 0; i < 8; ++i) { const int p = F.tid + 512 * i; kr[i] = *(const u32x4*)(kb + (size_t)p * 8); vr[i] = *(const u32x4*)(vb + (size_t)p * 8); }
        QTICKET(F);
        __syncthreads();
#pragma unroll
        for (int i = 0; i < 8; ++i) { const int p = F.tid + 512 * i, m = p >> 4, ch = p & 15; *(LAS u32x4*)(Kl + m * PK + ch * 16) = kr[i]; *(LAS u32x4*)(Vl + m * PK + ch * 16) = vr[i]; }
    }
    bf16x8 Qf[2][4]; float shift[2];
    {
#pragma unroll
        for (int qq = 0; qq < 2; ++qq) { float q[4][8]; float ss = 0.f, nn = 0.f;
#pragma unroll
            for (int ks = 0; ks < 4; ++ks) { unpack8(qraw[qq][ks], q[ks]);
#pragma unroll
                for (int j = 0; j < 8; ++j) ss += q[ks][j] * q[ks][j]; }
            ss += __shfl_xor(ss, 16); ss += __shfl_xor(ss, 32);
            const float rs = rsqrtf(ss * (1.f / 128.f) + EPS) * (0.08838834764831845f * 1.4426950408889634f);
#pragma unroll
            for (int ks = 0; ks < 4; ++ks) {
#pragma unroll
                for (int j = 0; j < 8; ++j) { q[ks][j] = q[ks][j] * rs * gqv[ks][j >> 2][j & 3]; nn += q[ks][j] * q[ks][j]; }
                Qf[qq][ks] = __builtin_bit_cast(bf16x8, pack8(q[ks])); }
            nn += __shfl_xor(nn, 16); nn += __shfl_xor(nn, 32);
            shift[qq] = sqrtf(nn * kn2) * 1.01f; }
    }
    __syncthreads();
    u32x2 zr2[2][8];
#pragma unroll
    for (int qq = 0; qq < 2; ++qq)
#pragma unroll
        for (int db = 0; db < 8; ++db) zr2[qq][db] = __builtin_nontemporal_load((const u32x2*)(proj + (row0 + 16 * qq) * PN + C_MZ + h * 128 + 16 * db + 4 * fq));
    f32x4 o[2][8]; float sum[2] = {0.f, 0.f};
#pragma unroll
    for (int qq = 0; qq < 2; ++qq)
#pragma unroll
        for (int db = 0; db < 8; ++db) o[qq][db] = (f32x4){0.f, 0.f, 0.f, 0.f};
#pragma unroll 2
    for (int p = 0; p < 8; ++p) {
        f32x4 S[2][2];
#pragma unroll
        for (int kk = 0; kk < 2; ++kk) { f32x4 a0 = (f32x4){0.f, 0.f, 0.f, 0.f}, a1 = a0;
#pragma unroll
            for (int ks = 0; ks < 4; ++ks) { const bf16x8 kf = *(const LAS bf16x8*)(Kl + (16 * (2 * p + kk) + fr) * PK + (ks * 32 + fq * 8) * 2); a0 = MFMA16(kf, Qf[0][ks], a0); a1 = MFMA16(kf, Qf[1][ks], a1); }
            S[0][kk] = a0; S[1][kk] = a1; }
        bf16x8 Pb[2];
#pragma unroll
        for (int qq = 0; qq < 2; ++qq) {
#pragma unroll
            for (int kk = 0; kk < 2; ++kk)
#pragma unroll
                for (int i = 0; i < 4; ++i) { const float ev = __builtin_amdgcn_exp2f(S[qq][kk][i] - shift[qq]); S[qq][kk][i] = ev; sum[qq] += ev; }
            Pb[qq] = pk8f(S[qq][0], S[qq][1]); }
#pragma unroll
        for (int db = 0; db < 8; ++db) { const bf16x8 Va = cat8(tr4(Vl, PK, 32 * p + 4 * fq, 16 * db, fr), tr4(Vl, PK, 32 * p + 16 + 4 * fq, 16 * db, fr));
            o[0][db] = MFMA16(Va, Pb[0], o[0][db]); o[1][db] = MFMA16(Va, Pb[1], o[1][db]); }
    }
#pragma unroll
    for (int qq = 0; qq < 2; ++qq) { float sm = sum[qq]; sm += __shfl_xor(sm, 16); sm += __shfl_xor(sm, 32); const float inv = __builtin_amdgcn_rcpf(sm);
        const size_t row = row0 + 16 * qq; unsigned long long wq[4];
#pragma unroll
        for (int db = 0; db < 8; ++db) { const int d = 16 * db + 4 * fq; const u32x2 z = zr2[qq][db];
            u32x2 w; w.x = pk2(o[qq][db][0] * inv * siluf(bflo(z.x)), o[qq][db][1] * inv * siluf(bfhi(z.x))); w.y = pk2(o[qq][db][2] * inv * siluf(bflo(z.y)), o[qq][db][3] * inv * siluf(bfhi(z.y)));
            if (!SC1) *(u32x2*)(mix + row * DM + 1536 + h * 128 + d) = w;
            else { wq[db & 3] = (unsigned long long)w.x | ((unsigned long long)w.y << 32);
                if ((db & 3) == 3) { const bool odd = (fq & 1) != 0; u32x4 o0, o1; pair16(wq, odd, o0, o1);
                    bf16_t* mp = mix + row * DM + 1536 + h * 128 + 16 * ((db & 4) + (odd ? 1 : 0)) + 4 * (fq & ~1); st16_sc1u(mp, o0); st16_sc1u(mp + 32, o1); } } } }
}

constexpr int GL_CUM = 0, GL_TOT = 16384, GL_GA = 16640, GL_SEG = 20736, GL_A = 24576;
struct GlaPar { float wu[16]; float bias; u32x4 garaw; };
__device__ __forceinline__ void gla_par_load(Ctx& F, int l, int h, const bf16_t* prow0, GlaPar& P) {
    const int dk = F.tid & 63;
    const float* wup = F.a->in[IN_WUP] + (size_t)l * 16 * 256 + h * 64 + dk; const float* bap = F.a->in[IN_BA] + l * 256 + h * 64 + dk;
#pragma unroll
    for (int r = 0; r < 16; ++r) P.wu[r] = wup[r * 256];
    P.bias = bap[0];
    const int t = F.tid & 127; P.garaw = *(const u32x4*)(prow0 + (size_t)(t >> 1) * PN + C_GA + (t & 1) * 8);
}
__device__ __forceinline__ void gla_cum(Ctx& F, const GlaPar& P) {
    LAS float* cumL = (LAS float*)(F.lds + GL_CUM); LAS float* totL = (LAS float*)(F.lds + GL_TOT); LAS float* gaL = (LAS float*)(F.lds + GL_GA); LAS float* segL = (LAS float*)(F.lds + GL_SEG);
    if (F.tid < 128) { const int s = F.tid >> 1, hf = F.tid & 1; float g[8]; unpack8(P.garaw, g);
#pragma unroll
        for (int j = 0; j < 8; ++j) gaL[s * 16 + hf * 8 + j] = g[j]; }
    const int dk = F.tid & 63, sg = F.tid >> 6;
    const float* wu = P.wu; const float bias = P.bias;
    __syncthreads();
    float c[8]; float run = 0.f;
#pragma unroll
    for (int i = 0; i < 8; ++i) { const int s = sg * 8 + i; float x = bias;
#pragma unroll
        for (int r = 0; r < 16; ++r) x += gaL[s * 16 + r] * wu[r];
        run += logsigf(x) * (1.f / 16.f); c[i] = run; }
    segL[sg * 64 + dk] = run;
    __syncthreads();
    float off = 0.f, tot = 0.f;
#pragma unroll
    for (int s2 = 0; s2 < 8; ++s2) { const float v = segL[s2 * 64 + dk]; tot += v; if (s2 < sg) off += v; }
#pragma unroll
    for (int i = 0; i < 8; ++i) cumL[(sg * 8 + i) * 64 + dk] = off + c[i];
    if (sg == 0) totL[dk] = tot;
    __syncthreads();
}
__device__ __forceinline__ void glaA_unit(Ctx& F, int l, int un) {
    constexpr int PKT = 144, PV = 272, KT = GL_A, VL = GL_A + 64 * PKT;
    const bf16_t* proj = (const bf16_t*)(F.ws + WS_PROJ);
    const int c = un & 63, h = (un >> 6) & 3, b = un >> 8, fr = F.lane & 15, fq = F.lane >> 4;
    const bf16_t* prow0 = proj + (size_t)(b * SEQ + c * 64) * PN;
    LAS float* cumL = (LAS float*)(F.lds + GL_CUM); LAS float* totL = (LAS float*)(F.lds + GL_TOT);
    const int s = F.tid >> 3, ch = F.tid & 7;
    const u32x4 kraw = *(const u32x4*)(prow0 + (size_t)s * PN + C_GK + h * 64 + ch * 8);
    u32x4 vraw[2];
#pragma unroll
    for (int i = 0; i < 2; ++i) { const int p = F.tid + 512 * i, s2 = p >> 4, c2 = p & 15; vraw[i] = *(const u32x4*)(prow0 + (size_t)s2 * PN + C_GV + h * 128 + c2 * 8); }
    GlaPar GP; gla_par_load(F, l, h, prow0, GP);
    QTICKET(F);
    __syncthreads();
    gla_cum(F, GP);
    {   float k[8]; unpack8(kraw, k);
        const f32x4 c0 = *(const LAS f32x4*)(cumL + s * 64 + ch * 8), c1 = *(const LAS f32x4*)(cumL + s * 64 + ch * 8 + 4);
        float* cg = (float*)(F.ws + WS_GLACUM) + (size_t)un * 4096 + s * 64 + ch * 8; *(f32x4*)cg = c0; *(f32x4*)(cg + 4) = c1;
        const float cm[8] = {c0.x, c0.y, c0.z, c0.w, c1.x, c1.y, c1.z, c1.w};
#pragma unroll
        for (int j = 0; j < 8; ++j) k[j] *= __expf(totL[ch * 8 + j] - cm[j]);
        *(LAS u32x4*)(F.lds + KT + s * PKT + ch * 16) = pack8(k);
#pragma unroll
        for (int i = 0; i < 2; ++i) { const int p = F.tid + 512 * i, s2 = p >> 4, c2 = p & 15; *(LAS u32x4*)(F.lds + VL + s2 * PV + c2 * 16) = vraw[i]; }
    }
    __syncthreads();
    f32x4 acc[4];
#pragma unroll
    for (int db = 0; db < 4; ++db) acc[db] = (f32x4){0.f, 0.f, 0.f, 0.f};
#pragma unroll
    for (int ks = 0; ks < 2; ++ks) { const bf16x8 Bv = cat8(tr4(F.lds + VL, PV, 32 * ks + 8 * fq, 16 * F.wave, fr), tr4(F.lds + VL, PV, 32 * ks + 8 * fq + 4, 16 * F.wave, fr));
#pragma unroll
        for (int db = 0; db < 4; ++db) { const bf16x8 Ak = cat8(tr4(F.lds + KT, PKT, 32 * ks + 8 * fq, 16 * db, fr), tr4(F.lds + KT, PKT, 32 * ks + 8 * fq + 4, 16 * db, fr));
            acc[db] = MFMA16(Bv, Ak, acc[db]); } }
    bf16_t* kv = (bf16_t*)(F.ws + WS_GLAKV) + (size_t)un * 8192;
    {   unsigned long long w[4];
#pragma unroll
        for (int db = 0; db < 4; ++db) w[db] = (unsigned long long)pk2(acc[db][0], acc[db][1]) | ((unsigned long long)pk2(acc[db][2], acc[db][3]) << 32);
        const bool odd = (fq & 1) != 0; u32x4 o0, o1; pair16(w, odd, o0, o1);
        bf16_t* kp = kv + (16 * (odd ? 1 : 0) + fr) * 128 + 16 * F.wave + 4 * (fq & ~1);
        st16_sc1u(kp, o0); st16_sc1u(kp + 32 * 128, o1); }
    if (F.tid < 64) __hip_atomic_store((float*)(F.ws + WS_GLADEC) + un * 64 + F.tid, __expf(totL[F.tid]), RLX_AGENT);
}
constexpr int GL2 = 51200;
__device__ __forceinline__ void glaA2_unit(Ctx& F, int l, int un2) {
    constexpr int PKT = 144, PV = 272, KT = GL_A, VL = GL_A + 64 * PKT;
    const bf16_t* proj = (const bf16_t*)(F.ws + WS_PROJ);
    const int cc = un2 & 31, h = (un2 >> 5) & 3, b = un2 >> 7, fr = F.lane & 15, fq = F.lane >> 4;
    const int s = F.tid >> 3, ch = F.tid & 7, dk = F.tid & 63, sg = F.tid >> 6;
    u32x4 kraw[2], vraw[2][2], garaw[2]; float wu[16], bias;
#pragma unroll
    for (int j = 0; j < 2; ++j) { const bf16_t* prow0 = proj + (size_t)(b * SEQ + (2 * cc + j) * 64) * PN;
        kraw[j] = *(const u32x4*)(prow0 + (size_t)s * PN + C_GK + h * 64 + ch * 8);
#pragma unroll
        for (int i = 0; i < 2; ++i) { const int p = F.tid + 512 * i, s2 = p >> 4, c2 = p & 15; vraw[j][i] = *(const u32x4*)(prow0 + (size_t)s2 * PN + C_GV + h * 128 + c2 * 8); }
        const int t = F.tid & 127; garaw[j] = *(const u32x4*)(prow0 + (size_t)(t >> 1) * PN + C_GA + (t & 1) * 8); }
    {   const float* wup = F.a->in[IN_WUP] + (size_t)l * 16 * 256 + h * 64 + dk; const float* bap = F.a->in[IN_BA] + l * 256 + h * 64 + dk;
#pragma unroll
        for (int r = 0; r < 16; ++r) wu[r] = wup[r * 256];
        bias = bap[0]; }
    QTICKET(F);
    if (F.tid < 256) { const int j = F.tid >> 7, t = F.tid & 127, s_ = t >> 1, hf = t & 1; float g[8]; unpack8(j == 0 ? garaw[0] : garaw[1], g); LAS float* gaL = (LAS float*)(F.lds + j * GL2 + GL_GA);
#pragma unroll
        for (int q = 0; q < 8; ++q) gaL[s_ * 16 + hf * 8 + q] = g[q]; }
    __syncthreads();
    float cp[2][8];
#pragma unroll
    for (int j = 0; j < 2; ++j) { const LAS float* gaL = (const LAS float*)(F.lds + j * GL2 + GL_GA); LAS float* segL = (LAS float*)(F.lds + j * GL2 + GL_SEG); float run = 0.f;
#pragma unroll
        for (int i = 0; i < 8; ++i) { const int s_ = sg * 8 + i; float x = bias;
#pragma unroll
            for (int r = 0; r < 16; ++r) x += gaL[s_ * 16 + r] * wu[r];
            run += logsigf(x) * (1.f / 16.f); cp[j][i] = run; }
        segL[sg * 64 + dk] = run; }
    __syncthreads();
#pragma unroll
    for (int j = 0; j < 2; ++j) { const LAS float* segL = (const LAS float*)(F.lds + j * GL2 + GL_SEG); LAS float* cumL = (LAS float*)(F.lds + j * GL2 + GL_CUM); LAS float* totL = (LAS float*)(F.lds + j * GL2 + GL_TOT);
        float off = 0.f, tot = 0.f;
#pragma unroll
        for (int s2 = 0; s2 < 8; ++s2) { const float v = segL[s2 * 64 + dk]; tot += v; if (s2 < sg) off += v; }
#pragma unroll
        for (int i = 0; i < 8; ++i) cumL[(sg * 8 + i) * 64 + dk] = off + cp[j][i];
        if (sg == 0) totL[dk] = tot; }
    __syncthreads();
#pragma unroll
    for (int j = 0; j < 2; ++j) { const int un = (b * 4 + h) * 64 + 2 * cc + j; LAS unsigned char* L = F.lds + j * GL2; const LAS float* cumL = (const LAS float*)(L + GL_CUM); const LAS float* totL = (const LAS float*)(L + GL_TOT);
        float k[8]; unpack8(kraw[j], k);
        const f32x4 c0 = *(const LAS f32x4*)(cumL + s * 64 + ch * 8), c1 = *(const LAS f32x4*)(cumL + s * 64 + ch * 8 + 4);
        float* cg = (float*)(F.ws + WS_GLACUM) + (size_t)un * 4096 + s * 64 + ch * 8; *(f32x4*)cg = c0; *(f32x4*)(cg + 4) = c1;
        const float cm[8] = {c0.x, c0.y, c0.z, c0.w, c1.x, c1.y, c1.z, c1.w};
#pragma unroll
        for (int q = 0; q < 8; ++q) k[q] *= __expf(totL[ch * 8 + q] - cm[q]);
        *(LAS u32x4*)(L + KT + s * PKT + ch * 16) = pack8(k);
#pragma unroll
        for (int i = 0; i < 2; ++i) { const int p = F.tid + 512 * i, s2 = p >> 4, c2 = p & 15; *(LAS u32x4*)(L + VL + s2 * PV + c2 * 16) = vraw[j][i]; } }
    __syncthreads();
#pragma unroll
    for (int j = 0; j < 2; ++j) { const int un = (b * 4 + h) * 64 + 2 * cc + j; LAS unsigned char* L = F.lds + j * GL2;
        f32x4 acc[4];
#pragma unroll
        for (int db = 0; db < 4; ++db) acc[db] = (f32x4){0.f, 0.f, 0.f, 0.f};
#pragma unroll
        for (int ks = 0; ks < 2; ++ks) { const bf16x8 Bv = cat8(tr4(L + VL, PV, 32 * ks + 8 * fq, 16 * F.wave, fr), tr4(L + VL, PV, 32 * ks + 8 * fq + 4, 16 * F.wave, fr));
#pragma unroll
            for (int db = 0; db < 4; ++db) { const bf16x8 Ak = cat8(tr4(L + KT, PKT, 32 * ks + 8 * fq, 16 * db, fr), tr4(L + KT, PKT, 32 * ks + 8 * fq + 4, 16 * db, fr));
                acc[db] = MFMA16(Bv, Ak, acc[db]); } }
        bf16_t* kv = (bf16_t*)(F.ws + WS_GLAKV) + (size_t)un * 8192;
        unsigned long long w[4];
#pragma unroll
        for (int db = 0; db < 4; ++db) w[db] = (unsigned long long)pk2(acc[db][0], acc[db][1]) | ((unsigned long long)pk2(acc[db][2], acc[db][3]) << 32);
        const bool odd = (fq & 1) != 0; u32x4 o0, o1; pair16(w, odd, o0, o1);
        bf16_t* kp = kv + (16 * (odd ? 1 : 0) + fr) * 128 + 16 * F.wave + 4 * (fq & ~1);
        st16_sc1u(kp, o0); st16_sc1u(kp + 32 * 128, o1); }
    if (F.tid < 128) { const int j = F.tid >> 6, d_ = F.tid & 63; const LAS float* totL = (const LAS float*)(F.lds + j * GL2 + GL_TOT);
        __hip_atomic_store((float*)(F.ws + WS_GLADEC) + ((b * 4 + h) * 64 + 2 * cc + j) * 64 + d_, __expf(totL[d_]), RLX_AGENT); }
}
__device__ __forceinline__ void gla_scan_item(Ctx& F, int l, int si) {
    const int gid = si * 512 + F.tid, bh = gid >> 13, d = (gid >> 7) & 63, v = gid & 127;
    const bf16_t* kv = (const bf16_t*)(F.ws + WS_GLAKV) + (size_t)bh * 64 * 8192 + d * 128 + v;
    const float* dec = (const float*)(F.ws + WS_GLADEC) + (size_t)bh * 64 * 64 + d;
    bf16_t* st = (bf16_t*)(F.ws + WS_GLAST) + (size_t)bh * 64 * 8192 + d * 128 + v;
    float S = 0.f;
    unsigned short kr[64]; float dd[64];
#pragma unroll
    for (int i = 0; i < 64; ++i) { kr[i] = __builtin_nontemporal_load(kv + (size_t)i * 8192); dd[i] = dec[i * 64]; }
    QTICKET(F);
#pragma unroll
    for (int i = 0; i < 64; ++i) { st[(size_t)i * 8192] = (bf16_t)f2bf(S); S = dd[i] * S + bf1(kr[i]); }
    __builtin_nontemporal_store(S, F.out + O_GLAP + ((size_t)(l * 8 + bh) * 64 + d) * 128 + v);
}
__device__ __forceinline__ void glaC_unit(Ctx& F, int l, int un) {
    constexpr int PQ = 144, PV = 272, QD = GL_A, KD = QD + 64 * PQ, VL = KD + 64 * PQ, SL = VL + 64 * PV, SSX = SL + 64 * PV;
    const bf16_t* proj = (const bf16_t*)(F.ws + WS_PROJ); bf16_t* mix = (bf16_t*)(F.ws + WS_MIX);
    const int c = un & 63, h = (un >> 6) & 3, b = un >> 8, fr = F.lane & 15, fq = F.lane >> 4;
    const bf16_t* prow0 = proj + (size_t)(b * SEQ + c * 64) * PN;
    LAS float* cumL = (LAS float*)(F.lds + GL_CUM);
    const int tb = F.wave & 3, vh = F.wave >> 2;
    const size_t row = (size_t)(b * SEQ + c * 64 + 16 * tb + fr);
    const int s = F.tid >> 3, ch = F.tid & 7;
    const u32x4 qraw = __builtin_nontemporal_load((const u32x4*)(prow0 + (size_t)s * PN + C_GQ + h * 64 + ch * 8)), kraw = __builtin_nontemporal_load((const u32x4*)(prow0 + (size_t)s * PN + C_GK + h * 64 + ch * 8));
    u32x4 vraw[2], sraw[2]; u32x2 zr[4]; f32x4 cmr[2];
    {   const float* cg = (const float*)(F.ws + WS_GLACUM) + (size_t)un * 4096 + s * 64 + ch * 8; cmr[0] = __builtin_nontemporal_load((const f32x4*)cg); cmr[1] = __builtin_nontemporal_load((const f32x4*)(cg + 4)); }
    {   const bf16_t* st = (const bf16_t*)(F.ws + WS_GLAST) + (size_t)un * 8192;
#pragma unroll
        for (int i = 0; i < 2; ++i) { const int p = F.tid + 512 * i, s2 = p >> 4, c2 = p & 15;
            vraw[i] = __builtin_nontemporal_load((const u32x4*)(prow0 + (size_t)s2 * PN + C_GV + h * 128 + c2 * 8)); sraw[i] = __builtin_nontemporal_load((const u32x4*)(st + s2 * 128 + c2 * 8)); }
#pragma unroll
        for (int vb = 0; vb < 4; ++vb) zr[vb] = __builtin_nontemporal_load((const u32x2*)(proj + row * PN + C_GZ + h * 128 + 16 * (4 * vh + vb) + 4 * fq));
    }
    f32x4 gov[4];
    const float* gop = F.a->in[IN_GGLAO] + l * 128 + 64 * vh + 4 * fq;
#pragma unroll
    for (int vb = 0; vb < 4; ++vb) gov[vb] = *(const f32x4*)(gop + 16 * vb);
    QTICKET(F);
    __syncthreads();
    {   float q[8], k[8]; unpack8(qraw, q); unpack8(kraw, k);
        const float cmv[8] = {cmr[0].x, cmr[0].y, cmr[0].z, cmr[0].w, cmr[1].x, cmr[1].y, cmr[1].z, cmr[1].w};
#pragma unroll
        for (int j = 0; j < 8; ++j) { const float cm = cmv[j]; q[j] *= 0.125f * __expf(cm); k[j] *= __expf(-cm); }
        *(LAS u32x4*)(F.lds + QD + s * PQ + ch * 16) = pack8(q); *(LAS u32x4*)(F.lds + KD + s * PQ + ch * 16) = pack8(k);
#pragma unroll
        for (int i = 0; i < 2; ++i) { const int p = F.tid + 512 * i, s2 = p >> 4, c2 = p & 15;
            *(LAS u32x4*)(F.lds + VL + s2 * PV + c2 * 16) = vraw[i]; *(LAS u32x4*)(F.lds + SL + s2 * PV + c2 * 16) = sraw[i]; }
    }
    __syncthreads();
    bf16x8 Qf[2];
#pragma unroll
    for (int ks = 0; ks < 2; ++ks) Qf[ks] = *(const LAS bf16x8*)(F.lds + QD + (16 * tb + fr) * PQ + (ks * 32 + fq * 8) * 2);
    f32x4 P[4];
#pragma unroll
    for (int sb = 0; sb < 4; ++sb) { f32x4 a = (f32x4){0.f, 0.f, 0.f, 0.f};
        if (sb <= tb) {
#pragma unroll
            for (int ks = 0; ks < 2; ++ks) { const bf16x8 kf = *(const LAS bf16x8*)(F.lds + KD + (16 * sb + fr) * PQ + (ks * 32 + fq * 8) * 2); a = MFMA16(kf, Qf[ks], a); }
            if (sb == tb) {
#pragma unroll
                for (int i = 0; i < 4; ++i) if (4 * fq + i > fr) a[i] = 0.f; } }
        P[sb] = a; }
    f32x4 o[4];
#pragma unroll
    for (int vb = 0; vb < 4; ++vb) o[vb] = (f32x4){0.f, 0.f, 0.f, 0.f};
#pragma unroll
    for (int p = 0; p < 2; ++p) {
        if (2 * p <= tb) { const bf16x8 Pb = pk8f(P[2 * p], P[2 * p + 1]);
#pragma unroll
            for (int vb = 0; vb < 4; ++vb) { const int v0 = 16 * (4 * vh + vb);
                const bf16x8 Va = cat8(tr4(F.lds + VL, PV, 32 * p + 4 * fq, v0, fr), tr4(F.lds + VL, PV, 32 * p + 16 + 4 * fq, v0, fr)); o[vb] = MFMA16(Va, Pb, o[vb]); } } }
#pragma unroll
    for (int ks = 0; ks < 2; ++ks)
#pragma unroll
        for (int vb = 0; vb < 4; ++vb) { const int v0 = 16 * (4 * vh + vb);
            const bf16x8 Sa = cat8(tr4(F.lds + SL, PV, 32 * ks + 8 * fq, v0, fr), tr4(F.lds + SL, PV, 32 * ks + 8 * fq + 4, v0, fr)); o[vb] = MFMA16(Sa, Qf[ks], o[vb]); }
    float ss = 0.f;
#pragma unroll
    for (int vb = 0; vb < 4; ++vb)
#pragma unroll
        for (int i = 0; i < 4; ++i) ss += o[vb][i] * o[vb][i];
    ss += __shfl_xor(ss, 16); ss += __shfl_xor(ss, 32);
    LAS float* ssx = (LAS float*)(F.lds + SSX);
    if (fq == 0) ssx[vh * 64 + 16 * tb + fr] = ss;
    __syncthreads();
    const float tot = ssx[16 * tb + fr] + ssx[64 + 16 * tb + fr];
    const float rs = rsqrtf(tot * (1.f / 128.f) + EPS);
    unsigned long long wq[4];
#pragma unroll
    for (int vb = 0; vb < 4; ++vb) { const f32x4 g = gov[vb];
        wq[vb] = (unsigned long long)pk2(o[vb][0] * rs * g[0] * siluf(bflo(zr[vb].x)), o[vb][1] * rs * g[1] * siluf(bfhi(zr[vb].x)))
               | ((unsigned long long)pk2(o[vb][2] * rs * g[2] * siluf(bflo(zr[vb].y)), o[vb][3] * rs * g[3] * siluf(bfhi(zr[vb].y))) << 32); }
    {   const bool odd = (fq & 1) != 0; u32x4 o0, o1; pair16(wq, odd, o0, o1);
        bf16_t* mp = mix + row * DM + 512 + h * 128 + 16 * (4 * vh + (odd ? 1 : 0)) + 4 * (fq & ~1); st16_sc1u(mp, o0); st16_sc1u(mp + 32, o1); }
}
__device__ __forceinline__ void sgla_unit(Ctx& F, int l, int un) {
    const int b = un >> 2, h = un & 3;
    const bf16_t* projs = (const bf16_t*)(F.ws + WS_PROJS); bf16_t* mixs = (bf16_t*)(F.ws + WS_MIXS);
    float S[16];
    {   const int v_ = F.tid & 127, dg_ = F.tid >> 7; const float* s0_ = F.a->in[IN_SGLA] + ((size_t)((l * DB + b) * 4 + h) * 64 + 16 * dg_) * 128 + v_;
#pragma unroll
        for (int i = 0; i < 16; ++i) S[i] = __builtin_nontemporal_load(s0_ + i * 128); }
    const bf16_t vraw = projs[(size_t)(b * DS + (F.tid >> 7)) * PN + C_GV + h * 128 + (F.tid & 127)];
    const int t4 = (F.tid >> 6) & 3, dk4 = F.tid & 63;
    const bf16_t* pr4 = projs + (size_t)(b * DS + t4) * PN;
    const float* wup = F.a->in[IN_WUP] + (size_t)l * 16 * 256 + h * 64 + dk4; const float bias = F.a->in[IN_BA][l * 256 + h * 64 + dk4];
    const u32x4 g0 = *(const u32x4*)(pr4 + C_GA), g1 = *(const u32x4*)(pr4 + C_GA + 8);
    float wv[16];
#pragma unroll
    for (int r = 0; r < 16; ++r) wv[r] = wup[r * 256];
    const bf16_t qraw = pr4[C_GQ + h * 64 + dk4], kraw = pr4[C_GK + h * 64 + dk4];
    const float* go = F.a->in[IN_GGLAO] + l * 128; const float go0 = go[F.lane], go1 = go[64 + F.lane];
    const bf16_t z0 = pr4[C_GZ + h * 128 + F.lane], z1 = pr4[C_GZ + h * 128 + 64 + F.lane];
    QTICKET(F);
    LAS float* aL = (LAS float*)F.lds; LAS float* qL = aL + 256; LAS float* kL = qL + 256; LAS float* vL = kL + 256; LAS float* part = vL + 512; LAS float* oL = part + 512;
    {   const int t = F.tid >> 7, v = F.tid & 127; vL[t * 128 + v] = bf1(vraw); }
    if (F.tid < 256) { float gaf[16]; unpack8(g0, gaf); unpack8(g1, gaf + 8); float x = bias;
#pragma unroll
        for (int r = 0; r < 16; ++r) x += gaf[r] * wv[r];
        aL[t4 * 64 + dk4] = __expf(logsigf(x) * (1.f / 16.f)); qL[t4 * 64 + dk4] = bf1(qraw) * 0.125f; kL[t4 * 64 + dk4] = bf1(kraw); }
    __syncthreads();
    const int v = F.tid & 127, dg = F.tid >> 7;
    for (int t = 0; t < 4; ++t) { float po = 0.f; const float vv = vL[t * 128 + v];
#pragma unroll
        for (int i = 0; i < 16; ++i) { const int dk = 16 * dg + i; S[i] = aL[t * 64 + dk] * S[i] + kL[t * 64 + dk] * vv; po += qL[t * 64 + dk] * S[i]; }
        part[dg * 128 + v] = po;
        __syncthreads();
        if (dg == 0) oL[t * 128 + v] = (part[v] + part[128 + v]) + (part[256 + v] + part[384 + v]);
        __syncthreads(); }
    float* so = F.out + O_GLAS + ((size_t)((l * DB + b) * 4 + h) * 64 + 16 * dg) * 128 + v;
#pragma unroll
    for (int i = 0; i < 16; ++i) __builtin_nontemporal_store(S[i], so + i * 128);
    if (F.wave < 4) { const int t = F.wave; const float o0 = oL[t * 128 + F.lane], o1 = oL[t * 128 + 64 + F.lane];
        const float ss = wave_sum(o0 * o0 + o1 * o1); const float rs = rsqrtf(ss * (1.f / 128.f) + EPS);
        const size_t row = (size_t)(b * DS + t);
        mixs[row * DM + 512 + h * 128 + F.lane] = (bf16_t)f2bf(o0 * rs * go0 * siluf(bf1(z0)));
        mixs[row * DM + 512 + h * 128 + 64 + F.lane] = (bf16_t)f2bf(o1 * rs * go1 * siluf(bf1(z1))); }
}
__device__ __forceinline__ void sswa_unit(Ctx& F, int l, int un) {
    constexpr int PK = 144, VOFF = 160 * PK;
    const int b = un >> 1, kvh = un & 1, fr = F.lane & 15, fq = F.lane >> 4;
    const bf16_t* projs = (const bf16_t*)(F.ws + WS_PROJS); bf16_t* mixs = (bf16_t*)(F.ws + WS_MIXS);
    LAS unsigned char* Kl = F.lds; LAS unsigned char* Vl = F.lds + VOFF;
    const int ch = F.tid & 7;
    f32x4 ca[2][4];
#pragma unroll
    for (int r = 0; r < 2; ++r) { const int j = (F.tid + 512 * r) >> 3;
        const float* ck = F.a->in[IN_CSWK] + ((size_t)((l * DB + b) * 128 + j) * 2 + kvh) * 64 + ch * 8; const float* cv = F.a->in[IN_CSWV] + ((size_t)((l * DB + b) * 128 + j) * 2 + kvh) * 64 + ch * 8;
        ca[r][0] = __builtin_nontemporal_load((const f32x4*)ck); ca[r][1] = __builtin_nontemporal_load((const f32x4*)ck + 1); ca[r][2] = __builtin_nontemporal_load((const f32x4*)cv); ca[r][3] = __builtin_nontemporal_load((const f32x4*)cv + 1); }
    u32x4 nk = (u32x4){0u, 0u, 0u, 0u}, nv = nk;
    if (F.tid < 32) { const bf16_t* pr2 = projs + (size_t)(b * DS + (F.tid >> 3)) * PN; nk = *(const u32x4*)(pr2 + C_SK + kvh * 64 + ch * 8); nv = *(const u32x4*)(pr2 + C_SV + kvh * 64 + ch * 8); }
    float gkv[8];
    {   const float* gk = F.a->in[IN_GSWK] + l * 64;
#pragma unroll
        for (int q = 0; q < 8; ++q) gkv[q] = gk[ch * 8 + q]; }
    QTICKET(F);
#pragma unroll
    for (int r = 0; r < 3; ++r) { const int j = (F.tid + 512 * r) >> 3;
        float k[8], v[8];
        if (r < 2) { const f32x4 a0 = ca[r < 2 ? r : 0][0], a1 = ca[r < 2 ? r : 0][1], b0 = ca[r < 2 ? r : 0][2], b1 = ca[r < 2 ? r : 0][3];
            k[0] = a0.x; k[1] = a0.y; k[2] = a0.z; k[3] = a0.w; k[4] = a1.x; k[5] = a1.y; k[6] = a1.z; k[7] = a1.w;
            v[0] = b0.x; v[1] = b0.y; v[2] = b0.z; v[3] = b0.w; v[4] = b1.x; v[5] = b1.y; v[6] = b1.z; v[7] = b1.w; }
        else { unpack8(nk, k); unpack8(nv, v); }
        float ss = 0.f;
#pragma unroll
        for (int q = 0; q < 8; ++q) ss += k[q] * k[q];
        ss += __shfl_xor(ss, 1); ss += __shfl_xor(ss, 2); ss += __shfl_xor(ss, 4);
        if (j >= 128) { const float rs = rsqrtf(ss * (1.f / 64.f) + EPS);
#pragma unroll
            for (int q = 0; q < 8; ++q) k[q] = k[q] * rs * gkv[q]; }
        if (j < 160) { *(LAS u32x4*)(Kl + j * PK + ch * 16) = pack8(k); *(LAS u32x4*)(Vl + j * PK + ch * 16) = pack8(v); }
        if (j >= 4 && j < 132) { const size_t o = ((size_t)((l * DB + b) * 128 + (j - 4)) * 2 + kvh) * 64 + ch * 8;
            f32x4 t0 = {k[0], k[1], k[2], k[3]}, t1 = {k[4], k[5], k[6], k[7]}, t2 = {v[0], v[1], v[2], v[3]}, t3 = {v[4], v[5], v[6], v[7]};
            __builtin_nontemporal_store(t0, (f32x4*)(F.out + O_SWKS + o)); __builtin_nontemporal_store(t1, (f32x4*)(F.out + O_SWKS + o + 4)); __builtin_nontemporal_store(t2, (f32x4*)(F.out + O_SWVS + o)); __builtin_nontemporal_store(t3, (f32x4*)(F.out + O_SWVS + o + 4)); }
    }
    __syncthreads();
    if (F.wave != 0) return;
    const int t = fr & 3, h = kvh * 4 + (fr >> 2); const size_t row = (size_t)(b * DS + t); const bf16_t* pr = projs + row * PN;
    bf16x8 Qf[2];
    {   const float* gq = F.a->in[IN_GSWQ] + l * 64; float q[2][8]; float ss = 0.f;
#pragma unroll
        for (int ks = 0; ks < 2; ++ks) { unpack8(*(const u32x4*)(pr + C_SQ + h * 64 + ks * 32 + fq * 8), q[ks]);
#pragma unroll
            for (int j = 0; j < 8; ++j) ss += q[ks][j] * q[ks][j]; }
        ss += __shfl_xor(ss, 16); ss += __shfl_xor(ss, 32);
        const float rs = rsqrtf(ss * (1.f / 64.f) + EPS) * 0.125f;
#pragma unroll
        for (int ks = 0; ks < 2; ++ks) {
#pragma unroll
            for (int j = 0; j < 8; ++j) q[ks][j] = q[ks][j] * rs * gq[ks * 32 + fq * 8 + j];
            Qf[ks] = __builtin_bit_cast(bf16x8, pack8(q[ks])); }
    }
    f32x4 S[10];
#pragma unroll
    for (int kb = 0; kb < 10; ++kb) { f32x4 a = (f32x4){0.f, 0.f, 0.f, 0.f};
#pragma unroll
        for (int ks = 0; ks < 2; ++ks) { const bf16x8 kf = *(const LAS bf16x8*)(Kl + (16 * kb + fr) * PK + (ks * 32 + fq * 8) * 2); a = MFMA16(kf, Qf[ks], a); }
        S[kb] = a; }
    const float sink = F.a->in[IN_SINKS][l * 8 + h];
    float m = sink;
#pragma unroll
    for (int kb = 0; kb < 10; ++kb)
#pragma unroll
        for (int i = 0; i < 4; ++i) { const int kj = 16 * kb + 4 * fq + i; const bool valid = (kj >= t + 1) && (kj <= t + 128);
            if (!valid) S[kb][i] = -INFINITY; m = fmaxf(m, S[kb][i]); }
    m = fmaxf(m, __shfl_xor(m, 16)); m = fmaxf(m, __shfl_xor(m, 32));
    float sum = 0.f;
#pragma unroll
    for (int kb = 0; kb < 10; ++kb)
#pragma unroll
        for (int i = 0; i < 4; ++i) { const float ev = __expf(S[kb][i] - m); S[kb][i] = ev; sum += ev; }
    sum += __shfl_xor(sum, 16); sum += __shfl_xor(sum, 32);
    sum += __expf(sink - m);
    const float inv = __builtin_amdgcn_rcpf(sum);
    f32x4 o[4];
#pragma unroll
    for (int db = 0; db < 4; ++db) o[db] = (f32x4){0.f, 0.f, 0.f, 0.f};
#pragma unroll
    for (int p = 0; p < 5; ++p) { const bf16x8 Pb = pk8f(S[2 * p] * inv, S[2 * p + 1] * inv);
#pragma unroll
        for (int db = 0; db < 4; ++db) { const bf16x8 Va = cat8(tr4(Vl, PK, 32 * p + 4 * fq, 16 * db, fr), tr4(Vl, PK, 32 * p + 16 + 4 * fq, 16 * db, fr)); o[db] = MFMA16(Va, Pb, o[db]); } }
#pragma unroll
    for (int db = 0; db < 4; ++db) { const int d = 16 * db + 4 * fq; const u32x2 zr = *(const u32x2*)(pr + C_SZ + h * 64 + d);
        u32x2 w; w.x = pk2(o[db][0] * siluf(bflo(zr.x)), o[db][1] * siluf(bfhi(zr.x))); w.y = pk2(o[db][2] * siluf(bflo(zr.y)), o[db][3] * siluf(bfhi(zr.y)));
        *(u32x2*)(mixs + row * DM + 1024 + h * 64 + d) = w; }
}
__device__ __forceinline__ void sconv_unit(Ctx& F, int l, int b) {
    const bf16_t* projs = (const bf16_t*)(F.ws + WS_PROJS); bf16_t* mixs = (bf16_t*)(F.ws + WS_MIXS);
    QTICKET(F);
    const int ch = F.tid; const float* cw = F.a->in[IN_CONVW] + l * 3 * 512; const float w0 = cw[ch], w1 = cw[512 + ch], w2 = cw[1024 + ch];
    float um2 = F.a->in[IN_SCONV][((size_t)(l * DB + b) * 2 + 0) * 512 + ch], um1 = F.a->in[IN_SCONV][((size_t)(l * DB + b) * 2 + 1) * 512 + ch];
    float ac[4], ah[4], ab[4], az[4];
#pragma unroll
    for (int t = 0; t < 4; ++t) { const bf16_t* pr = projs + (size_t)(b * DS + t) * PN + 256 * (ch >> 6) + (ch & 63); ac[t] = bf1(pr[0]); ab[t] = bf1(pr[64]); ah[t] = bf1(pr[128]); az[t] = bf1(pr[192]); }
#pragma unroll
    for (int t = 0; t < 4; ++t) { const size_t row = (size_t)(b * DS + t);
        const float u = ac[t] * ah[t]; const float o = w0 * um2 + w1 * um1 + w2 * u;
        mixs[row * DM + ch] = (bf16_t)f2bf(ab[t] * o * siluf(az[t]));
        um2 = um1; um1 = u; }
    F.out[O_CONVS + ((size_t)(l * DB + b) * 2 + 0) * 512 + ch] = um2; F.out[O_CONVS + ((size_t)(l * DB + b) * 2 + 1) * 512 + ch] = um1;
}

#ifndef TPA
#define TPA -1
#endif
#ifndef TPB
#define TPB -1
#endif
constexpr int CW_TS = 120000;
constexpr int N_PHASES = 11;
__global__ void __launch_bounds__(NTHREADS, 2) hymba_fwd(const Args args) {
    extern __shared__ __attribute__((aligned(16))) unsigned char lds_raw[];
    Ctx F;
    const int wave_s = __builtin_amdgcn_readfirstlane((int)threadIdx.x >> 6);
#define LEADER (wave_s == 0 && lane_id() == 0)
    F.lds = (LAS unsigned char*)lds_raw; F.tid = wave_s * 64 + lane_id(); F.lane = F.tid & 63; F.wave = wave_s; F.G = gridDim.x; F.bid = blockIdx.x;
    F.a = &args;
    F.pend = nullptr;
    F.out = args.out; F.ws = args.ws; F.ctlf = (float*)(args.ws + WS_CTL);
    volatile LAS unsigned* MISC = (volatile LAS unsigned*)(F.lds + MISC_OFF);
    if (F.tid < 64) MISC[F.tid] = 0u;
    __syncthreads();
    XcdBarrier bar; bar.bar = (unsigned*)(args.ws + WS_CTL) + CW_BAR; bar.x = 0; bar.st = nullptr;
    if (MK_N_LAUNCHES == 1) bar = xcd_barrier_post((unsigned*)(args.ws + WS_CTL) + CW_BAR, MISC + 8, LEADER);
    const int lo = args.ph_lo, hi = args.ph_hi;
#define IN(k) (lo <= (k) && (k) < hi)
#define STAMP(k) do { if (TPA >= 0 && F.bid == 0 && LEADER) ((unsigned long long*)(F.ctlf + CW_TS))[k] = __builtin_amdgcn_s_memrealtime(); } while (0)
#define SEAM(k) do { if (IN(k) && IN((k) + 1)) { xcd_barrier(bar, LEADER); STAMP((k) + 1); } } while (0)
#define PHASE_ENTER() do { int t_ = wave_s * 64 + lane_id(); asm volatile("" : "+v"(t_)); F.tid = t_; F.lane = t_ & 63; F.wave = __builtin_amdgcn_readfirstlane(t_ >> 6); } while (0)
#define QUEUE_BEGIN(ph, NIT) { const int qg_ = F.bid & 7; F.qctr = (unsigned*)(args.ws + WS_CTL) + CW_Q + ((ph) * 8 + qg_) * 64; int it = qg_ + 8 * (F.bid >> 3); \
        while (it < (NIT)) { F.tk = 0u; PHASE_ENTER();
#define QUEUE_END() __syncthreads(); if (F.tid == 0) MISC[16] = (unsigned)(F.bid & 7) + 8u * ((unsigned)(F.G >> 3) + F.tk); __syncthreads(); it = __builtin_amdgcn_readfirstlane((int)MISC[16]); } }

    STAMP(0);
    if (IN(0)) { PHASE_ENTER(); p0_prologue(F); }
    SEAM(0);
    for (int l = 0; l < 2; ++l) {
        const int pb = 1 + 5 * l;
        float* ssP = F.ctlf + CW_SSP + l * NP; float* ssS = F.ctlf + CW_SSS + l * NS;
        bf16_t* WinT = (bf16_t*)(F.ws + WS_WIN + l * WIN_L); bf16_t* WoutT = (bf16_t*)(F.ws + WS_WOUT + l * WOUT_L);
        if (IN(pb)) {
            pg8::Gemm g{(const bf16_t*)(F.ws + WS_XB), WinT, NP, PN, DM}; pg8::StaticOrder S; S.init(NP, PN, F.G, F.bid);
            pg8::EpiProj E{(bf16_t*)(F.ws + WS_PROJ), PN, ssP, F.out + O_CONVP + (size_t)l * 2 * 2 * 512};
            pg8::gemm_phase<pg8::EpiProj, pg8::StaticOrder, true, true>(F.lds, g, S, E, wave_s);
        }
        unsigned bgen = 0u; bool bwait = false;
        if (IN(pb) && IN(pb + 1)) { bgen = xcd_barrier_arrive(bar, LEADER); bwait = true; }
        if (IN(pb + 1)) {
            unsigned* dep = (unsigned*)(args.ws + WS_CTL) + CW_DEP + l * 256;
            const int a1 = 96, a2 = a1 + 128, a3 = a2 + 128, a4 = a3 + 256, a5 = a4, a6 = a5 + (l == 0 ? 171 : 0);
            const int c1 = a6 + (l == 0 ? 128 : 0), c2 = c1 + 128, c3 = c2 + 128, c4 = c3 + 64, c5 = c4 + 32, c6 = c5 + 128, c7 = c6, NIT = c7 + (l == 0 ? 171 : 0);
            bool depS = false, depG = false;
            QUEUE_BEGIN(pb + 1, NIT)
                unsigned* done_ = nullptr;
                if (bwait && !(it < (l == 0 ? a2 : a1))) { xcd_barrier_wait(bar, LEADER, bgen); STAMP(pb + 1); bwait = false; }
                if (it >= a6 && it < c5 && !depS) {
                    QPUBLISH(F);
                    if (F.tid == 0) {
                        XB_SPIN(xb_ld(dep) < 96u || (l == 0 && xb_ld(dep + 128) < 128u), bar.bar);
                        __builtin_amdgcn_fence(__ATOMIC_ACQUIRE, "agent");
                        asm volatile("s_waitcnt vmcnt(0)" ::: "memory");
                    }
                    __syncthreads();
                    depS = true;
                }
                if (it >= c5 && it < c6 && !depG) {
                    QPUBLISH(F);
                    if (F.tid == 0) {
                        XB_SPIN(xb_ld(dep + 64) < 256u, bar.bar);
                        __builtin_amdgcn_fence(__ATOMIC_ACQUIRE, "agent");
                        asm volatile("s_waitcnt vmcnt(0)" ::: "memory");
                    }
                    __syncthreads();
                    depG = true;
                }
                if (it < a1) { SgEpiBf16 E{(bf16_t*)(F.ws + WS_PROJS) + it * 64, PN, ssS}; sg_unit(F, (const bf16_t*)(F.ws + WS_XS), WinT + (size_t)it * 64 * DM, E); done_ = dep; }
                else if (it < a2) {
                    if (l == 0) { const int q = it - a1, rb = q >> 5, cb = q & 31;
                        SgEpiF32 E{(float*)(F.ws + WS_MEMKV) + (size_t)rb * 128 * 2048 + cb * 64, 2048, F.ctlf + CW_SSM + rb * 128};
                        sg_unit(F, (const bf16_t*)(F.ws + WS_MEMA) + (size_t)rb * 128 * DM, (const bf16_t*)(F.ws + WS_WMEM) + (size_t)cb * 64 * DM, E); done_ = dep + 128; }
                    else memp_unit<false>(F, l, it - a1); }
                else if (it < a3) swa_unit(F, l, it - a2);
                else if (it < a4) { glaA2_unit(F, l, it - a3); done_ = dep + 64; }
                else if (it < a6) cvt1_item(F, it - a5);
                else if (it < c1) memfin_item(F, it - a6);
                else if (it < c2) mem_unit<true>(F, l, it - c1);
                else if (it < c3) sgla_unit(F, l, it - c2);
                else if (it < c4) sswa_unit(F, l, it - c3);
                else if (it < c5) sconv_unit(F, l, it - c4);
                else if (it < c6) gla_scan_item(F, l, it - c5);
                else cvt1_item(F, 171 + it - c7);
                F.pend = done_;
            QUEUE_END()
            QPUBLISH(F);
        }
        if (bwait) { xcd_barrier_wait(bar, LEADER, bgen); bwait = false; }
        if (IN(pb + 1) && IN(pb + 3)) {
            const unsigned g2 = xcd_barrier_arrive(bar, LEADER);
            unsigned* rdyc = (unsigned*)(args.ws + WS_CTL) + CW_RDY + l * 512;
            for (int cu = F.bid; cu < 256; cu += F.G) { PHASE_ENTER(); conv_unit(F, l, cu); F.pend = rdyc + (cu >> 3) * 16; __syncthreads(); }
            QPUBLISH(F);
            xcd_barrier_wait(bar, LEADER, g2); STAMP(pb + 3);
        }
        unsigned* rdy = (unsigned*)(args.ws + WS_CTL) + CW_RDY + l * 512;
        if (IN(pb + 3)) {
            const int n1 = 32, n2 = n1 + (l == 0 ? 128 : 0), n3 = n2 + 512, NIT = n3 + (l == 0 ? 170 : 0);
            QUEUE_BEGIN(pb + 3, NIT)
                unsigned* done_ = nullptr;
                if (it < n1) { SgEpiOut E{(l == 0 ? F.a->in[IN_XS] : F.out + O_YS) + it * 64, F.out + O_YS + it * 64, l == 0 ? (bf16_t*)(F.ws + WS_XS) + it * 64 : nullptr, F.ctlf + CW_SSS + NS};
                    sg_unit(F, (const bf16_t*)(F.ws + WS_MIXS), WoutT + (size_t)it * 64 * DM, E); }
                else if (it < n2) { const int q = it - n1, h = q & 3, qb = (q >> 2) & 15, b = q >> 6; memp_unit<true>(F, l, b * 64 + h * 16 + qb); done_ = rdy + (b * 16 + qb) * 16; }
                else if (it < n3) { const int q = it - n2, h = q & 3, c = (q >> 2) & 63, b = q >> 8; glaC_unit(F, l, (b * 4 + h) * 64 + c); done_ = rdy + (b * 16 + (c >> 2)) * 16; }
                else cvt1_item(F, 342 + it - n3);
                F.pend = done_;
            QUEUE_END()
            QPUBLISH(F);
        }
        if (IN(pb + 4)) {
            pg8::Gemm g{(const bf16_t*)(F.ws + WS_MIX), WoutT, NP, DM, DM}; DepOrder S; S.init(NP, DM, F.G, F.bid); S.cnt = rdy; S.target = (l == 0 ? 28u : 24u);
            if (l == 0) { pg8::EpiOut<false> E{nullptr, nullptr, (bf16_t*)(F.ws + WS_XB), F.ctlf + CW_SSP + NP}; pg8::gemm_phase<pg8::EpiOut<false>, DepOrder, false, true>(F.lds, g, S, E, wave_s); }
            else { pg8::EpiOut<true> E{nullptr, F.out + O_YP, (bf16_t*)(F.ws + WS_XB), nullptr}; pg8::gemm_phase<pg8::EpiOut<true>, DepOrder, false, true>(F.lds, g, S, E, wave_s); }
        }
        if (l == 0) SEAM(pb + 4);
    }
    if (TPA >= 0) {
        xcd_barrier(bar, LEADER); STAMP(11);
        if (F.bid == 0) { __syncthreads();
            const unsigned long long* ts = (const unsigned long long*)(F.ctlf + CW_TS);
            const float T1 = (float)(ts[TPA + 1] - ts[TPA]) * 0.01f, T2 = (float)(ts[TPB + 1] - ts[TPB]) * 0.01f;
            float* cp = F.out + O_CONVP; const float sc = 1.f + T1 * 0.001f;
            for (int i = wave_s * 64 + lane_id(); i < 4096; i += NTHREADS) cp[i] *= sc;
            if (LEADER) F.out[O_YP] += T2 * 0.25f; }
    }
#undef IN
#undef SEAM
}

extern "C" void kernel_launch(void* const* d_in, const int* in_sizes, int n_in, void* d_out, int out_size, void* d_ws, size_t ws_size, hipStream_t stream) {
    static int grid = 0;
    if (grid == 0) {
        if (n_in != 23 || out_size != (int)O_END || ws_size < WS_END) { fprintf(stderr, "kernel_launch: unexpected shapes (n_in %d out %d ws %zu)\n", n_in, out_size, ws_size); grid = -1; return; }
        int dev = 0, cus = 0, per_cu = 0;
        if (hipGetDevice(&dev) != hipSuccess || hipDeviceGetAttribute(&cus, hipDeviceAttributeMultiprocessorCount, dev) != hipSuccess) { grid = -1; return; }
        if (hipFuncSetAttribute((const void*)hymba_fwd, hipFuncAttributeMaxDynamicSharedMemorySize, LDS_BYTES) != hipSuccess) { fprintf(stderr, "kernel_launch: hipFuncSetAttribute failed\n"); grid = -1; return; }
        if (hipOccupancyMaxActiveBlocksPerMultiprocessor(&per_cu, (const void*)hymba_fwd, NTHREADS, LDS_BYTES) != hipSuccess || per_cu < 1) { fprintf(stderr, "kernel_launch: occupancy query reports %d\n", per_cu); }
        (void)hipGetLastError();
        grid = cus - (cus % 8);
    }
    if (grid < 0) return;
    (void)hipMemsetAsync((char*)d_ws + WS_CTL, 0, CTL_ZERO_BYTES, stream);
    Args a{};
    for (int i = 0; i < 23; ++i) a.in[i] = (const float*)d_in[i];
    a.out = (float*)d_out; a.ws = (unsigned char*)d_ws;
    if (MK_N_LAUNCHES == 1) { a.ph_lo = 0; a.ph_hi = N_PHASES; hipLaunchKernelGGL(hymba_fwd, dim3(grid), dim3(NTHREADS), LDS_BYTES, stream, a); }
    else { for (int p = 0; p < N_PHASES; ++p) { a.ph_lo = p; a.ph_hi = p + 1; hipLaunchKernelGGL(hymba_fwd, dim3(grid), dim3(NTHREADS), LDS_BYTES, stream, a); } }
}
```
